# Optimizing an MI355X kernel written in HIP

```python
import jax, jax.numpy as jnp
from jax import lax
import numpy as np

D_MODEL = 1024
BATCH = 8
SEQ = 2048
DEPTH = 1

MIX_WIDTH = D_MODEL
HG_WIDTH = MIX_WIDTH // 2
HG_HEAD_DIM = 128
HG_HEADS = HG_WIDTH // HG_HEAD_DIM
GL_WIDTH = MIX_WIDTH - HG_WIDTH
GL_HEADS = 4
GL_DV = GL_WIDTH // GL_HEADS
GL_DK = GL_DV // 2
GL_QK = GL_HEADS * GL_DK
GATE_RANK = 16
GATE_TAU = 16.0
CHUNK = 16
N_GROUPS = 8
EXPERTS_PER_GROUP = 8
N_EXPERTS = N_GROUPS * EXPERTS_PER_GROUP
TOP_K = 2
D_EXPERT = D_MODEL // 2
MOE_BLOCK = 128
DEEPNORM_ALPHA = (2.0 * DEPTH) ** 0.25
DEEPNORM_BETA = (8.0 * DEPTH) ** -0.25
LN_EPS = 1e-5
IN_SPLITS = (HG_WIDTH, HG_WIDTH, HG_WIDTH, HG_WIDTH, GL_QK, GL_QK, GL_WIDTH, GATE_RANK, GL_WIDTH)
IN_COLS = sum(IN_SPLITS)

kernel_name = 'hymba_hgrn2_gla_hmoe_deepnorm'


def layer_norm(x, g, b):
    xf = x.astype(jnp.float32)
    mu = jnp.mean(xf, -1, keepdims=True)
    var = jnp.mean(jnp.square(xf - mu), -1, keepdims=True)
    return ((xf - mu) * lax.rsqrt(var + LN_EPS) * g.astype(jnp.float32) + b.astype(jnp.float32)).astype(x.dtype)


def head_rms_norm(o, gain):
    B, T, H, dv = o.shape
    o = o * lax.rsqrt(jnp.mean(jnp.square(o), -1, keepdims=True) + LN_EPS)
    return o.reshape(B, T, H * dv) * gain.astype(jnp.float32)


def to_chunks(t):
    B, T, H, d = t.shape
    return t.reshape(B, T // CHUNK, CHUNK, H, d).transpose(0, 3, 1, 2, 4)


def chunk_gla(q, k, v, log_g):
    B, T, H, dk = q.shape
    dv = v.shape[-1]
    q, k, v, lg = [to_chunks(t.astype(jnp.float32)) for t in (q, k, v, log_g)]
    b = jnp.cumsum(lg, axis=3)
    b_last = b[..., -1:, :]
    causal = jnp.tril(jnp.ones((CHUNK, CHUNK), bool))[:, :, None]
    diff = b[..., :, None, :] - b[..., None, :, :]
    decay = jnp.exp(jnp.where(causal, diff, -jnp.inf))
    scores = jnp.einsum('bhntsk,bhnsk->bhnts', q[..., :, None, :] * decay, k)
    o_intra = jnp.einsum('bhnts,bhnsv->bhntv', scores, v)
    u = jnp.einsum('bhnsk,bhnsv->bhnkv', k * jnp.exp(b_last - b), v)
    g_chunk = jnp.exp(b_last[..., 0, :])

    def step(S, inp):
        g_n, u_n = inp
        return g_n[..., None] * S + u_n, S

    _, s_prev = lax.scan(step, jnp.zeros((B, H, dk, dv), jnp.float32),
                         (jnp.moveaxis(g_chunk, 2, 0), jnp.moveaxis(u, 2, 0)))
    s_prev = jnp.moveaxis(s_prev, 0, 2)
    o_inter = jnp.einsum('bhntk,bhnkv->bhntv', q * jnp.exp(b), s_prev)
    o = o_intra + o_inter
    return o.transpose(0, 2, 3, 1, 4).reshape(B, T, H, dv)


def hybrid_mixer(x, w_in, w_a2, b_a, lb, norm_h, norm_g, w_out):
    B, T, _ = x.shape
    split_at = [int(i) for i in np.cumsum(IN_SPLITS)[:-1]]
    hq, hf, hi, hg, gq, gk, gv, ga, gg = jnp.split(x @ w_in, split_at, axis=-1)

    f = lb + (1.0 - lb) * jax.nn.sigmoid(hf.astype(jnp.float32))
    o_h = chunk_gla((hq * HG_HEAD_DIM ** -0.5).reshape(B, T, HG_HEADS, HG_HEAD_DIM),
                    (1.0 - f).reshape(B, T, HG_HEADS, HG_HEAD_DIM),
                    hi.reshape(B, T, HG_HEADS, HG_HEAD_DIM),
                    jnp.log(f).reshape(B, T, HG_HEADS, HG_HEAD_DIM))
    o_h = head_rms_norm(o_h, norm_h) * jax.nn.silu(hg.astype(jnp.float32))

    log_a = jax.nn.log_sigmoid((ga @ w_a2 + b_a).astype(jnp.float32)) / GATE_TAU
    o_g = chunk_gla((gq * GL_DK ** -0.5).reshape(B, T, GL_HEADS, GL_DK),
                    gk.reshape(B, T, GL_HEADS, GL_DK),
                    gv.reshape(B, T, GL_HEADS, GL_DV),
                    log_a.reshape(B, T, GL_HEADS, GL_DK))
    o_g = head_rms_norm(o_g, norm_g) * jax.nn.silu(gg.astype(jnp.float32))

    o = jnp.concatenate([o_h, o_g], axis=-1).astype(x.dtype)
    return o @ w_out


def hierarchical_moe(x, w_group_router, w_expert_router, w_gate, w_up, w_down):
    B, T, D = x.shape
    n_tok = B * T
    xf = x.reshape(n_tok, D)
    p_group = jax.nn.softmax((xf @ w_group_router).astype(jnp.float32), axis=-1)
    p_top_group, g_idx = lax.top_k(p_group, 1)
    e_logits = (xf @ w_expert_router).astype(jnp.float32).reshape(n_tok, N_GROUPS, EXPERTS_PER_GROUP)
    e_logits = jnp.take_along_axis(e_logits, g_idx[:, :, None], axis=1)[:, 0]
    p_top, e_local = lax.top_k(jax.nn.softmax(e_logits, axis=-1), TOP_K)
    gates = p_top_group * p_top / jnp.sum(p_top, -1, keepdims=True)
    expert_id = g_idx * EXPERTS_PER_GROUP + e_local

    n_assign = n_tok * TOP_K
    flat_e = expert_id.reshape(-1)
    flat_tok = jnp.repeat(jnp.arange(n_tok, dtype=jnp.int32), TOP_K)
    flat_w = gates.reshape(-1)
    order = jnp.argsort(flat_e)
    sorted_e = flat_e[order]
    counts = jnp.bincount(flat_e, length=N_EXPERTS)
    starts = jnp.cumsum(counts) - counts
    padded = (counts + MOE_BLOCK - 1) // MOE_BLOCK * MOE_BLOCK
    padded_ends = jnp.cumsum(padded)
    padded_starts = padded_ends - padded
    dest = padded_starts[sorted_e] + jnp.arange(n_assign, dtype=jnp.int32) - starts[sorted_e]
    n_blocks = -(-n_assign // MOE_BLOCK) + N_EXPERTS
    n_slots = n_blocks * MOE_BLOCK
    slot_tok = jnp.full((n_slots,), n_tok, jnp.int32).at[dest].set(flat_tok[order])
    slot_w = jnp.zeros((n_slots,), jnp.float32).at[dest].set(flat_w[order])
    block_expert = jnp.minimum(
        jnp.searchsorted(padded_ends, jnp.arange(n_blocks, dtype=jnp.int32) * MOE_BLOCK, side='right'),
        N_EXPERTS - 1)
    x_pad = jnp.concatenate([xf, jnp.zeros((1, D), xf.dtype)], axis=0)
    xb = x_pad[slot_tok].reshape(n_blocks, MOE_BLOCK, D)

    def expert_block(args):
        xb_, e = args
        h = jax.nn.silu(xb_ @ w_gate[e]) * (xb_ @ w_up[e])
        return h @ w_down[e]

    yb = lax.map(expert_block, (xb, block_expert)).reshape(n_slots, D)
    y = jnp.zeros((n_tok + 1, D), jnp.float32).at[slot_tok].add(yb.astype(jnp.float32) * slot_w[:, None])
    return y[:n_tok].astype(x.dtype).reshape(B, T, D)


def setup_inputs(seed: int = 0) -> dict:
    key = jax.random.key(seed)
    ks = jax.random.split(key, 20)
    L = DEPTH
    f32 = jnp.float32

    def nrm(k, shape, scale):
        return jax.random.normal(k, shape, f32) * scale

    col_scale = jnp.concatenate([jnp.full((n,), DEEPNORM_BETA if i in (2, 6) else 1.0, f32)
                                 for i, n in enumerate(IN_SPLITS)])
    return {
        'x': nrm(ks[0], (BATCH, SEQ, D_MODEL), 1.0),
        'w_in': nrm(ks[1], (L, D_MODEL, IN_COLS), D_MODEL ** -0.5) * col_scale,
        'w_a2': nrm(ks[2], (L, GATE_RANK, GL_QK), GATE_RANK ** -0.5),
        'b_a': nrm(ks[3], (L, GL_QK), 0.1),
        'lb_logits': nrm(ks[4], (L + 1, HG_WIDTH), 0.5),
        'norm_h': 1.0 + nrm(ks[5], (L, HG_WIDTH), 0.02),
        'norm_g': 1.0 + nrm(ks[6], (L, GL_WIDTH), 0.02),
        'w_out': nrm(ks[7], (L, MIX_WIDTH, D_MODEL), MIX_WIDTH ** -0.5 * DEEPNORM_BETA),
        'ln1_g': 1.0 + nrm(ks[8], (L, D_MODEL), 0.02),
        'ln1_b': nrm(ks[9], (L, D_MODEL), 0.02),
        'w_group_router': nrm(ks[10], (L, D_MODEL, N_GROUPS), D_MODEL ** -0.5),
        'w_expert_router': nrm(ks[11], (L, D_MODEL, N_EXPERTS), D_MODEL ** -0.5),
        'w_gate': nrm(ks[12], (L, N_EXPERTS, D_MODEL, D_EXPERT), D_MODEL ** -0.5 * DEEPNORM_BETA),
        'w_up': nrm(ks[13], (L, N_EXPERTS, D_MODEL, D_EXPERT), D_MODEL ** -0.5 * DEEPNORM_BETA),
        'w_down': nrm(ks[14], (L, N_EXPERTS, D_EXPERT, D_MODEL), D_EXPERT ** -0.5 * DEEPNORM_BETA),
        'ln2_g': 1.0 + nrm(ks[15], (L, D_MODEL), 0.02),
        'ln2_b': nrm(ks[16], (L, D_MODEL), 0.02),
    }


def reference(x, w_in, w_a2, b_a, lb_logits, norm_h, norm_g, w_out, ln1_g, ln1_b,
              w_group_router, w_expert_router, w_gate, w_up, w_down, ln2_g, ln2_b):
    lb_all = jnp.cumsum(jax.nn.softmax(lb_logits.astype(jnp.float32), axis=0), axis=0)
    for l in range(DEPTH):
        h = hybrid_mixer(x, w_in[l], w_a2[l], b_a[l], lb_all[l], norm_h[l], norm_g[l], w_out[l])
        x = layer_norm(DEEPNORM_ALPHA * x + h, ln1_g[l], ln1_b[l])
        h = hierarchical_moe(x, w_group_router[l], w_expert_router[l], w_gate[l], w_up[l], w_down[l])
        x = layer_norm(DEEPNORM_ALPHA * x + h, ln2_g[l], ln2_b[l])
    return x
```

```cpp
#include <hip/hip_runtime.h>
#include <hip/hip_cooperative_groups.h>
#include <cstdio>
namespace cg = cooperative_groups;

#ifndef SINGLE
#define SINGLE 1
#endif

typedef unsigned short u16;
typedef __attribute__((ext_vector_type(8))) short bf16x8;
typedef __attribute__((ext_vector_type(4))) short bf16x4;
typedef __attribute__((ext_vector_type(4))) float f32x4;
typedef __bf16 bf16x2_t __attribute__((ext_vector_type(2)));
typedef float f32x2_t __attribute__((ext_vector_type(2)));
typedef unsigned u32x4 __attribute__((ext_vector_type(4)));
typedef unsigned u32x2 __attribute__((ext_vector_type(2)));

constexpr int NTOK = 16384;
constexpr int SEQ = 2048;
constexpr int DM = 1024;
constexpr int INC = 3600;
constexpr int NEXP = 64;
constexpr int DEXP = 512;
constexpr int CAP = 32768;
constexpr float ALPHA = 1.189207115002721f;
constexpr float LN_EPS = 1e-5f;

struct Params {
  const float *x, *w_in, *w_a2, *b_a, *lb, *norm_h, *norm_g, *w_out, *ln1_g, *ln1_b, *w_gr, *w_er,
      *w_gate, *w_up, *w_down, *ln2_g, *ln2_b;
  float* out;
  u16* P;
  float* LF;
  float* GA;
  float* Z;
  u16* O;
  float* X1;
  u16* X1B;
  u16* H;
  u16* Y;
  int* cnt;
  int* tok_e;
  int* tok_pos;
  int* list_tok;
  float* list_gate;
  u16* XB;
  u16* WinT;
  u16* WoutT;
  char* IMGH;
  char* IMGG;
  unsigned* bar;
  int use_cg; int pad_;
};

__device__ __forceinline__ unsigned pack2(float a, float b) {
  f32x2_t f = {a, b};
  bf16x2_t h = __builtin_convertvector(f, bf16x2_t);
  return *(unsigned*)&h;
}
__device__ __forceinline__ u16 f2bf(float a) {
  __bf16 h = (__bf16)a;
  return *(u16*)&h;
}
__device__ __forceinline__ float bf2f(u16 v) { return __uint_as_float(((unsigned)v) << 16); }
__device__ __forceinline__ float bflo(unsigned v) { return __uint_as_float(v << 16); }
__device__ __forceinline__ float bfhi(unsigned v) { return __uint_as_float(v & 0xffff0000u); }
__device__ __forceinline__ float sigmoidf(float x) { return 1.f / (1.f + __expf(-x)); }
__device__ __forceinline__ float siluf(float x) { return x / (1.f + __expf(-x)); }

constexpr int BM = 128, BN = 128, BK = 64, LDT = 72;
constexpr int GEMM_SMEM = (BM + BN) * LDT * 2;

template <bool ABF, bool BBF, class RowF, class ColF, class Epi>
__device__ __forceinline__ void gemm_tile(char* smem, int K, RowF rowptr, ColF colptr, int ldb, Epi epi) {
  u16* As = (u16*)smem;
  u16* Bs = As + BM * LDT;
  const int tid = threadIdx.x, lane = tid & 63, w = tid >> 6, wm = w >> 1, wn = w & 1;
  const int l15 = lane & 15, kg = lane >> 4;
  f32x4 acc[4][4];
#pragma unroll
  for (int i = 0; i < 4; i++)
#pragma unroll
    for (int j = 0; j < 4; j++) acc[i][j] = f32x4{0.f, 0.f, 0.f, 0.f};

  constexpr int NA = ABF ? 4 : 8;
  const int ar0 = ABF ? (tid >> 3) : (tid >> 4);
  const int ac = ABF ? (tid & 7) * 8 : (tid & 15) * 4;
  constexpr int ARS = ABF ? 32 : 16;
  const char* ap[NA];
#pragma unroll
  for (int i = 0; i < NA; i++) ap[i] = (const char*)rowptr(ar0 + ARS * i) + ac * (ABF ? 2 : 4);
  const int bc = tid & 127, kh = tid >> 7;
  const float* bp = BBF ? nullptr : ((const float*)colptr(bc) + (size_t)(kh * 32) * ldb);
  const int br0 = tid >> 3, bcc = (tid & 7) * 8;
  const char* bq[4];
  if (BBF) {
#pragma unroll
    for (int i = 0; i < 4; i++) bq[i] = (const char*)colptr(br0 + 32 * i) + bcc * 2;
  }

  u32x4 ra[NA];
  float rb[BBF ? 1 : 32];
  u32x4 rbb[BBF ? 4 : 1];
  auto gload = [&](int k0) {
#pragma unroll
    for (int i = 0; i < NA; i++) ra[i] = *(const u32x4*)(ap[i] + (size_t)k0 * (ABF ? 2 : 4));
    if (BBF) {
#pragma unroll
      for (int i = 0; i < 4; i++) rbb[BBF ? i : 0] = *(const u32x4*)(bq[i] + (size_t)k0 * 2);
    } else {
      const float* b = bp + (size_t)k0 * ldb;
#pragma unroll
      for (int j = 0; j < 32; j++) rb[BBF ? 0 : j] = b[(size_t)j * ldb];
    }
  };
  auto sstore = [&]() {
#pragma unroll
    for (int i = 0; i < NA; i++) {
      if (ABF) {
        *(u32x4*)&As[(ar0 + ARS * i) * LDT + ac] = ra[i];
      } else {
        u32x2 v;
        v[0] = pack2(__uint_as_float(ra[i][0]), __uint_as_float(ra[i][1]));
        v[1] = pack2(__uint_as_float(ra[i][2]), __uint_as_float(ra[i][3]));
        *(u32x2*)&As[(ar0 + ARS * i) * LDT + ac] = v;
      }
    }
    if (BBF) {
#pragma unroll
      for (int i = 0; i < 4; i++) *(u32x4*)&Bs[(br0 + 32 * i) * LDT + bcc] = rbb[BBF ? i : 0];
    } else {
#pragma unroll
      for (int j = 0; j < 4; j++) {
        u32x4 v;
        v[0] = pack2(rb[BBF ? 0 : 8 * j + 0], rb[BBF ? 0 : 8 * j + 1]);
        v[1] = pack2(rb[BBF ? 0 : 8 * j + 2], rb[BBF ? 0 : 8 * j + 3]);
        v[2] = pack2(rb[BBF ? 0 : 8 * j + 4], rb[BBF ? 0 : 8 * j + 5]);
        v[3] = pack2(rb[BBF ? 0 : 8 * j + 6], rb[BBF ? 0 : 8 * j + 7]);
        *(u32x4*)&Bs[bc * LDT + kh * 32 + 8 * j] = v;
      }
    }
  };

  gload(0);
  for (int k0 = 0; k0 < K; k0 += BK) {
    __syncthreads();
    sstore();
    __syncthreads();
    if (k0 + BK < K) gload(k0 + BK);
#pragma unroll
    for (int ks = 0; ks < 2; ks++) {
      bf16x8 af[4], bfr[4];
#pragma unroll
      for (int mi = 0; mi < 4; mi++) af[mi] = *(const bf16x8*)&As[(wm * 64 + mi * 16 + l15) * LDT + ks * 32 + kg * 8];
#pragma unroll
      for (int ni = 0; ni < 4; ni++) bfr[ni] = *(const bf16x8*)&Bs[(wn * 64 + ni * 16 + l15) * LDT + ks * 32 + kg * 8];
#pragma unroll
      for (int mi = 0; mi < 4; mi++)
#pragma unroll
        for (int ni = 0; ni < 4; ni++)
          acc[mi][ni] = __builtin_amdgcn_mfma_f32_16x16x32_bf16(bfr[ni], af[mi], acc[mi][ni], 0, 0, 0);
    }
  }
  epi(acc, wm * 64 + l15, wn * 64 + kg * 4);
}


__device__ void transpose_tile(const float* W, int ld, int N, int k0, int n0, u16* WT, int K, char* smem) {
  u16* T = (u16*)smem;
  const int tid = threadIdx.x;
  __syncthreads();
  {
    const int r = tid >> 4, c4 = (tid & 15) * 4;
#pragma unroll
    for (int i = 0; i < 4; i++) {
      const int k = r + 16 * i;
      float4 v = make_float4(0.f, 0.f, 0.f, 0.f);
      if (n0 + c4 < N) v = *(const float4*)&W[(size_t)(k0 + k) * ld + n0 + c4];
      T[(c4 + 0) * 72 + k] = f2bf(v.x); T[(c4 + 1) * 72 + k] = f2bf(v.y);
      T[(c4 + 2) * 72 + k] = f2bf(v.z); T[(c4 + 3) * 72 + k] = f2bf(v.w);
    }
  }
  __syncthreads();
  {
    const int n = tid >> 2, seg = (tid & 3) * 16;
    if (n0 + n < N) {
      u32x4 a = *(const u32x4*)&T[n * 72 + seg], b = *(const u32x4*)&T[n * 72 + seg + 8];
      *(u32x4*)&WT[(size_t)(n0 + n) * K + k0 + seg] = a;
      *(u32x4*)&WT[(size_t)(n0 + n) * K + k0 + seg + 8] = b;
    }
  }
}
__device__ void phaseP0(const Params& p, char* smem) {
  if (blockIdx.x == 0 && threadIdx.x < 64) p.cnt[threadIdx.x] = 0;
  constexpr int NTI = 57 * 16, NTO = 16 * 16;
  for (int u = blockIdx.x; u < NTI + NTO; u += gridDim.x) {
    if (u < NTI) transpose_tile(p.w_in, INC, INC, (u % 16) * 64, (u / 16) * 64, p.WinT, DM, smem);
    else { const int v = u - NTI; transpose_tile(p.w_out, DM, DM, (v % 16) * 64, (v / 16) * 64, p.WoutT, DM, smem); }
  }
  const size_t n4 = (size_t)NTOK * DM / 4;
  for (size_t i = blockIdx.x * (size_t)256 + threadIdx.x; i < n4; i += (size_t)gridDim.x * 256) {
    float4 v = ((const float4*)p.x)[i];
    uint2 o; o.x = pack2(v.x, v.y); o.y = pack2(v.z, v.w);
    ((uint2*)p.XB)[i] = o;
  }
}

__device__ void phaseA(const Params& p, char* smem) {
  constexpr int NT = 29;
  for (int u = blockIdx.x; u < 128 * NT; u += gridDim.x) {
    const int mt = u / NT, nt = u % NT;
    const int m0 = mt * 128, n0 = nt * 128;
    const u16* xa = p.XB + (size_t)m0 * DM;
    auto rowf = [&](int r) { return (const void*)(xa + (size_t)r * DM); };
    auto colf = [&](int c) { int n = n0 + c; if (n > INC - 1) n = INC - 1; return (const void*)(p.WinT + (size_t)n * DM); };
    auto epi = [&](f32x4 (&acc)[4][4], int mb, int nb) {
#pragma unroll
      for (int mi = 0; mi < 4; mi++)
#pragma unroll
        for (int ni = 0; ni < 4; ni++) {
          const int m = m0 + mb + mi * 16, n = n0 + nb + ni * 16;
          f32x4 v = acc[mi][ni];
          if (n >= INC) continue;
          if (n >= 512 && n < 1024) {
            const int c = n - 512;
            float lf[4], kf[4];
#pragma unroll
            for (int r = 0; r < 4; r++) {
              float lbv = sigmoidf(p.lb[c + r] - p.lb[512 + c + r]);
              float sg = sigmoidf(v[r]);
              float f = lbv + (1.f - lbv) * sg;
              lf[r] = __logf(f);
              kf[r] = (1.f - lbv) * (1.f - sg);
            }
            *(float4*)&p.LF[(size_t)m * 512 + c] = make_float4(lf[0], lf[1], lf[2], lf[3]);
            uint2 o; o.x = pack2(kf[0], kf[1]); o.y = pack2(kf[2], kf[3]);
            *(uint2*)&p.P[(size_t)m * INC + n] = o;
          } else if (n >= 3072 && n < 3088) {
            *(float4*)&p.GA[(size_t)m * 16 + (n - 3072)] = make_float4(v[0], v[1], v[2], v[3]);
          } else {
            if (n < 512) { v *= 0.08838834764831845f; }
            else if ((n >= 1536 && n < 2048) || n >= 3088) {
#pragma unroll
              for (int r = 0; r < 4; r++) v[r] = siluf(v[r]);
            } else if (n >= 2048 && n < 2304) { v *= 0.125f; }
            uint2 o; o.x = pack2(v[0], v[1]); o.y = pack2(v[2], v[3]);
            *(uint2*)&p.P[(size_t)m * INC + n] = o;
          }
        }
    };
    gemm_tile<true, true>(smem, DM, rowf, colf, INC, epi);
  }
}

__device__ __forceinline__ float dpp_scan_add(float x) {
  int xi;
  xi = __builtin_amdgcn_update_dpp(0, __float_as_int(x), 0x111, 0xf, 0xf, true); x += __int_as_float(xi);
  xi = __builtin_amdgcn_update_dpp(0, __float_as_int(x), 0x112, 0xf, 0xf, true); x += __int_as_float(xi);
  xi = __builtin_amdgcn_update_dpp(0, __float_as_int(x), 0x114, 0xf, 0xf, true); x += __int_as_float(xi);
  xi = __builtin_amdgcn_update_dpp(0, __float_as_int(x), 0x118, 0xf, 0xf, true); x += __int_as_float(xi);
  return x;
}


__device__ __forceinline__ float dpp_row_bcast15(float x) {
  return __int_as_float(__builtin_amdgcn_update_dpp(0, __float_as_int(x), 0x15F, 0xf, 0xf, false));
}
__device__ __forceinline__ float dpp_row_sum(float x) {
  x += __int_as_float(__builtin_amdgcn_update_dpp(0, __float_as_int(x), 0x128, 0xf, 0xf, false));
  x += __int_as_float(__builtin_amdgcn_update_dpp(0, __float_as_int(x), 0x124, 0xf, 0xf, false));
  x += __int_as_float(__builtin_amdgcn_update_dpp(0, __float_as_int(x), 0x122, 0xf, 0xf, false));
  x += __int_as_float(__builtin_amdgcn_update_dpp(0, __float_as_int(x), 0x121, 0xf, 0xf, false));
  return x;
}

#define STAGE() do { __builtin_amdgcn_sched_barrier(0); asm volatile("s_nop 15\n\ts_nop 15" ::: "memory"); __builtin_amdgcn_sched_barrier(0); } while (0)
template <int DK, bool HG, int MODE>
__device__ void recur_unit(const Params& p, char* smem, int b, int h, char* img, int nstart, int nstep) {
  constexpr int IMG = (2 * 16 * (DK + 8) + DK * 20 + 128 * 20) * 2 + DK * 4;
  constexpr int NIM = (IMG + 4095) / 4096;
  constexpr int KPT = DK / 16;
  constexpr int NKS = DK / 32;
  constexpr int NKT = DK / 16;
  constexpr int LQ = DK + 8;
  u16* Qt = (u16*)smem;
  u16* Kt = Qt + 16 * LQ;
  u16* KhT = Kt + 16 * LQ;
  u16* VT = KhT + DK * 20;
  float* Gch = (float*)(VT + 128 * 20);
  float* SS = Gch + DK;
  float* Wa = SS + 64;

  const int tid = threadIdx.x, lane = tid & 63, w = tid >> 6, l15 = lane & 15, kg = lane >> 4;
  const int t = tid & 15, kgp = tid >> 4, k0 = kgp * KPT;
  const int qcol = HG ? (h * 128) : (2048 + h * 64);
  const int kcol = HG ? (512 + h * 128) : (2304 + h * 64);
  const int vcol = HG ? (1024 + h * 128) : (2560 + h * 128);
  const int gcol = HG ? (1536 + h * 128) : (3088 + h * 128);
  const int ocol = HG ? (h * 128) : (512 + h * 128);
  const float* gain = HG ? p.norm_h : p.norm_g;

  float ba[KPT];
  if (!HG && MODE == 1) {
    __syncthreads();
    for (int i = tid; i < 16 * 64; i += 256) Wa[i] = p.w_a2[(i >> 6) * 256 + h * 64 + (i & 63)];
#pragma unroll
    for (int i = 0; i < KPT; i++) ba[i] = p.b_a[h * 64 + k0 + i];
    __syncthreads();
  }
  const float g0 = gain[h * 128 + w * 32 + l15], g1 = gain[h * 128 + w * 32 + 16 + l15];

  f32x4 S[NKT][2];
#pragma unroll
  for (int i = 0; i < NKT; i++) { S[i][0] = f32x4{0, 0, 0, 0}; S[i][1] = f32x4{0, 0, 0, 0}; }

  float4 pl[4];
  uint4 pq, pk, pv;
  u16 psg[8];
  u32x4 im[NIM];
  u16 pend[8] = {0, 0, 0, 0, 0, 0, 0, 0};
  auto prefetch = [&](int n) {
    if (MODE == 2) {
      const char* src = img + (size_t)n * IMG;
#pragma unroll
      for (int i = 0; i < NIM; i++) if (tid * 16 + 4096 * i < IMG) im[i] = *(const u32x4*)(src + tid * 16 + 4096 * i);
#pragma unroll
      for (int r = 0; r < 4; r++) {
        const u16* gr = p.P + ((size_t)b * SEQ + n * 16 + kg * 4 + r) * INC + gcol + w * 32 + l15;
        psg[r] = gr[0];
        psg[4 + r] = gr[16];
      }
      return;
    }
    const size_t tok = (size_t)b * SEQ + n * 16 + t;
    const u16* prow = p.P + tok * INC;
    if (HG) {
      pl[0] = *(const float4*)&p.LF[tok * 512 + h * 128 + k0];
      pl[1] = *(const float4*)&p.LF[tok * 512 + h * 128 + k0 + 4];
      pq = *(const uint4*)&prow[qcol + k0];
      pk = *(const uint4*)&prow[kcol + k0];
    } else {
#pragma unroll
      for (int i = 0; i < 4; i++) pl[i] = *(const float4*)&p.GA[tok * 16 + 4 * i];
      uint2 a = *(const uint2*)&prow[qcol + k0];
      uint2 c = *(const uint2*)&prow[kcol + k0];
      pq.x = a.x; pq.y = a.y; pk.x = c.x; pk.y = c.y;
    }
    pv = *(const uint4*)&prow[vcol + kgp * 8];
  };

  prefetch(nstart);
  for (int n = nstart; n < SEQ / 16; n += nstep) {
    asm volatile("s_waitcnt vmcnt(0)" ::: "memory");
    float sgate[8];
    if (MODE == 2) {
      if (n > 0) {
#pragma unroll
        for (int r = 0; r < 4; r++) {
          u16* orow = p.O + ((size_t)b * SEQ + (n - 1) * 16 + kg * 4 + r) * DM + ocol + w * 32 + l15;
          orow[0] = pend[r];
          orow[16] = pend[4 + r];
        }
      }
#pragma unroll
      for (int i = 0; i < NIM; i++) if (tid * 16 + 4096 * i < IMG) *(u32x4*)(smem + tid * 16 + 4096 * i) = im[i];
#pragma unroll
      for (int i = 0; i < 8; i++) sgate[i] = bf2f(psg[i]);
      __builtin_amdgcn_sched_barrier(0);
      if (n + nstep < SEQ / 16) prefetch(n + nstep);
      __builtin_amdgcn_sched_barrier(0);
    } else {
    float lg[KPT], qv[KPT], kv[KPT];
    if (HG) {
      lg[0] = pl[0].x; lg[1] = pl[0].y; lg[2] = pl[0].z; lg[3] = pl[0].w;
      if (KPT > 4) { lg[4 % KPT] = pl[1].x; lg[5 % KPT] = pl[1].y; lg[6 % KPT] = pl[1].z; lg[7 % KPT] = pl[1].w; }
    } else {
      float ga[16] = {pl[0].x, pl[0].y, pl[0].z, pl[0].w, pl[1].x, pl[1].y, pl[1].z, pl[1].w,
                      pl[2].x, pl[2].y, pl[2].z, pl[2].w, pl[3].x, pl[3].y, pl[3].z, pl[3].w};
      float z[4] = {ba[0], ba[1], ba[2], ba[3]};
#pragma unroll
      for (int r = 0; r < 16; r++) {
        float4 wv = *(const float4*)&Wa[r * 64 + k0];
        z[0] += ga[r] * wv.x; z[1] += ga[r] * wv.y; z[2] += ga[r] * wv.z; z[3] += ga[r] * wv.w;
      }
#pragma unroll
      for (int i = 0; i < 4; i++) {
        float sp = fmaxf(-z[i], 0.f) + __logf(1.f + __expf(-fabsf(z[i])));
        lg[i] = -sp * (1.f / 16.f);
      }
    }
    {
      unsigned qq[4] = {pq.x, pq.y, pq.z, pq.w}, kk[4] = {pk.x, pk.y, pk.z, pk.w};
#pragma unroll
      for (int i = 0; i < KPT / 2; i++) {
        qv[2 * i] = bflo(qq[i]); qv[2 * i + 1] = bfhi(qq[i]);
        kv[2 * i] = bflo(kk[i]); kv[2 * i + 1] = bfhi(kk[i]);
      }
    }
    {
      unsigned vv[4] = {pv.x, pv.y, pv.z, pv.w};
#pragma unroll
      for (int i = 0; i < 4; i++) {
        VT[(kgp * 8 + 2 * i) * 20 + t] = (u16)(vv[i] & 0xffff);
        VT[(kgp * 8 + 2 * i + 1) * 20 + t] = (u16)(vv[i] >> 16);
      }
    }
    __builtin_amdgcn_sched_barrier(0);
    if (n + nstep < SEQ / 16) prefetch(n + nstep);
    __builtin_amdgcn_sched_barrier(0);
    float qt[KPT], kt[KPT], kh[KPT];
#pragma unroll
    for (int i = 0; i < KPT; i++) {
      float bcum = dpp_scan_add(lg[i]);
      float bl = dpp_row_bcast15(bcum);
      qt[i] = qv[i] * __expf(bcum);
      kt[i] = kv[i] * __expf(-bcum);
      kh[i] = kv[i] * __expf(bl - bcum);
      if (t == 15) Gch[k0 + i] = __expf(bl);
      KhT[(k0 + i) * 20 + t] = f2bf(kh[i]);
    }
    if (KPT == 8) {
      uint4 a, c;
      a.x = pack2(qt[0], qt[1]); a.y = pack2(qt[2], qt[3]); a.z = pack2(qt[4 % KPT], qt[5 % KPT]); a.w = pack2(qt[6 % KPT], qt[7 % KPT]);
      c.x = pack2(kt[0], kt[1]); c.y = pack2(kt[2], kt[3]); c.z = pack2(kt[4 % KPT], kt[5 % KPT]); c.w = pack2(kt[6 % KPT], kt[7 % KPT]);
      *(uint4*)&Qt[t * LQ + k0] = a;
      *(uint4*)&Kt[t * LQ + k0] = c;
    } else {
      uint2 a, c;
      a.x = pack2(qt[0], qt[1]); a.y = pack2(qt[2], qt[3]);
      c.x = pack2(kt[0], kt[1]); c.y = pack2(kt[2], kt[3]);
      *(uint2*)&Qt[t * LQ + k0] = a;
      *(uint2*)&Kt[t * LQ + k0] = c;
    }
    }
    __syncthreads();
    if (MODE == 1) {
      char* dst = img + (size_t)n * IMG;
#pragma unroll
      for (int i = 0; i < NIM; i++) if (tid * 16 + 4096 * i < IMG) *(u32x4*)(dst + tid * 16 + 4096 * i) = *(const u32x4*)(smem + tid * 16 + 4096 * i);
      __syncthreads();
      continue;
    }

    STAGE();
    f32x4 sc = f32x4{0, 0, 0, 0};
    bf16x8 qf[NKS];
#pragma unroll
    for (int st = 0; st < NKS; st++) {
      bf16x4 q0 = *(const bf16x4*)&Qt[l15 * LQ + 32 * st + kg * 4];
      bf16x4 q1 = *(const bf16x4*)&Qt[l15 * LQ + 32 * st + 16 + kg * 4];
      bf16x4 c0 = *(const bf16x4*)&Kt[l15 * LQ + 32 * st + kg * 4];
      bf16x4 c1 = *(const bf16x4*)&Kt[l15 * LQ + 32 * st + 16 + kg * 4];
      qf[st] = bf16x8{q0[0], q0[1], q0[2], q0[3], q1[0], q1[1], q1[2], q1[3]};
      bf16x8 kf = bf16x8{c0[0], c0[1], c0[2], c0[3], c1[0], c1[1], c1[2], c1[3]};
      sc = __builtin_amdgcn_mfma_f32_16x16x32_bf16(kf, qf[st], sc, 0, 0, 0);
    }
    STAGE();
#pragma unroll
    for (int r = 0; r < 4; r++) if (kg * 4 + r > l15) sc[r] = 0.f;
    bf16x4 pA;
    {
      unsigned a = pack2(sc[0], sc[1]), c = pack2(sc[2], sc[3]);
      pA = bf16x4{(short)(a & 0xffff), (short)(a >> 16), (short)(c & 0xffff), (short)(c >> 16)};
    }
    bf16x4 vf[2];
    f32x4 o[2], oin[2];
    bf16x8 sbv[2][NKS];
#pragma unroll
    for (int vt = 0; vt < 2; vt++) {
      vf[vt] = *(const bf16x4*)&VT[(w * 32 + vt * 16 + l15) * 20 + kg * 4];
#pragma unroll
      for (int st = 0; st < NKS; st++) {
        unsigned s0 = pack2(S[2 * st][vt][0], S[2 * st][vt][1]), s1 = pack2(S[2 * st][vt][2], S[2 * st][vt][3]);
        unsigned s2 = pack2(S[2 * st + 1][vt][0], S[2 * st + 1][vt][1]), s3 = pack2(S[2 * st + 1][vt][2], S[2 * st + 1][vt][3]);
        sbv[vt][st] = bf16x8{(short)(s0 & 0xffff), (short)(s0 >> 16), (short)(s1 & 0xffff), (short)(s1 >> 16),
                           (short)(s2 & 0xffff), (short)(s2 >> 16), (short)(s3 & 0xffff), (short)(s3 >> 16)};
      }
    }
    STAGE();
#pragma unroll
    for (int vt = 0; vt < 2; vt++) {
      o[vt] = __builtin_amdgcn_mfma_f32_16x16x16bf16_1k(pA, vf[vt], f32x4{0, 0, 0, 0}, 0, 0, 0);
      oin[vt] = f32x4{0, 0, 0, 0};
#pragma unroll
      for (int st = 0; st < NKS; st++) oin[vt] = __builtin_amdgcn_mfma_f32_16x16x32_bf16(qf[st], sbv[vt][st], oin[vt], 0, 0, 0);
    }
    STAGE();
    bf16x4 khf[NKT];
#pragma unroll
    for (int kt2 = 0; kt2 < NKT; kt2++) {
      khf[kt2] = *(const bf16x4*)&KhT[(16 * kt2 + l15) * 20 + kg * 4];
      float4 g4 = *(const float4*)&Gch[16 * kt2 + kg * 4];
      f32x4 gv = f32x4{g4.x, g4.y, g4.z, g4.w};
      S[kt2][0] *= gv; S[kt2][1] *= gv;
    }
    STAGE();
#pragma unroll
    for (int kt2 = 0; kt2 < NKT; kt2++) {
#pragma unroll
      for (int vt = 0; vt < 2; vt++)
        S[kt2][vt] = __builtin_amdgcn_mfma_f32_16x16x16bf16_1k(khf[kt2], vf[vt], S[kt2][vt], 0, 0, 0);
    }
    STAGE();
    float ss[4];
#pragma unroll
    for (int r = 0; r < 4; r++) {
      o[0][r] += oin[0][r]; o[1][r] += oin[1][r];
      float s = o[0][r] * o[0][r] + o[1][r] * o[1][r];
      s = dpp_row_sum(s);
      ss[r] = s;
    }
    if (l15 == 0) *(float4*)&SS[w * 16 + kg * 4] = make_float4(ss[0], ss[1], ss[2], ss[3]);
    __syncthreads();
    {
      float4 a0 = *(const float4*)&SS[0 * 16 + kg * 4], a1 = *(const float4*)&SS[1 * 16 + kg * 4];
      float4 a2 = *(const float4*)&SS[2 * 16 + kg * 4], a3 = *(const float4*)&SS[3 * 16 + kg * 4];
      float tot[4] = {a0.x + a1.x + a2.x + a3.x, a0.y + a1.y + a2.y + a3.y, a0.z + a1.z + a2.z + a3.z, a0.w + a1.w + a2.w + a3.w};
#pragma unroll
      for (int r = 0; r < 4; r++) {
        const float rstd = rsqrtf(tot[r] * (1.f / 128.f) + LN_EPS);
        pend[r] = f2bf(o[0][r] * rstd * g0 * sgate[r]);
        pend[4 + r] = f2bf(o[1][r] * rstd * g1 * sgate[4 + r]);
      }
    }
  }
  if (MODE == 2) {
#pragma unroll
    for (int r = 0; r < 4; r++) {
      u16* orow = p.O + ((size_t)b * SEQ + (SEQ / 16 - 1) * 16 + kg * 4 + r) * DM + ocol + w * 32 + l15;
      orow[0] = pend[r];
      orow[16] = pend[4 + r];
    }
  }
}

constexpr size_t IMGH_SZ = (2 * 16 * 136 + 128 * 20 + 128 * 20) * 2 + 128 * 4;
constexpr size_t IMGG_SZ = (2 * 16 * 72 + 64 * 20 + 128 * 20) * 2 + 64 * 4;
__device__ void phaseB0(const Params& p, char* smem) {
  const int nparts = gridDim.x >> 6;
  if ((int)blockIdx.x >= nparts * 64) return;
  const int u = blockIdx.x & 63, part = blockIdx.x >> 6;
  __syncthreads();
  if (u < 32) recur_unit<128, true, 1>(p, smem, u >> 2, u & 3, p.IMGH + (size_t)u * 128 * IMGH_SZ, part, nparts);
  else recur_unit<64, false, 1>(p, smem, (u - 32) >> 2, u & 3, p.IMGG + (size_t)(u - 32) * 128 * IMGG_SZ, part, nparts);
}
__device__ void phaseB(const Params& p, char* smem) {
  for (int u = blockIdx.x; u < 64; u += gridDim.x) {
    __syncthreads();
    if (u < 32) recur_unit<128, true, 2>(p, smem, u >> 2, u & 3, p.IMGH + (size_t)u * 128 * IMGH_SZ, 0, 1);
    else recur_unit<64, false, 2>(p, smem, (u - 32) >> 2, u & 3, p.IMGG + (size_t)(u - 32) * 128 * IMGG_SZ, 0, 1);
  }
}

__device__ void phaseC(const Params& p, char* smem) {
  for (int u = blockIdx.x; u < 128 * 8; u += gridDim.x) {
    const int mt = u >> 3, nt = u & 7;
    const int m0 = mt * 128, n0 = nt * 128;
    auto rowf = [&](int r) { return (const void*)(p.O + (size_t)(m0 + r) * DM); };
    auto colf = [&](int c) { return (const void*)(p.WoutT + (size_t)(n0 + c) * DM); };
    auto epi = [&](f32x4 (&acc)[4][4], int mb, int nb) {
#pragma unroll
      for (int mi = 0; mi < 4; mi++)
#pragma unroll
        for (int ni = 0; ni < 4; ni++) {
          const size_t idx = (size_t)(m0 + mb + mi * 16) * DM + n0 + nb + ni * 16;
          float4 xv = *(const float4*)&p.x[idx];
          f32x4 v = acc[mi][ni];
          *(float4*)&p.Z[idx] = make_float4(ALPHA * xv.x + v[0], ALPHA * xv.y + v[1], ALPHA * xv.z + v[2], ALPHA * xv.w + v[3]);
        }
    };
    gemm_tile<true, true>(smem, DM, rowf, colf, DM, epi);
  }
}

__device__ __forceinline__ float wave_sum(float v) {
  v = dpp_row_sum(v);
  const int vi = __float_as_int(v);
  return (__int_as_float(__builtin_amdgcn_readlane(vi, 0)) + __int_as_float(__builtin_amdgcn_readlane(vi, 16))) +
         (__int_as_float(__builtin_amdgcn_readlane(vi, 32)) + __int_as_float(__builtin_amdgcn_readlane(vi, 48)));
}

__device__ __forceinline__ void ln_row(const float* zin, const float* g, const float* bb, int lane, float4 (&o)[4]) {
  float4 v[4];
  float s = 0.f;
#pragma unroll
  for (int i = 0; i < 4; i++) { v[i] = *(const float4*)&zin[lane * 4 + 256 * i]; s += v[i].x + v[i].y + v[i].z + v[i].w; }
  const float mu = wave_sum(s) * (1.f / 1024.f);
  float q = 0.f;
#pragma unroll
  for (int i = 0; i < 4; i++) {
    v[i].x -= mu; v[i].y -= mu; v[i].z -= mu; v[i].w -= mu;
    q += v[i].x * v[i].x + v[i].y * v[i].y + v[i].z * v[i].z + v[i].w * v[i].w;
  }
  const float rstd = rsqrtf(wave_sum(q) * (1.f / 1024.f) + LN_EPS);
#pragma unroll
  for (int i = 0; i < 4; i++) {
    float4 gg = *(const float4*)&g[lane * 4 + 256 * i], b4 = *(const float4*)&bb[lane * 4 + 256 * i];
    o[i] = make_float4(v[i].x * rstd * gg.x + b4.x, v[i].y * rstd * gg.y + b4.y, v[i].z * rstd * gg.z + b4.z, v[i].w * rstd * gg.w + b4.w);
  }
}

__device__ void phaseD(const Params& p, char* smem) {
  float* part = (float*)smem;
  float* logits = part + 4 * 16 * 80;
  const int tid = threadIdx.x, lane = tid & 63, w = tid >> 6, l15 = lane & 15, kg = lane >> 4;
  for (int g = blockIdx.x; g < NTOK / 16; g += gridDim.x) {
    const int row0 = g * 16;
    for (int i = 0; i < 4; i++) {
      const int row = row0 + w * 4 + i;
      float4 o[4];
      ln_row(p.Z + (size_t)row * DM, p.ln1_g, p.ln1_b, lane, o);
#pragma unroll
      for (int j = 0; j < 4; j++) {
        *(float4*)&p.X1[(size_t)row * DM + lane * 4 + 256 * j] = o[j];
        uint2 h; h.x = pack2(o[j].x, o[j].y); h.y = pack2(o[j].z, o[j].w);
        *(uint2*)&p.X1B[(size_t)row * DM + lane * 4 + 256 * j] = h;
      }
    }
    __threadfence();
    __syncthreads();
    __builtin_amdgcn_fence(__ATOMIC_ACQUIRE, "agent");
    f32x4 acc[5];
#pragma unroll
    for (int i = 0; i < 5; i++) acc[i] = f32x4{0, 0, 0, 0};
    const float* xrow = p.X1 + (size_t)(row0 + l15) * DM + 256 * w + 4 * kg;
    for (int it = 0; it < 16; it++) {
      float4 a4 = *(const float4*)&xrow[16 * it];
      const float av[4] = {a4.x, a4.y, a4.z, a4.w};
      const int kb = 256 * w + 16 * it + 4 * kg;
#pragma unroll
      for (int i = 0; i < 4; i++) {
        const float* we = p.w_er + (size_t)(kb + i) * 64 + l15;
#pragma unroll
        for (int nt = 0; nt < 4; nt++)
          acc[nt] = __builtin_amdgcn_mfma_f32_16x16x4f32(av[i], we[16 * nt], acc[nt], 0, 0, 0);
        float wg = (l15 < 8) ? p.w_gr[(size_t)(kb + i) * 8 + l15] : 0.f;
        acc[4] = __builtin_amdgcn_mfma_f32_16x16x4f32(av[i], wg, acc[4], 0, 0, 0);
      }
    }
#pragma unroll
    for (int nt = 0; nt < 5; nt++)
#pragma unroll
      for (int r = 0; r < 4; r++) part[(w * 16 + kg * 4 + r) * 80 + nt * 16 + l15] = acc[nt][r];
    __syncthreads();
    for (int idx = tid; idx < 16 * 72; idx += 256) {
      const int r = idx / 72, c = idx % 72;
      logits[r * 72 + c] = part[(0 * 16 + r) * 80 + c] + part[(1 * 16 + r) * 80 + c] + part[(2 * 16 + r) * 80 + c] + part[(3 * 16 + r) * 80 + c];
    }
    __syncthreads();
    if (tid < 16) {
      const float* L = logits + tid * 72;
      const int tok = row0 + tid;
      float gm = L[64]; int gi = 0;
      for (int i = 1; i < 8; i++) if (L[64 + i] > gm) { gm = L[64 + i]; gi = i; }
      float gs = 0.f;
      for (int i = 0; i < 8; i++) gs += expf(L[64 + i] - gm);
      const float pg = 1.f / gs;
      const float* E = L + gi * 8;
      float em = E[0]; int i1 = 0;
      for (int i = 1; i < 8; i++) if (E[i] > em) { em = E[i]; i1 = i; }
      float e2 = -3.0e38f; int i2 = 0;
      for (int i = 0; i < 8; i++) if (i != i1 && E[i] > e2) { e2 = E[i]; i2 = i; }
      const float p1 = 1.f, p2 = expf(e2 - em);
      const float gt1 = pg * p1 / (p1 + p2), gt2 = pg * p2 / (p1 + p2);
      const int ex1 = gi * 8 + i1, ex2 = gi * 8 + i2;
      const int pos1 = atomicAdd(&p.cnt[ex1], 1);
      const int pos2 = atomicAdd(&p.cnt[ex2], 1);
      p.list_tok[ex1 * CAP + pos1] = tok; p.list_gate[ex1 * CAP + pos1] = gt1;
      p.list_tok[ex2 * CAP + pos2] = tok; p.list_gate[ex2 * CAP + pos2] = gt2;
      p.tok_e[tok * 2] = ex1; p.tok_e[tok * 2 + 1] = ex2;
      p.tok_pos[tok * 2] = pos1; p.tok_pos[tok * 2 + 1] = pos2;
    }
    __syncthreads();
  }
}

__device__ __forceinline__ void moe_prefix(const Params& p, int* s_off, int* s_rb) {
  __syncthreads();
  if (threadIdx.x == 0) {
    int o = 0, r = 0;
    for (int e = 0; e < NEXP; e++) {
      s_off[e] = o; s_rb[e] = r;
      int c = p.cnt[e];
      o += c; r += (c + 127) >> 7;
    }
    s_off[NEXP] = o; s_rb[NEXP] = r;
  }
  __syncthreads();
}

__device__ void phaseE1(const Params& p, char* smem) {
  int* s_off = (int*)(smem + GEMM_SMEM);
  int* s_rb = s_off + 72;
  moe_prefix(p, s_off, s_rb);
  const int nunits = s_rb[NEXP] * 8;
  for (int u = blockIdx.x; u < nunits; u += gridDim.x) {
    const int rbg = u >> 3, jt = u & 7;
    int e = 0;
    while (s_rb[e + 1] <= rbg) e++;
    const int rb = rbg - s_rb[e];
    const int cnt = p.cnt[e];
    const int rows = min(128, cnt - rb * 128);
    const int* lt = p.list_tok + e * CAP + rb * 128;
    const int slot0 = s_off[e] + rb * 128;
    const int j0 = jt * 64;
    const float* wg = p.w_gate + (size_t)e * DM * DEXP;
    const float* wu = p.w_up + (size_t)e * DM * DEXP;
    auto rowf = [&](int r) { int rr = r < rows ? r : 0; return (const void*)(p.X1B + (size_t)lt[rr] * DM); };
    auto colf = [&](int c) { return (const void*)(((c & 32) ? wu : wg) + j0 + (c >> 6) * 32 + (c & 31)); };
    auto epi = [&](f32x4 (&acc)[4][4], int mb, int nb) {
      const int wn = nb >> 6, kg4 = nb & 63;
#pragma unroll
      for (int mi = 0; mi < 4; mi++) {
        const int r = mb + mi * 16;
        if (r < rows) {
#pragma unroll
          for (int ni = 0; ni < 2; ni++) {
            f32x4 gv = acc[mi][ni], uv = acc[mi][ni + 2];
            uint2 o;
            o.x = pack2(siluf(gv[0]) * uv[0], siluf(gv[1]) * uv[1]);
            o.y = pack2(siluf(gv[2]) * uv[2], siluf(gv[3]) * uv[3]);
            *(uint2*)&p.H[(size_t)(slot0 + r) * DEXP + j0 + wn * 32 + ni * 16 + kg4] = o;
          }
        }
      }
    };
    gemm_tile<true, false>(smem, DM, rowf, colf, DEXP, epi);
  }
}

__device__ void phaseE2(const Params& p, char* smem) {
  int* s_off = (int*)(smem + GEMM_SMEM);
  int* s_rb = s_off + 72;
  moe_prefix(p, s_off, s_rb);
  const int nunits = s_rb[NEXP] * 8;
  for (int u = blockIdx.x; u < nunits; u += gridDim.x) {
    const int rbg = u >> 3, nt = u & 7;
    int e = 0;
    while (s_rb[e + 1] <= rbg) e++;
    const int rb = rbg - s_rb[e];
    const int cnt = p.cnt[e];
    const int rows = min(128, cnt - rb * 128);
    const int slot0 = s_off[e] + rb * 128;
    const int n0 = nt * 128;
    const float* wd = p.w_down + (size_t)e * DEXP * DM;
    const float* lg = p.list_gate + e * CAP + rb * 128;
    auto rowf = [&](int r) { int rr = r < rows ? r : 0; return (const void*)(p.H + (size_t)(slot0 + rr) * DEXP); };
    auto colf = [&](int c) { return (const void*)(wd + n0 + c); };
    auto epi = [&](f32x4 (&acc)[4][4], int mb, int nb) {
#pragma unroll
      for (int mi = 0; mi < 4; mi++) {
        const int r = mb + mi * 16;
        if (r < rows) {
          const float gt = lg[r];
#pragma unroll
          for (int ni = 0; ni < 4; ni++) {
            f32x4 v = acc[mi][ni];
            uint2 o; o.x = pack2(gt * v[0], gt * v[1]); o.y = pack2(gt * v[2], gt * v[3]);
            *(uint2*)&p.Y[(size_t)(slot0 + r) * DM + n0 + nb + ni * 16] = o;
          }
        }
      }
    };
    gemm_tile<true, false>(smem, DEXP, rowf, colf, DM, epi);
  }
}

__device__ void phaseF(const Params& p, char* smem) {
  int* s_off = (int*)(smem + GEMM_SMEM);
  int* s_rb = s_off + 72;
  moe_prefix(p, s_off, s_rb);
  const int tid = threadIdx.x, lane = tid & 63, w = tid >> 6;
  for (int row = blockIdx.x * 4 + w; row < NTOK; row += gridDim.x * 4) {
    const int s0 = s_off[p.tok_e[row * 2]] + p.tok_pos[row * 2];
    const int s1 = s_off[p.tok_e[row * 2 + 1]] + p.tok_pos[row * 2 + 1];
    float4 v[4];
    float s = 0.f;
#pragma unroll
    for (int i = 0; i < 4; i++) {
      const int c = lane * 4 + 256 * i;
      float4 xv = *(const float4*)&p.X1[(size_t)row * DM + c];
      uint2 ya = *(const uint2*)&p.Y[(size_t)s0 * DM + c];
      uint2 yb = *(const uint2*)&p.Y[(size_t)s1 * DM + c];
      v[i].x = ALPHA * xv.x + (bflo(ya.x) + bflo(yb.x));
      v[i].y = ALPHA * xv.y + (bfhi(ya.x) + bfhi(yb.x));
      v[i].z = ALPHA * xv.z + (bflo(ya.y) + bflo(yb.y));
      v[i].w = ALPHA * xv.w + (bfhi(ya.y) + bfhi(yb.y));
      s += v[i].x + v[i].y + v[i].z + v[i].w;
    }
    const float mu = wave_sum(s) * (1.f / 1024.f);
    float q = 0.f;
#pragma unroll
    for (int i = 0; i < 4; i++) {
      v[i].x -= mu; v[i].y -= mu; v[i].z -= mu; v[i].w -= mu;
      q += v[i].x * v[i].x + v[i].y * v[i].y + v[i].z * v[i].z + v[i].w * v[i].w;
    }
    const float rstd = rsqrtf(wave_sum(q) * (1.f / 1024.f) + LN_EPS);
#pragma unroll
    for (int i = 0; i < 4; i++) {
      const int c = lane * 4 + 256 * i;
      float4 gg = *(const float4*)&p.ln2_g[c], b4 = *(const float4*)&p.ln2_b[c];
      *(float4*)&p.out[(size_t)row * DM + c] =
          make_float4(v[i].x * rstd * gg.x + b4.x, v[i].y * rstd * gg.y + b4.y, v[i].z * rstd * gg.z + b4.z, v[i].w * rstd * gg.w + b4.w);
    }
  }
}


#define XB_TMO      128
#define XB_XCNT(j)  (256  + 64 * (j))
#define XB_XSUB(j)  (1280 + 64 * (j))
#define XB_XGEN(j)  (2304 + 64 * (j))
#define XB_TOP      3328
#define XB_TOPGEN   3392
#define XCD_BAR_WORDS 3456
#define XB_SPIN_CAP (1u << 18)
#define LAS __attribute__((address_space(3)))
__device__ __forceinline__ unsigned xb_ld(unsigned* p)              { return __hip_atomic_load(p, __ATOMIC_RELAXED, __HIP_MEMORY_SCOPE_AGENT); }
__device__ __forceinline__ unsigned xb_add(unsigned* p, unsigned v) { return __hip_atomic_fetch_add(p, v, __ATOMIC_RELAXED, __HIP_MEMORY_SCOPE_AGENT); }
__device__ __forceinline__ unsigned xb_xcc_id() { return (unsigned)__builtin_amdgcn_s_getreg((3 << 11) | 20) & 0xFu; }
#define XB_SPIN(cond, bar) do { unsigned _sp = 0; while (cond) { __builtin_amdgcn_s_sleep(1); \
    if ((++_sp & 255u) == 0u) { if (xb_ld(&(bar)[XB_TMO])) break; if (_sp > XB_SPIN_CAP) { atomicAdd(&(bar)[XB_TMO], 1u); break; } } } } while (0)
struct XcdBarrier { unsigned* bar; unsigned x; volatile LAS unsigned* st; };
__device__ __forceinline__ XcdBarrier xcd_barrier_post(unsigned* bar, volatile LAS unsigned* st) {
  XcdBarrier b; b.bar = bar; b.x = xb_xcc_id(); b.st = st;
  if (threadIdx.x == 0) (void)xb_add(&bar[XB_XCNT(b.x)], 1u);
  return b;
}
__device__ __forceinline__ void xcd_barrier_complete(unsigned* bar, unsigned x, unsigned& nloc, unsigned& nx) {
  const unsigned G = gridDim.x * gridDim.y * gridDim.z;
  unsigned sum, cnt, mine, sp = 0u;
  for (;;) {
    sum = 0u; cnt = 0u; mine = 0u;
#pragma unroll
    for (unsigned j = 0; j < 16; ++j) { const unsigned c = xb_ld(&bar[XB_XCNT(j)]); sum += c; cnt += (c > 0u) ? 1u : 0u; mine = (j == x) ? c : mine; }
    if (sum == G) break;
    __builtin_amdgcn_s_sleep(1);
    if ((++sp & 255u) == 0u) { if (xb_ld(&bar[XB_TMO])) break; if (sp > XB_SPIN_CAP) { atomicAdd(&bar[XB_TMO], 1u); break; } }
  }
  nloc = mine > 0u ? mine : 1u; nx = cnt > 0u ? cnt : 1u;
}
__device__ __forceinline__ void xcd_barrier(const XcdBarrier& b) {
  asm volatile("s_waitcnt vmcnt(0)" ::: "memory");
  __syncthreads();
  if (threadIdx.x == 0) {
    unsigned* bar = b.bar;
    __builtin_amdgcn_s_waitcnt(0);
    unsigned nloc = b.st[0], nx = b.st[1];
    if (nloc == 0u) { xcd_barrier_complete(bar, b.x, nloc, nx); b.st[0] = nloc; b.st[1] = nx; }
    const unsigned old = xb_add(&bar[XB_XSUB(b.x)], 1u);
    const unsigned gen = old / nloc;
    if (old + 1u == (gen + 1u) * nloc) {
      __builtin_amdgcn_fence(__ATOMIC_RELEASE, "agent");
      asm volatile("s_waitcnt vmcnt(0)" ::: "memory");
      const unsigned og = xb_add(&bar[XB_TOP], 1u);
      const unsigned tg = og / nx;
      if (og + 1u == (tg + 1u) * nx) xb_add(&bar[XB_TOPGEN], 1u);
      else XB_SPIN(xb_ld(&bar[XB_TOPGEN]) == tg, bar);
      __builtin_amdgcn_fence(__ATOMIC_ACQUIRE, "agent");
      xb_add(&bar[XB_XGEN(b.x)], 1u);
      asm volatile("s_waitcnt vmcnt(0)" ::: "memory");
    } else {
      XB_SPIN(xb_ld(&bar[XB_XGEN(b.x)]) == gen, bar);
      __builtin_amdgcn_fence(__ATOMIC_ACQUIRE, "agent");
      asm volatile("s_waitcnt vmcnt(0)" ::: "memory");
    }
  }
  __syncthreads();
}

constexpr int SMEM_BYTES = GEMM_SMEM + 1024;

#if SINGLE
__global__ void __launch_bounds__(256, 2) fwd_megakernel(Params p) {
  __shared__ __attribute__((aligned(16))) char smem[SMEM_BYTES];
  cg::grid_group grid = cg::this_grid();
  volatile LAS unsigned* st = (volatile LAS unsigned*)(smem + GEMM_SMEM + 768);
  if (threadIdx.x < 2) st[threadIdx.x] = 0u;
  __syncthreads();
  XcdBarrier xb = xcd_barrier_post(p.bar, st);
  if (p.use_cg) grid.sync();
  phaseP0(p, smem);
  xcd_barrier(xb);
  phaseA(p, smem);
  xcd_barrier(xb);
  phaseB0(p, smem);
  xcd_barrier(xb);
  phaseB(p, smem);
  xcd_barrier(xb);
  phaseC(p, smem);
  xcd_barrier(xb);
  phaseD(p, smem);
  xcd_barrier(xb);
  phaseE1(p, smem);
  xcd_barrier(xb);
  phaseE2(p, smem);
  xcd_barrier(xb);
  phaseF(p, smem);
}
#else
#define PHASE_KERNEL(NAME, FN)                                             \
  __global__ void __launch_bounds__(256, 2) NAME(Params p) {                  \
    __shared__ __attribute__((aligned(16))) char smem[SMEM_BYTES];         \
    FN(p, smem);                                                           \
  }
PHASE_KERNEL(kA, phaseA)
PHASE_KERNEL(kB, phaseB)
PHASE_KERNEL(kC, phaseC)
PHASE_KERNEL(kD, phaseD)
PHASE_KERNEL(kE1, phaseE1)
PHASE_KERNEL(kE2, phaseE2)
PHASE_KERNEL(kF, phaseF)
#endif

extern "C" void kernel_launch(void* const* d_in, const int* in_sizes, int n_in, void* d_out, int out_size,
                              void* d_ws, size_t ws_size, hipStream_t stream) {
  Params p{};
  p.x = (const float*)d_in[0];
  p.w_in = (const float*)d_in[1];
  p.w_a2 = (const float*)d_in[2];
  p.b_a = (const float*)d_in[3];
  p.lb = (const float*)d_in[4];
  p.norm_h = (const float*)d_in[5];
  p.norm_g = (const float*)d_in[6];
  p.w_out = (const float*)d_in[7];
  p.ln1_g = (const float*)d_in[8];
  p.ln1_b = (const float*)d_in[9];
  p.w_gr = (const float*)d_in[10];
  p.w_er = (const float*)d_in[11];
  p.w_gate = (const float*)d_in[12];
  p.w_up = (const float*)d_in[13];
  p.w_down = (const float*)d_in[14];
  p.ln2_g = (const float*)d_in[15];
  p.ln2_b = (const float*)d_in[16];
  p.out = (float*)d_out;
  char* ws = (char*)d_ws;
  size_t off = 0;
  auto take = [&](size_t bytes) { char* r = ws + off; off += (bytes + 255) & ~(size_t)255; return r; };
  p.P = (u16*)take((size_t)NTOK * INC * 2);
  p.LF = (float*)take((size_t)NTOK * 512 * 4);
  p.GA = (float*)take((size_t)NTOK * 16 * 4);
  p.Z = (float*)take((size_t)NTOK * DM * 4);
  p.O = (u16*)take((size_t)NTOK * DM * 2);
  p.X1 = (float*)take((size_t)NTOK * DM * 4);
  p.X1B = (u16*)take((size_t)NTOK * DM * 2);
  p.cnt = (int*)take(256);
  p.tok_e = (int*)take((size_t)NTOK * 2 * 4);
  p.tok_pos = (int*)take((size_t)NTOK * 2 * 4);
  p.list_tok = (int*)take((size_t)NEXP * CAP * 4);
  p.list_gate = (float*)take((size_t)NEXP * CAP * 4);
  p.bar = (unsigned*)take(XCD_BAR_WORDS * 4);
  p.XB = p.O;
  p.IMGH = (char*)p.X1;
  p.IMGG = (char*)p.Z;
  p.WinT = (u16*)take((size_t)INC * DM * 2);
  p.WoutT = (u16*)take((size_t)DM * DM * 2);
  p.use_cg = 0; p.pad_ = 0;
  p.H = p.P;
  p.Y = p.P + (size_t)32768 * DEXP;

#if SINGLE
  static int grid_blocks = 0;
  if (!grid_blocks) {
    int dev = 0, cus = 0, per_cu = 0;
    hipGetDevice(&dev);
    hipDeviceGetAttribute(&cus, hipDeviceAttributeMultiprocessorCount, dev);
    hipOccupancyMaxActiveBlocksPerMultiprocessor(&per_cu, fwd_megakernel, 256, 0);
    if (per_cu > 2) per_cu = 2;
    grid_blocks = cus * per_cu;
  }
  hipMemsetAsync(p.bar, 0, XCD_BAR_WORDS * 4, stream);
  void* args[] = {&p};
  hipError_t e = hipLaunchCooperativeKernel((void*)fwd_megakernel, dim3(grid_blocks), dim3(256), args, 0, stream);
  if (e != hipSuccess) fprintf(stderr, "cooperative launch failed: %s (grid %d)\n", hipGetErrorString(e), grid_blocks);
#else
  const int G = 512;
  kA<<<G, 256, 0, stream>>>(p);
  kB<<<64, 256, 0, stream>>>(p);
  kC<<<G, 256, 0, stream>>>(p);
  kD<<<G, 256, 0, stream>>>(p);
  kE1<<<G, 256, 0, stream>>>(p);
  kE2<<<G, 256, 0, stream>>>(p);
  kF<<<G, 256, 0, stream>>>(p);
#endif
}
```

```cpp
#include <hip/hip_runtime.h>
#include <hip/hip_cooperative_groups.h>
#include <cstdio>
namespace cg = cooperative_groups;

#ifndef SINGLE
#define SINGLE 1
#endif

typedef unsigned short u16;
typedef __attribute__((ext_vector_type(8))) short bf16x8;
typedef __attribute__((ext_vector_type(4))) short bf16x4;
typedef __attribute__((ext_vector_type(4))) float f32x4;
typedef __bf16 bf16x2_t __attribute__((ext_vector_type(2)));
typedef float f32x2_t __attribute__((ext_vector_type(2)));
typedef unsigned u32x4 __attribute__((ext_vector_type(4)));
typedef unsigned u32x2 __attribute__((ext_vector_type(2)));

constexpr int NTOK = 16384;
constexpr int SEQ = 2048;
constexpr int DM = 1024;
constexpr int INC = 3600;
constexpr int NEXP = 64;
constexpr int DEXP = 512;
constexpr int CAP = 32768;
constexpr float ALPHA = 1.189207115002721f;
constexpr float LN_EPS = 1e-5f;

struct Params {
  const float *x, *w_in, *w_a2, *b_a, *lb, *norm_h, *norm_g, *w_out, *ln1_g, *ln1_b, *w_gr, *w_er,
      *w_gate, *w_up, *w_down, *ln2_g, *ln2_b;
  float* out;
  u16* P;
  float* LF;
  float* GA;
  float* Z;
  u16* O;
  float* X1;
  u16* X1B;
  u16* H;
  u16* Y;
  int* cnt;
  int* tok_e;
  int* tok_pos;
  int* list_tok;
  float* list_gate;
  u16* XB;
  u16* WinT;
  u16* WoutT;
  u16* WgT;
  u16* WuT;
  char* IMGH;
  char* IMGG;
  unsigned* bar;
  int use_cg; int pad_;
};

__device__ __forceinline__ unsigned pack2(float a, float b) {
  f32x2_t f = {a, b};
  bf16x2_t h = __builtin_convertvector(f, bf16x2_t);
  return *(unsigned*)&h;
}
__device__ __forceinline__ u16 f2bf(float a) {
  __bf16 h = (__bf16)a;
  return *(u16*)&h;
}
__device__ __forceinline__ float bf2f(u16 v) { return __uint_as_float(((unsigned)v) << 16); }
__device__ __forceinline__ float bflo(unsigned v) { return __uint_as_float(v << 16); }
__device__ __forceinline__ float bfhi(unsigned v) { return __uint_as_float(v & 0xffff0000u); }
__device__ __forceinline__ float sigmoidf(float x) { return 1.f / (1.f + __expf(-x)); }
__device__ __forceinline__ float siluf(float x) { return x / (1.f + __expf(-x)); }


constexpr int QW_BASE = 3456;
__device__ __forceinline__ unsigned my_xcc_id() { return (unsigned)__builtin_amdgcn_s_getreg((3 << 11) | 20) & 7u; }
template <class F>
__device__ __forceinline__ void xcd_queue_run(unsigned* qwords, int nper, char* smem_aux, F fn) {
  volatile int* slot = (volatile int*)smem_aux;
  const unsigned x = my_xcc_id();
  for (int dj = 0; dj < 8; dj++) {
    const int j = (int)((x + dj) & 7u);
    for (;;) {
      __syncthreads();
      if (threadIdx.x == 0) *slot = (int)__hip_atomic_fetch_add(qwords + 64 * j, 1u, __ATOMIC_RELAXED, __HIP_MEMORY_SCOPE_AGENT);
      __syncthreads();
      const int q = *slot;
      if (q >= nper) break;
      fn(j, q);
    }
  }
}

constexpr int BM = 128, BN = 128, BK = 64, LDT = 64;
constexpr int GEMM_SMEM = (BM + BN) * LDT * 2;

template <bool ABF, bool BBF, class RowF, class ColF, class Epi>
__device__ __forceinline__ void gemm_tile(char* smem, int K, RowF rowptr, ColF colptr, int ldb, Epi epi) {
  u16* As0 = (u16*)smem;
  const int tid = threadIdx.x, lane = tid & 63, w = tid >> 6, wm = w >> 1, wn = w & 1;
  const int l15 = lane & 15, kg = lane >> 4, swz = (l15 >> 1) & 7;
  f32x4 acc[4][4];
#pragma unroll
  for (int i = 0; i < 4; i++)
#pragma unroll
    for (int j = 0; j < 4; j++) acc[i][j] = f32x4{0.f, 0.f, 0.f, 0.f};

  constexpr int NA = ABF ? 4 : 8;
  const int ar0 = ABF ? (tid >> 3) : (tid >> 4);
  const int ac = ABF ? (tid & 7) * 8 : (tid & 15) * 4;
  constexpr int ARS = ABF ? 32 : 16;
  const char* ap[NA];
#pragma unroll
  for (int i = 0; i < NA; i++) ap[i] = (const char*)rowptr(ar0 + ARS * i) + ac * (ABF ? 2 : 4);
  const int bc = tid & 127, kh = tid >> 7;
  const float* bp = BBF ? nullptr : ((const float*)colptr(bc) + (size_t)(kh * 32) * ldb);
  const int br0 = tid >> 3, bcc = (tid & 7) * 8;
  const char* bq[4];
  if (BBF) {
#pragma unroll
    for (int i = 0; i < 4; i++) bq[i] = (const char*)colptr(br0 + 32 * i) + bcc * 2;
  }

  u32x4 ra[NA];
  float rb[BBF ? 1 : 32];
  u32x4 rbb[BBF ? 4 : 1];
  auto gload = [&](int k0) {
#pragma unroll
    for (int i = 0; i < NA; i++) ra[i] = *(const u32x4*)(ap[i] + (size_t)k0 * (ABF ? 2 : 4));
    if (BBF) {
#pragma unroll
      for (int i = 0; i < 4; i++) rbb[BBF ? i : 0] = *(const u32x4*)(bq[i] + (size_t)k0 * 2);
    } else {
      const float* b = bp + (size_t)k0 * ldb;
#pragma unroll
      for (int j = 0; j < 32; j++) rb[BBF ? 0 : j] = b[(size_t)j * ldb];
    }
  };
  auto sstore = [&](int buf) {
    u16* As = As0 + buf * (GEMM_SMEM / 2);
    u16* Bs = As + BM * LDT;
#pragma unroll
    for (int i = 0; i < NA; i++) {
      if (ABF) {
        { const int row = ar0 + ARS * i; *(u32x4*)&As[row * LDT + (((ac >> 3) ^ ((row >> 1) & 7)) << 3)] = ra[i]; }
      } else {
        u32x2 v;
        v[0] = pack2(__uint_as_float(ra[i][0]), __uint_as_float(ra[i][1]));
        v[1] = pack2(__uint_as_float(ra[i][2]), __uint_as_float(ra[i][3]));
        { const int row = ar0 + ARS * i; *(u32x2*)&As[row * LDT + (((ac >> 3) ^ ((row >> 1) & 7)) << 3) + (ac & 4)] = v; }
      }
    }
    if (BBF) {
#pragma unroll
      for (int i = 0; i < 4; i++) { const int row = br0 + 32 * i; *(u32x4*)&Bs[row * LDT + (((bcc >> 3) ^ ((row >> 1) & 7)) << 3)] = rbb[BBF ? i : 0]; }
    } else {
#pragma unroll
      for (int j = 0; j < 4; j++) {
        u32x4 v;
        v[0] = pack2(rb[BBF ? 0 : 8 * j + 0], rb[BBF ? 0 : 8 * j + 1]);
        v[1] = pack2(rb[BBF ? 0 : 8 * j + 2], rb[BBF ? 0 : 8 * j + 3]);
        v[2] = pack2(rb[BBF ? 0 : 8 * j + 4], rb[BBF ? 0 : 8 * j + 5]);
        v[3] = pack2(rb[BBF ? 0 : 8 * j + 6], rb[BBF ? 0 : 8 * j + 7]);
        *(u32x4*)&Bs[bc * LDT + (((kh * 4 + j) ^ ((bc >> 1) & 7)) << 3)] = v;
      }
    }
  };

  gload(0);
  sstore(0);
  __syncthreads();
  int cur = 0;
  for (int k0 = 0; k0 < K; k0 += BK) {
    if (k0 + BK < K) gload(k0 + BK);
    const u16* As = As0 + cur * (GEMM_SMEM / 2);
    const u16* Bs = As + BM * LDT;
    {
      bf16x8 af[2][4], bfr[2][4];
#pragma unroll
      for (int ks = 0; ks < 2; ks++) {
#pragma unroll
        for (int mi = 0; mi < 4; mi++) af[ks][mi] = *(const bf16x8*)&As[(wm * 64 + mi * 16 + l15) * LDT + (((ks * 4 + kg) ^ swz) << 3)];
#pragma unroll
        for (int ni = 0; ni < 4; ni++) bfr[ks][ni] = *(const bf16x8*)&Bs[(wn * 64 + ni * 16 + l15) * LDT + (((ks * 4 + kg) ^ swz) << 3)];
      }
      __builtin_amdgcn_sched_barrier(0);
#pragma unroll
      for (int ks = 0; ks < 2; ks++)
#pragma unroll
        for (int mi = 0; mi < 4; mi++)
#pragma unroll
          for (int ni = 0; ni < 4; ni++)
            acc[mi][ni] = __builtin_amdgcn_mfma_f32_16x16x32_bf16(bfr[ks][ni], af[ks][mi], acc[mi][ni], 0, 0, 0);
      __builtin_amdgcn_sched_barrier(0);
    }
    if (k0 + BK < K) sstore(cur ^ 1);
    __syncthreads();
    cur ^= 1;
  }
  epi(acc, wm * 64 + l15, wn * 64 + kg * 4);
}


__device__ void transpose_tile(const float* W, int ld, int N, int k0, int n0, u16* WT, int K, char* smem) {
  u16* T = (u16*)smem;
  const int tid = threadIdx.x;
  __syncthreads();
  {
    const int r = tid >> 4, c4 = (tid & 15) * 4;
#pragma unroll
    for (int i = 0; i < 4; i++) {
      const int k = r + 16 * i;
      float4 v = make_float4(0.f, 0.f, 0.f, 0.f);
      if (n0 + c4 < N) v = *(const float4*)&W[(size_t)(k0 + k) * ld + n0 + c4];
      T[(c4 + 0) * 72 + k] = f2bf(v.x); T[(c4 + 1) * 72 + k] = f2bf(v.y);
      T[(c4 + 2) * 72 + k] = f2bf(v.z); T[(c4 + 3) * 72 + k] = f2bf(v.w);
    }
  }
  __syncthreads();
  {
    const int n = tid >> 2, seg = (tid & 3) * 16;
    if (n0 + n < N) {
      u32x4 a = *(const u32x4*)&T[n * 72 + seg], b = *(const u32x4*)&T[n * 72 + seg + 8];
      *(u32x4*)&WT[(size_t)(n0 + n) * K + k0 + seg] = a;
      *(u32x4*)&WT[(size_t)(n0 + n) * K + k0 + seg + 8] = b;
    }
  }
}
__device__ void phaseP0(const Params& p, char* smem) {
  if (blockIdx.x == 0 && threadIdx.x < 64) p.cnt[threadIdx.x] = 0;
  constexpr int NTI = 57 * 16, NTO = 16 * 16;
  for (int u = blockIdx.x; u < NTI + NTO; u += gridDim.x) {
    if (u < NTI) transpose_tile(p.w_in, INC, INC, (u % 16) * 64, (u / 16) * 64, p.WinT, DM, smem);
    else { const int v = u - NTI; transpose_tile(p.w_out, DM, DM, (v % 16) * 64, (v / 16) * 64, p.WoutT, DM, smem); }
  }
  const size_t n4 = (size_t)NTOK * DM / 4;
  for (size_t i = blockIdx.x * (size_t)256 + threadIdx.x; i < n4; i += (size_t)gridDim.x * 256) {
    float4 v = ((const float4*)p.x)[i];
    uint2 o; o.x = pack2(v.x, v.y); o.y = pack2(v.z, v.w);
    ((uint2*)p.XB)[i] = o;
  }
}

__device__ void phaseA(const Params& p, char* smem) {
  xcd_queue_run(p.bar + QW_BASE, 464, smem + 2 * GEMM_SMEM + 800, [&](int j, int q) {
    const int pj = j >> 1, odd = j & 1;
    int mt, nt;
    if (q < 384) { mt = q / 3; nt = 7 * pj + odd * 4 + q % 3; }
    else if (q < 448) { mt = odd * 64 + (q - 384); nt = 7 * pj + 3; }
    else { mt = 16 * j + (q - 448); nt = 28; }
    const int m0 = mt * 128, n0 = nt * 128;
    const u16* xa = p.XB + (size_t)m0 * DM;
    auto rowf = [&](int r) { return (const void*)(xa + (size_t)r * DM); };
    auto colf = [&](int c) { int n = n0 + c; if (n > INC - 1) n = INC - 1; return (const void*)(p.WinT + (size_t)n * DM); };
    auto epi = [&](f32x4 (&acc)[4][4], int mb, int nb) {
#pragma unroll
      for (int mi = 0; mi < 4; mi++)
#pragma unroll
        for (int ni = 0; ni < 4; ni++) {
          const int m = m0 + mb + mi * 16, n = n0 + nb + ni * 16;
          f32x4 v = acc[mi][ni];
          if (n >= INC) continue;
          if (n >= 512 && n < 1024) {
            const int c = n - 512;
            float lf[4], kf[4];
#pragma unroll
            for (int r = 0; r < 4; r++) {
              float lbv = sigmoidf(p.lb[c + r] - p.lb[512 + c + r]);
              float sg = sigmoidf(v[r]);
              float f = lbv + (1.f - lbv) * sg;
              lf[r] = __logf(f);
              kf[r] = (1.f - lbv) * (1.f - sg);
            }
            *(float4*)&p.LF[(size_t)m * 512 + c] = make_float4(lf[0], lf[1], lf[2], lf[3]);
            uint2 o; o.x = pack2(kf[0], kf[1]); o.y = pack2(kf[2], kf[3]);
            *(uint2*)&p.P[(size_t)m * INC + n] = o;
          } else if (n >= 3072 && n < 3088) {
            *(float4*)&p.GA[(size_t)m * 16 + (n - 3072)] = make_float4(v[0], v[1], v[2], v[3]);
          } else {
            if (n < 512) { v *= 0.08838834764831845f; }
            else if ((n >= 1536 && n < 2048) || n >= 3088) {
#pragma unroll
              for (int r = 0; r < 4; r++) v[r] = siluf(v[r]);
            } else if (n >= 2048 && n < 2304) { v *= 0.125f; }
            uint2 o; o.x = pack2(v[0], v[1]); o.y = pack2(v[2], v[3]);
            *(uint2*)&p.P[(size_t)m * INC + n] = o;
          }
        }
    };
    gemm_tile<true, true>(smem, DM, rowf, colf, INC, epi);
  });
}

__device__ __forceinline__ float dpp_scan_add(float x) {
  int xi;
  xi = __builtin_amdgcn_update_dpp(0, __float_as_int(x), 0x111, 0xf, 0xf, true); x += __int_as_float(xi);
  xi = __builtin_amdgcn_update_dpp(0, __float_as_int(x), 0x112, 0xf, 0xf, true); x += __int_as_float(xi);
  xi = __builtin_amdgcn_update_dpp(0, __float_as_int(x), 0x114, 0xf, 0xf, true); x += __int_as_float(xi);
  xi = __builtin_amdgcn_update_dpp(0, __float_as_int(x), 0x118, 0xf, 0xf, true); x += __int_as_float(xi);
  return x;
}


__device__ __forceinline__ float dpp_row_bcast15(float x) {
  return __int_as_float(__builtin_amdgcn_update_dpp(0, __float_as_int(x), 0x15F, 0xf, 0xf, false));
}
__device__ __forceinline__ float dpp_row_sum(float x) {
  x += __int_as_float(__builtin_amdgcn_update_dpp(0, __float_as_int(x), 0x128, 0xf, 0xf, false));
  x += __int_as_float(__builtin_amdgcn_update_dpp(0, __float_as_int(x), 0x124, 0xf, 0xf, false));
  x += __int_as_float(__builtin_amdgcn_update_dpp(0, __float_as_int(x), 0x122, 0xf, 0xf, false));
  x += __int_as_float(__builtin_amdgcn_update_dpp(0, __float_as_int(x), 0x121, 0xf, 0xf, false));
  return x;
}

#define STAGE() do { __builtin_amdgcn_sched_barrier(0); asm volatile("s_nop 15\n\ts_nop 15" ::: "memory"); __builtin_amdgcn_sched_barrier(0); } while (0)
template <int DK, bool HG, int MODE>
__device__ void recur_unit(const Params& p, char* smem, int b, int h, char* img, int nstart, int nstep) {
  constexpr int IMG = (2 * 16 * (DK + 8) + DK * 20 + 128 * 20) * 2 + DK * 4;
  constexpr int NIM = (IMG + 4095) / 4096;
  constexpr int KPT = DK / 16;
  constexpr int NKS = DK / 32;
  constexpr int NKT = DK / 16;
  constexpr int LQ = DK + 8;
  u16* Qt = (u16*)smem;
  u16* Kt = Qt + 16 * LQ;
  u16* KhT = Kt + 16 * LQ;
  u16* VT = KhT + DK * 20;
  float* Gch = (float*)(VT + 128 * 20);
  float* SS = Gch + DK;
  float* Wa = SS + 64;
  u16* GT = (u16*)(smem + 20480);
  u16* OT = (u16*)(smem + 24832);

  const int tid = threadIdx.x, lane = tid & 63, w = tid >> 6, l15 = lane & 15, kg = lane >> 4;
  const int t = tid & 15, kgp = tid >> 4, k0 = kgp * KPT;
  const int qcol = HG ? (h * 128) : (2048 + h * 64);
  const int kcol = HG ? (512 + h * 128) : (2304 + h * 64);
  const int vcol = HG ? (1024 + h * 128) : (2560 + h * 128);
  const int gcol = HG ? (1536 + h * 128) : (3088 + h * 128);
  const int ocol = HG ? (h * 128) : (512 + h * 128);
  const float* gain = HG ? p.norm_h : p.norm_g;

  float ba[KPT];
  if (!HG && MODE == 1) {
    __syncthreads();
    for (int i = tid; i < 16 * 64; i += 256) Wa[i] = p.w_a2[(i >> 6) * 256 + h * 64 + (i & 63)];
#pragma unroll
    for (int i = 0; i < KPT; i++) ba[i] = p.b_a[h * 64 + k0 + i];
    __syncthreads();
  }
  const float g0 = gain[h * 128 + w * 32 + l15], g1 = gain[h * 128 + w * 32 + 16 + l15];

  f32x4 S[NKT][2];
#pragma unroll
  for (int i = 0; i < NKT; i++) { S[i][0] = f32x4{0, 0, 0, 0}; S[i][1] = f32x4{0, 0, 0, 0}; }

  float4 pl[4];
  uint4 pq, pk, pv;
  u16 psg[8];
  u32x4 imA[NIM], imB[NIM];
  u16 psgB[8];
  auto prefetch = [&](int n, u32x4 (&im)[NIM], u16 (&psg)[8]) {
    if (MODE == 2) {
      const char* src = img + (size_t)n * IMG;
#pragma unroll
      for (int i = 0; i < NIM; i++) if (tid * 16 + 4096 * i < IMG) im[i] = *(const u32x4*)(src + tid * 16 + 4096 * i);
      {
        const u32x4 g = *(const u32x4*)(p.P + ((size_t)b * SEQ + n * 16 + (tid >> 4)) * INC + gcol + (tid & 15) * 8);
        psg[0] = (u16)(g[0] & 0xffff); psg[1] = (u16)(g[0] >> 16); psg[2] = (u16)(g[1] & 0xffff); psg[3] = (u16)(g[1] >> 16);
        psg[4] = (u16)(g[2] & 0xffff); psg[5] = (u16)(g[2] >> 16); psg[6] = (u16)(g[3] & 0xffff); psg[7] = (u16)(g[3] >> 16);
      }
      return;
    }
    const size_t tok = (size_t)b * SEQ + n * 16 + t;
    const u16* prow = p.P + tok * INC;
    if (HG) {
      pl[0] = *(const float4*)&p.LF[tok * 512 + h * 128 + k0];
      pl[1] = *(const float4*)&p.LF[tok * 512 + h * 128 + k0 + 4];
      pq = *(const uint4*)&prow[qcol + k0];
      pk = *(const uint4*)&prow[kcol + k0];
    } else {
#pragma unroll
      for (int i = 0; i < 4; i++) pl[i] = *(const float4*)&p.GA[tok * 16 + 4 * i];
      uint2 a = *(const uint2*)&prow[qcol + k0];
      uint2 c = *(const uint2*)&prow[kcol + k0];
      pq.x = a.x; pq.y = a.y; pk.x = c.x; pk.y = c.y;
    }
    pv = *(const uint4*)&prow[vcol + kgp * 8];
  };

  constexpr int PFD = (MODE == 2) ? 2 : 1;
  auto step = [&](int n, u32x4 (&im)[NIM], u16 (&psg)[8]) {
    float sgate[8];
    if (MODE == 2) {
#pragma unroll
      for (int i = 0; i < NIM; i++) if (tid * 16 + 4096 * i < IMG) *(u32x4*)(smem + tid * 16 + 4096 * i) = im[i];
      {
        u32x4 g;
        g[0] = (unsigned)psg[0] | ((unsigned)psg[1] << 16); g[1] = (unsigned)psg[2] | ((unsigned)psg[3] << 16);
        g[2] = (unsigned)psg[4] | ((unsigned)psg[5] << 16); g[3] = (unsigned)psg[6] | ((unsigned)psg[7] << 16);
        *(u32x4*)&GT[(tid >> 4) * 136 + (tid & 15) * 8] = g;
      }
      __builtin_amdgcn_sched_barrier(0);
      if (n + PFD * nstep < SEQ / 16) prefetch(n + PFD * nstep, im, psg);
      __builtin_amdgcn_sched_barrier(0);
    } else {
    float lg[KPT], qv[KPT], kv[KPT];
    if (HG) {
      lg[0] = pl[0].x; lg[1] = pl[0].y; lg[2] = pl[0].z; lg[3] = pl[0].w;
      if (KPT > 4) { lg[4 % KPT] = pl[1].x; lg[5 % KPT] = pl[1].y; lg[6 % KPT] = pl[1].z; lg[7 % KPT] = pl[1].w; }
    } else {
      float ga[16] = {pl[0].x, pl[0].y, pl[0].z, pl[0].w, pl[1].x, pl[1].y, pl[1].z, pl[1].w,
                      pl[2].x, pl[2].y, pl[2].z, pl[2].w, pl[3].x, pl[3].y, pl[3].z, pl[3].w};
      float z[4] = {ba[0], ba[1], ba[2], ba[3]};
#pragma unroll
      for (int r = 0; r < 16; r++) {
        float4 wv = *(const float4*)&Wa[r * 64 + k0];
        z[0] += ga[r] * wv.x; z[1] += ga[r] * wv.y; z[2] += ga[r] * wv.z; z[3] += ga[r] * wv.w;
      }
#pragma unroll
      for (int i = 0; i < 4; i++) {
        float sp = fmaxf(-z[i], 0.f) + __logf(1.f + __expf(-fabsf(z[i])));
        lg[i] = -sp * (1.f / 16.f);
      }
    }
    {
      unsigned qq[4] = {pq.x, pq.y, pq.z, pq.w}, kk[4] = {pk.x, pk.y, pk.z, pk.w};
#pragma unroll
      for (int i = 0; i < KPT / 2; i++) {
        qv[2 * i] = bflo(qq[i]); qv[2 * i + 1] = bfhi(qq[i]);
        kv[2 * i] = bflo(kk[i]); kv[2 * i + 1] = bfhi(kk[i]);
      }
    }
    {
      unsigned vv[4] = {pv.x, pv.y, pv.z, pv.w};
#pragma unroll
      for (int i = 0; i < 4; i++) {
        VT[(kgp * 8 + 2 * i) * 20 + t] = (u16)(vv[i] & 0xffff);
        VT[(kgp * 8 + 2 * i + 1) * 20 + t] = (u16)(vv[i] >> 16);
      }
    }
    __builtin_amdgcn_sched_barrier(0);
    if (n + nstep < SEQ / 16) prefetch(n + nstep, im, psg);
    __builtin_amdgcn_sched_barrier(0);
    float qt[KPT], kt[KPT], kh[KPT];
#pragma unroll
    for (int i = 0; i < KPT; i++) {
      float bcum = dpp_scan_add(lg[i]);
      float bl = dpp_row_bcast15(bcum);
      qt[i] = qv[i] * __expf(bcum);
      kt[i] = kv[i] * __expf(-bcum);
      kh[i] = kv[i] * __expf(bl - bcum);
      if (t == 15) Gch[k0 + i] = __expf(bl);
      KhT[(k0 + i) * 20 + t] = f2bf(kh[i]);
    }
    if (KPT == 8) {
      uint4 a, c;
      a.x = pack2(qt[0], qt[1]); a.y = pack2(qt[2], qt[3]); a.z = pack2(qt[4 % KPT], qt[5 % KPT]); a.w = pack2(qt[6 % KPT], qt[7 % KPT]);
      c.x = pack2(kt[0], kt[1]); c.y = pack2(kt[2], kt[3]); c.z = pack2(kt[4 % KPT], kt[5 % KPT]); c.w = pack2(kt[6 % KPT], kt[7 % KPT]);
      *(uint4*)&Qt[t * LQ + k0] = a;
      *(uint4*)&Kt[t * LQ + k0] = c;
    } else {
      uint2 a, c;
      a.x = pack2(qt[0], qt[1]); a.y = pack2(qt[2], qt[3]);
      c.x = pack2(kt[0], kt[1]); c.y = pack2(kt[2], kt[3]);
      *(uint2*)&Qt[t * LQ + k0] = a;
      *(uint2*)&Kt[t * LQ + k0] = c;
    }
    }
    __syncthreads();
    if (MODE == 1) {
      char* dst = img + (size_t)n * IMG;
#pragma unroll
      for (int i = 0; i < NIM; i++) if (tid * 16 + 4096 * i < IMG) *(u32x4*)(dst + tid * 16 + 4096 * i) = *(const u32x4*)(smem + tid * 16 + 4096 * i);
      __syncthreads();
      return;
    }

    STAGE();
    f32x4 sc = f32x4{0, 0, 0, 0};
    bf16x8 qf[NKS];
#pragma unroll
    for (int st = 0; st < NKS; st++) {
      bf16x4 q0 = *(const bf16x4*)&Qt[l15 * LQ + 32 * st + kg * 4];
      bf16x4 q1 = *(const bf16x4*)&Qt[l15 * LQ + 32 * st + 16 + kg * 4];
      bf16x4 c0 = *(const bf16x4*)&Kt[l15 * LQ + 32 * st + kg * 4];
      bf16x4 c1 = *(const bf16x4*)&Kt[l15 * LQ + 32 * st + 16 + kg * 4];
      qf[st] = bf16x8{q0[0], q0[1], q0[2], q0[3], q1[0], q1[1], q1[2], q1[3]};
      bf16x8 kf = bf16x8{c0[0], c0[1], c0[2], c0[3], c1[0], c1[1], c1[2], c1[3]};
      sc = __builtin_amdgcn_mfma_f32_16x16x32_bf16(kf, qf[st], sc, 0, 0, 0);
    }
    STAGE();
#pragma unroll
    for (int r = 0; r < 4; r++) if (kg * 4 + r > l15) sc[r] = 0.f;
    bf16x4 pA;
    {
      unsigned a = pack2(sc[0], sc[1]), c = pack2(sc[2], sc[3]);
      pA = bf16x4{(short)(a & 0xffff), (short)(a >> 16), (short)(c & 0xffff), (short)(c >> 16)};
    }
    bf16x4 vf[2];
    f32x4 o[2], oin[2];
    bf16x8 sbv[2][NKS];
#pragma unroll
    for (int vt = 0; vt < 2; vt++) {
      vf[vt] = *(const bf16x4*)&VT[(w * 32 + vt * 16 + l15) * 20 + kg * 4];
#pragma unroll
      for (int st = 0; st < NKS; st++) {
        unsigned s0 = pack2(S[2 * st][vt][0], S[2 * st][vt][1]), s1 = pack2(S[2 * st][vt][2], S[2 * st][vt][3]);
        unsigned s2 = pack2(S[2 * st + 1][vt][0], S[2 * st + 1][vt][1]), s3 = pack2(S[2 * st + 1][vt][2], S[2 * st + 1][vt][3]);
        sbv[vt][st] = bf16x8{(short)(s0 & 0xffff), (short)(s0 >> 16), (short)(s1 & 0xffff), (short)(s1 >> 16),
                           (short)(s2 & 0xffff), (short)(s2 >> 16), (short)(s3 & 0xffff), (short)(s3 >> 16)};
      }
    }
    STAGE();
#pragma unroll
    for (int vt = 0; vt < 2; vt++) {
      o[vt] = __builtin_amdgcn_mfma_f32_16x16x16bf16_1k(pA, vf[vt], f32x4{0, 0, 0, 0}, 0, 0, 0);
      oin[vt] = f32x4{0, 0, 0, 0};
#pragma unroll
      for (int st = 0; st < NKS; st++) oin[vt] = __builtin_amdgcn_mfma_f32_16x16x32_bf16(qf[st], sbv[vt][st], oin[vt], 0, 0, 0);
    }
    STAGE();
    bf16x4 khf[NKT];
#pragma unroll
    for (int kt2 = 0; kt2 < NKT; kt2++) {
      khf[kt2] = *(const bf16x4*)&KhT[(16 * kt2 + l15) * 20 + kg * 4];
      float4 g4 = *(const float4*)&Gch[16 * kt2 + kg * 4];
      f32x4 gv = f32x4{g4.x, g4.y, g4.z, g4.w};
      S[kt2][0] *= gv; S[kt2][1] *= gv;
    }
    STAGE();
#pragma unroll
    for (int kt2 = 0; kt2 < NKT; kt2++) {
#pragma unroll
      for (int vt = 0; vt < 2; vt++)
        S[kt2][vt] = __builtin_amdgcn_mfma_f32_16x16x16bf16_1k(khf[kt2], vf[vt], S[kt2][vt], 0, 0, 0);
    }
    STAGE();
    float ss[4];
#pragma unroll
    for (int r = 0; r < 4; r++) {
      o[0][r] += oin[0][r]; o[1][r] += oin[1][r];
      float s = o[0][r] * o[0][r] + o[1][r] * o[1][r];
      s = dpp_row_sum(s);
      ss[r] = s;
    }
    if (l15 == 0) *(float4*)&SS[w * 16 + kg * 4] = make_float4(ss[0], ss[1], ss[2], ss[3]);
    __syncthreads();
    {
      float4 a0 = *(const float4*)&SS[0 * 16 + kg * 4], a1 = *(const float4*)&SS[1 * 16 + kg * 4];
      float4 a2 = *(const float4*)&SS[2 * 16 + kg * 4], a3 = *(const float4*)&SS[3 * 16 + kg * 4];
      float tot[4] = {a0.x + a1.x + a2.x + a3.x, a0.y + a1.y + a2.y + a3.y, a0.z + a1.z + a2.z + a3.z, a0.w + a1.w + a2.w + a3.w};
#pragma unroll
      for (int r = 0; r < 4; r++) {
        const float rstd = rsqrtf(tot[r] * (1.f / 128.f) + LN_EPS);
        const int li = (kg * 4 + r) * 136 + w * 32 + l15;
        sgate[r] = bf2f(GT[li]); sgate[4 + r] = bf2f(GT[li + 16]);
        OT[li] = f2bf(o[0][r] * rstd * g0 * sgate[r]);
        OT[li + 16] = f2bf(o[1][r] * rstd * g1 * sgate[4 + r]);
      }
    }
    __syncthreads();
    *(u32x4*)(p.O + ((size_t)b * SEQ + n * 16 + (tid >> 4)) * DM + ocol + (tid & 15) * 8) = *(const u32x4*)&OT[(tid >> 4) * 136 + (tid & 15) * 8];
  };
  if (MODE == 2) {
    prefetch(0, imA, psg);
    prefetch(1, imB, psgB);
    for (int n = 0; n < SEQ / 16; n += 2) { step(n, imA, psg); step(n + 1, imB, psgB); }
  } else {
    prefetch(nstart, imA, psg);
    for (int n = nstart; n < SEQ / 16; n += nstep) step(n, imA, psg);
  }
}

constexpr size_t IMGH_SZ = (2 * 16 * 136 + 128 * 20 + 128 * 20) * 2 + 128 * 4;
constexpr size_t IMGG_SZ = (2 * 16 * 72 + 64 * 20 + 128 * 20) * 2 + 64 * 4;
__device__ void phaseB0(const Params& p, char* smem) {
  const int nparts = gridDim.x >> 6;
  if ((int)blockIdx.x >= nparts * 64) return;
  const int u = blockIdx.x & 63, part = blockIdx.x >> 6;
  __syncthreads();
  if (u < 32) recur_unit<128, true, 1>(p, smem, u >> 2, u & 3, p.IMGH + (size_t)u * 128 * IMGH_SZ, part, nparts);
  else recur_unit<64, false, 1>(p, smem, (u - 32) >> 2, u & 3, p.IMGG + (size_t)(u - 32) * 128 * IMGG_SZ, part, nparts);
}
__device__ void phaseB(const Params& p, char* smem) {
  if (blockIdx.x >= 64) {
    const int nb = gridDim.x - 64;
    for (int u = blockIdx.x - 64; u < NEXP * 2 * 128; u += nb) {
      const int tile = u & 127, mat = (u >> 7) & 1, e = u >> 8;
      const float* W = (mat ? p.w_up : p.w_gate) + (size_t)e * DM * DEXP;
      u16* WT = (mat ? p.WuT : p.WgT) + (size_t)e * DEXP * DM;
      transpose_tile(W, DEXP, DEXP, (tile & 15) * 64, (tile >> 4) * 64, WT, DM, smem);
    }
    return;
  }
  for (int u = blockIdx.x; u < 64; u += gridDim.x) {
    __syncthreads();
    if (u < 32) recur_unit<128, true, 2>(p, smem, u >> 2, u & 3, p.IMGH + (size_t)u * 128 * IMGH_SZ, 0, 1);
    else recur_unit<64, false, 2>(p, smem, (u - 32) >> 2, u & 3, p.IMGG + (size_t)(u - 32) * 128 * IMGG_SZ, 0, 1);
  }
}

__device__ void phaseC(const Params& p, char* smem) {
  xcd_queue_run(p.bar + QW_BASE + 512, 128, smem + 2 * GEMM_SMEM + 800, [&](int j, int q) {
    const int mt = q, nt = j;
    const int m0 = mt * 128, n0 = nt * 128;
    auto rowf = [&](int r) { return (const void*)(p.O + (size_t)(m0 + r) * DM); };
    auto colf = [&](int c) { return (const void*)(p.WoutT + (size_t)(n0 + c) * DM); };
    auto epi = [&](f32x4 (&acc)[4][4], int mb, int nb) {
#pragma unroll
      for (int mi = 0; mi < 4; mi++)
#pragma unroll
        for (int ni = 0; ni < 4; ni++) {
          const size_t idx = (size_t)(m0 + mb + mi * 16) * DM + n0 + nb + ni * 16;
          float4 xv = *(const float4*)&p.x[idx];
          f32x4 v = acc[mi][ni];
          *(float4*)&p.Z[idx] = make_float4(ALPHA * xv.x + v[0], ALPHA * xv.y + v[1], ALPHA * xv.z + v[2], ALPHA * xv.w + v[3]);
        }
    };
    gemm_tile<true, true>(smem, DM, rowf, colf, DM, epi);
  });
}

__device__ __forceinline__ float wave_sum(float v) {
  v = dpp_row_sum(v);
  const int vi = __float_as_int(v);
  return (__int_as_float(__builtin_amdgcn_readlane(vi, 0)) + __int_as_float(__builtin_amdgcn_readlane(vi, 16))) +
         (__int_as_float(__builtin_amdgcn_readlane(vi, 32)) + __int_as_float(__builtin_amdgcn_readlane(vi, 48)));
}

__device__ __forceinline__ void ln_row(const float* zin, const float* g, const float* bb, int lane, float4 (&o)[4]) {
  float4 v[4];
  float s = 0.f;
#pragma unroll
  for (int i = 0; i < 4; i++) { v[i] = *(const float4*)&zin[lane * 4 + 256 * i]; s += v[i].x + v[i].y + v[i].z + v[i].w; }
  const float mu = wave_sum(s) * (1.f / 1024.f);
  float q = 0.f;
#pragma unroll
  for (int i = 0; i < 4; i++) {
    v[i].x -= mu; v[i].y -= mu; v[i].z -= mu; v[i].w -= mu;
    q += v[i].x * v[i].x + v[i].y * v[i].y + v[i].z * v[i].z + v[i].w * v[i].w;
  }
  const float rstd = rsqrtf(wave_sum(q) * (1.f / 1024.f) + LN_EPS);
#pragma unroll
  for (int i = 0; i < 4; i++) {
    float4 gg = *(const float4*)&g[lane * 4 + 256 * i], b4 = *(const float4*)&bb[lane * 4 + 256 * i];
    o[i] = make_float4(v[i].x * rstd * gg.x + b4.x, v[i].y * rstd * gg.y + b4.y, v[i].z * rstd * gg.z + b4.z, v[i].w * rstd * gg.w + b4.w);
  }
}

__device__ void phaseD(const Params& p, char* smem) {
  float* part = (float*)smem;
  float* logits = part + 4 * 16 * 80;
  const int tid = threadIdx.x, lane = tid & 63, w = tid >> 6, l15 = lane & 15, kg = lane >> 4;
  for (int g = blockIdx.x; g < NTOK / 16; g += gridDim.x) {
    const int row0 = g * 16;
    for (int i = 0; i < 4; i++) {
      const int row = row0 + w * 4 + i;
      float4 o[4];
      ln_row(p.Z + (size_t)row * DM, p.ln1_g, p.ln1_b, lane, o);
#pragma unroll
      for (int j = 0; j < 4; j++) {
        *(float4*)&p.X1[(size_t)row * DM + lane * 4 + 256 * j] = o[j];
        uint2 h; h.x = pack2(o[j].x, o[j].y); h.y = pack2(o[j].z, o[j].w);
        *(uint2*)&p.X1B[(size_t)row * DM + lane * 4 + 256 * j] = h;
      }
    }
    __threadfence();
    __syncthreads();
    __builtin_amdgcn_fence(__ATOMIC_ACQUIRE, "agent");
    f32x4 acc[5];
#pragma unroll
    for (int i = 0; i < 5; i++) acc[i] = f32x4{0, 0, 0, 0};
    const float* xrow = p.X1 + (size_t)(row0 + l15) * DM + 256 * w + 4 * kg;
    for (int it = 0; it < 16; it++) {
      float4 a4 = *(const float4*)&xrow[16 * it];
      const float av[4] = {a4.x, a4.y, a4.z, a4.w};
      const int kb = 256 * w + 16 * it + 4 * kg;
#pragma unroll
      for (int i = 0; i < 4; i++) {
        const float* we = p.w_er + (size_t)(kb + i) * 64 + l15;
#pragma unroll
        for (int nt = 0; nt < 4; nt++)
          acc[nt] = __builtin_amdgcn_mfma_f32_16x16x4f32(av[i], we[16 * nt], acc[nt], 0, 0, 0);
        float wg = (l15 < 8) ? p.w_gr[(size_t)(kb + i) * 8 + l15] : 0.f;
        acc[4] = __builtin_amdgcn_mfma_f32_16x16x4f32(av[i], wg, acc[4], 0, 0, 0);
      }
    }
#pragma unroll
    for (int nt = 0; nt < 5; nt++)
#pragma unroll
      for (int r = 0; r < 4; r++) part[(w * 16 + kg * 4 + r) * 80 + nt * 16 + l15] = acc[nt][r];
    __syncthreads();
    for (int idx = tid; idx < 16 * 72; idx += 256) {
      const int r = idx / 72, c = idx % 72;
      logits[r * 72 + c] = part[(0 * 16 + r) * 80 + c] + part[(1 * 16 + r) * 80 + c] + part[(2 * 16 + r) * 80 + c] + part[(3 * 16 + r) * 80 + c];
    }
    __syncthreads();
    if (tid < 16) {
      const float* L = logits + tid * 72;
      const int tok = row0 + tid;
      float gm = L[64]; int gi = 0;
      for (int i = 1; i < 8; i++) if (L[64 + i] > gm) { gm = L[64 + i]; gi = i; }
      float gs = 0.f;
      for (int i = 0; i < 8; i++) gs += expf(L[64 + i] - gm);
      const float pg = 1.f / gs;
      const float* E = L + gi * 8;
      float em = E[0]; int i1 = 0;
      for (int i = 1; i < 8; i++) if (E[i] > em) { em = E[i]; i1 = i; }
      float e2 = -3.0e38f; int i2 = 0;
      for (int i = 0; i < 8; i++) if (i != i1 && E[i] > e2) { e2 = E[i]; i2 = i; }
      const float p1 = 1.f, p2 = expf(e2 - em);
      const float gt1 = pg * p1 / (p1 + p2), gt2 = pg * p2 / (p1 + p2);
      const int ex1 = gi * 8 + i1, ex2 = gi * 8 + i2;
      const int pos1 = atomicAdd(&p.cnt[ex1], 1);
      const int pos2 = atomicAdd(&p.cnt[ex2], 1);
      p.list_tok[ex1 * CAP + pos1] = tok; p.list_gate[ex1 * CAP + pos1] = gt1;
      p.list_tok[ex2 * CAP + pos2] = tok; p.list_gate[ex2 * CAP + pos2] = gt2;
      p.tok_e[tok * 2] = ex1; p.tok_e[tok * 2 + 1] = ex2;
      p.tok_pos[tok * 2] = pos1; p.tok_pos[tok * 2 + 1] = pos2;
    }
    __syncthreads();
  }
}

__device__ __forceinline__ void moe_prefix(const Params& p, int* s_off, int* s_rb) {
  __syncthreads();
  if (threadIdx.x == 0) {
    int o = 0, r = 0;
    for (int e = 0; e < NEXP; e++) {
      s_off[e] = o; s_rb[e] = r;
      int c = p.cnt[e];
      o += c; r += (c + 127) >> 7;
    }
    s_off[NEXP] = o; s_rb[NEXP] = r;
  }
  __syncthreads();
}

__device__ void phaseE1(const Params& p, char* smem) {
  int* s_off = (int*)(smem + 2 * GEMM_SMEM);
  int* s_rb = s_off + 72;
  moe_prefix(p, s_off, s_rb);
  xcd_queue_run(p.bar + QW_BASE + 1024, s_rb[NEXP], smem + 2 * GEMM_SMEM + 800, [&](int j, int q) {
    const int rbg = q, jt = j;
    int e = 0;
    while (s_rb[e + 1] <= rbg) e++;
    const int rb = rbg - s_rb[e];
    const int cnt = p.cnt[e];
    const int rows = min(128, cnt - rb * 128);
    const int* lt = p.list_tok + e * CAP + rb * 128;
    const int slot0 = s_off[e] + rb * 128;
    const int j0 = jt * 64;
    const u16* wg = p.WgT + (size_t)e * DEXP * DM;
    const u16* wu = p.WuT + (size_t)e * DEXP * DM;
    auto rowf = [&](int r) { int rr = r < rows ? r : 0; return (const void*)(p.X1B + (size_t)lt[rr] * DM); };
    auto colf = [&](int c) { return (const void*)(((c & 32) ? wu : wg) + (size_t)(j0 + (c >> 6) * 32 + (c & 31)) * DM); };
    auto epi = [&](f32x4 (&acc)[4][4], int mb, int nb) {
      const int wn = nb >> 6, kg4 = nb & 63;
#pragma unroll
      for (int mi = 0; mi < 4; mi++) {
        const int r = mb + mi * 16;
        if (r < rows) {
#pragma unroll
          for (int ni = 0; ni < 2; ni++) {
            f32x4 gv = acc[mi][ni], uv = acc[mi][ni + 2];
            uint2 o;
            o.x = pack2(siluf(gv[0]) * uv[0], siluf(gv[1]) * uv[1]);
            o.y = pack2(siluf(gv[2]) * uv[2], siluf(gv[3]) * uv[3]);
            *(uint2*)&p.H[(size_t)(slot0 + r) * DEXP + j0 + wn * 32 + ni * 16 + kg4] = o;
          }
        }
      }
    };
    gemm_tile<true, true>(smem, DM, rowf, colf, DEXP, epi);
  });
}

__device__ void phaseE2(const Params& p, char* smem) {
  int* s_off = (int*)(smem + 2 * GEMM_SMEM);
  int* s_rb = s_off + 72;
  moe_prefix(p, s_off, s_rb);
  xcd_queue_run(p.bar + QW_BASE + 1536, s_rb[NEXP], smem + 2 * GEMM_SMEM + 800, [&](int j, int q) {
    const int rbg = q, nt = j;
    int e = 0;
    while (s_rb[e + 1] <= rbg) e++;
    const int rb = rbg - s_rb[e];
    const int cnt = p.cnt[e];
    const int rows = min(128, cnt - rb * 128);
    const int slot0 = s_off[e] + rb * 128;
    const int n0 = nt * 128;
    const float* wd = p.w_down + (size_t)e * DEXP * DM;
    const float* lg = p.list_gate + e * CAP + rb * 128;
    auto rowf = [&](int r) { int rr = r < rows ? r : 0; return (const void*)(p.H + (size_t)(slot0 + rr) * DEXP); };
    auto colf = [&](int c) { return (const void*)(wd + n0 + c); };
    auto epi = [&](f32x4 (&acc)[4][4], int mb, int nb) {
#pragma unroll
      for (int mi = 0; mi < 4; mi++) {
        const int r = mb + mi * 16;
        if (r < rows) {
          const float gt = lg[r];
#pragma unroll
          for (int ni = 0; ni < 4; ni++) {
            f32x4 v = acc[mi][ni];
            uint2 o; o.x = pack2(gt * v[0], gt * v[1]); o.y = pack2(gt * v[2], gt * v[3]);
            *(uint2*)&p.Y[(size_t)(slot0 + r) * DM + n0 + nb + ni * 16] = o;
          }
        }
      }
    };
    gemm_tile<true, false>(smem, DEXP, rowf, colf, DM, epi);
  });
}

__device__ void phaseF(const Params& p, char* smem) {
  int* s_off = (int*)(smem + 2 * GEMM_SMEM);
  int* s_rb = s_off + 72;
  moe_prefix(p, s_off, s_rb);
  const int tid = threadIdx.x, lane = tid & 63, w = tid >> 6;
  for (int row = blockIdx.x * 4 + w; row < NTOK; row += gridDim.x * 4) {
    const int s0 = s_off[p.tok_e[row * 2]] + p.tok_pos[row * 2];
    const int s1 = s_off[p.tok_e[row * 2 + 1]] + p.tok_pos[row * 2 + 1];
    float4 v[4];
    float s = 0.f;
#pragma unroll
    for (int i = 0; i < 4; i++) {
      const int c = lane * 4 + 256 * i;
      float4 xv = *(const float4*)&p.X1[(size_t)row * DM + c];
      uint2 ya = *(const uint2*)&p.Y[(size_t)s0 * DM + c];
      uint2 yb = *(const uint2*)&p.Y[(size_t)s1 * DM + c];
      v[i].x = ALPHA * xv.x + (bflo(ya.x) + bflo(yb.x));
      v[i].y = ALPHA * xv.y + (bfhi(ya.x) + bfhi(yb.x));
      v[i].z = ALPHA * xv.z + (bflo(ya.y) + bflo(yb.y));
      v[i].w = ALPHA * xv.w + (bfhi(ya.y) + bfhi(yb.y));
      s += v[i].x + v[i].y + v[i].z + v[i].w;
    }
    const float mu = wave_sum(s) * (1.f / 1024.f);
    float q = 0.f;
#pragma unroll
    for (int i = 0; i < 4; i++) {
      v[i].x -= mu; v[i].y -= mu; v[i].z -= mu; v[i].w -= mu;
      q += v[i].x * v[i].x + v[i].y * v[i].y + v[i].z * v[i].z + v[i].w * v[i].w;
    }
    const float rstd = rsqrtf(wave_sum(q) * (1.f / 1024.f) + LN_EPS);
#pragma unroll
    for (int i = 0; i < 4; i++) {
      const int c = lane * 4 + 256 * i;
      float4 gg = *(const float4*)&p.ln2_g[c], b4 = *(const float4*)&p.ln2_b[c];
      *(float4*)&p.out[(size_t)row * DM + c] =
          make_float4(v[i].x * rstd * gg.x + b4.x, v[i].y * rstd * gg.y + b4.y, v[i].z * rstd * gg.z + b4.z, v[i].w * rstd * gg.w + b4.w);
    }
  }
}


#define XB_TMO      128
#define XB_XCNT(j)  (256  + 64 * (j))
#define XB_XSUB(j)  (1280 + 64 * (j))
#define XB_XGEN(j)  (2304 + 64 * (j))
#define XB_TOP      3328
#define XB_TOPGEN   3392
#define XCD_BAR_WORDS 3456
#define XB_SPIN_CAP (1u << 18)
#define LAS __attribute__((address_space(3)))
__device__ __forceinline__ unsigned xb_ld(unsigned* p)              { return __hip_atomic_load(p, __ATOMIC_RELAXED, __HIP_MEMORY_SCOPE_AGENT); }
__device__ __forceinline__ unsigned xb_add(unsigned* p, unsigned v) { return __hip_atomic_fetch_add(p, v, __ATOMIC_RELAXED, __HIP_MEMORY_SCOPE_AGENT); }
__device__ __forceinline__ unsigned xb_xcc_id() { return (unsigned)__builtin_amdgcn_s_getreg((3 << 11) | 20) & 0xFu; }
#define XB_SPIN(cond, bar) do { unsigned _sp = 0; while (cond) { __builtin_amdgcn_s_sleep(1); \
    if ((++_sp & 255u) == 0u) { if (xb_ld(&(bar)[XB_TMO])) break; if (_sp > XB_SPIN_CAP) { atomicAdd(&(bar)[XB_TMO], 1u); break; } } } } while (0)
struct XcdBarrier { unsigned* bar; unsigned x; volatile LAS unsigned* st; };
__device__ __forceinline__ XcdBarrier xcd_barrier_post(unsigned* bar, volatile LAS unsigned* st) {
  XcdBarrier b; b.bar = bar; b.x = xb_xcc_id(); b.st = st;
  if (threadIdx.x == 0) (void)xb_add(&bar[XB_XCNT(b.x)], 1u);
  return b;
}
__device__ __forceinline__ void xcd_barrier_complete(unsigned* bar, unsigned x, unsigned& nloc, unsigned& nx) {
  const unsigned G = gridDim.x * gridDim.y * gridDim.z;
  unsigned sum, cnt, mine, sp = 0u;
  for (;;) {
    sum = 0u; cnt = 0u; mine = 0u;
#pragma unroll
    for (unsigned j = 0; j < 16; ++j) { const unsigned c = xb_ld(&bar[XB_XCNT(j)]); sum += c; cnt += (c > 0u) ? 1u : 0u; mine = (j == x) ? c : mine; }
    if (sum == G) break;
    __builtin_amdgcn_s_sleep(1);
    if ((++sp & 255u) == 0u) { if (xb_ld(&bar[XB_TMO])) break; if (sp > XB_SPIN_CAP) { atomicAdd(&bar[XB_TMO], 1u); break; } }
  }
  nloc = mine > 0u ? mine : 1u; nx = cnt > 0u ? cnt : 1u;
}
__device__ __forceinline__ void xcd_barrier(const XcdBarrier& b) {
  asm volatile("s_waitcnt vmcnt(0)" ::: "memory");
  __syncthreads();
  if (threadIdx.x == 0) {
    unsigned* bar = b.bar;
    __builtin_amdgcn_s_waitcnt(0);
    unsigned nloc = b.st[0], nx = b.st[1];
    if (nloc == 0u) { xcd_barrier_complete(bar, b.x, nloc, nx); b.st[0] = nloc; b.st[1] = nx; }
    const unsigned old = xb_add(&bar[XB_XSUB(b.x)], 1u);
    const unsigned gen = old / nloc;
    if (old + 1u == (gen + 1u) * nloc) {
      __builtin_amdgcn_fence(__ATOMIC_RELEASE, "agent");
      asm volatile("s_waitcnt vmcnt(0)" ::: "memory");
      const unsigned og = xb_add(&bar[XB_TOP], 1u);
      const unsigned tg = og / nx;
      if (og + 1u == (tg + 1u) * nx) xb_add(&bar[XB_TOPGEN], 1u);
      else XB_SPIN(xb_ld(&bar[XB_TOPGEN]) == tg, bar);
      __builtin_amdgcn_fence(__ATOMIC_ACQUIRE, "agent");
      xb_add(&bar[XB_XGEN(b.x)], 1u);
      asm volatile("s_waitcnt vmcnt(0)" ::: "memory");
    } else {
      XB_SPIN(xb_ld(&bar[XB_XGEN(b.x)]) == gen, bar);
      __builtin_amdgcn_fence(__ATOMIC_ACQUIRE, "agent");
      asm volatile("s_waitcnt vmcnt(0)" ::: "memory");
    }
  }
  __syncthreads();
}

constexpr int AUX_OFF = 2 * GEMM_SMEM;
constexpr int SMEM_BYTES = AUX_OFF + 1024;

#if SINGLE
__global__ void __launch_bounds__(256, 2) fwd_megakernel(Params p) {
  extern __shared__ __attribute__((aligned(16))) char smem[];
  cg::grid_group grid = cg::this_grid();
  volatile LAS unsigned* st = (volatile LAS unsigned*)(smem + AUX_OFF + 768);
  if (threadIdx.x < 2) st[threadIdx.x] = 0u;
  __syncthreads();
  XcdBarrier xb = xcd_barrier_post(p.bar, st);
  if (p.use_cg) grid.sync();
  phaseP0(p, smem);
  xcd_barrier(xb);
  phaseA(p, smem);
  xcd_barrier(xb);
  phaseB0(p, smem);
  xcd_barrier(xb);
  phaseB(p, smem);
  xcd_barrier(xb);
  phaseC(p, smem);
  xcd_barrier(xb);
  phaseD(p, smem);
  xcd_barrier(xb);
  phaseE1(p, smem);
  xcd_barrier(xb);
  phaseE2(p, smem);
  xcd_barrier(xb);
  phaseF(p, smem);
}
#else
#define PHASE_KERNEL(NAME, FN)                                             \
  __global__ void __launch_bounds__(256, 2) NAME(Params p) {                  \
    __shared__ __attribute__((aligned(16))) char smem[SMEM_BYTES];         \
    FN(p, smem);                                                           \
  }
PHASE_KERNEL(kA, phaseA)
PHASE_KERNEL(kB, phaseB)
PHASE_KERNEL(kC, phaseC)
PHASE_KERNEL(kD, phaseD)
PHASE_KERNEL(kE1, phaseE1)
PHASE_KERNEL(kE2, phaseE2)
PHASE_KERNEL(kF, phaseF)
#endif

extern "C" void kernel_launch(void* const* d_in, const int* in_sizes, int n_in, void* d_out, int out_size,
                              void* d_ws, size_t ws_size, hipStream_t stream) {
  Params p{};
  p.x = (const float*)d_in[0];
  p.w_in = (const float*)d_in[1];
  p.w_a2 = (const float*)d_in[2];
  p.b_a = (const float*)d_in[3];
  p.lb = (const float*)d_in[4];
  p.norm_h = (const float*)d_in[5];
  p.norm_g = (const float*)d_in[6];
  p.w_out = (const float*)d_in[7];
  p.ln1_g = (const float*)d_in[8];
  p.ln1_b = (const float*)d_in[9];
  p.w_gr = (const float*)d_in[10];
  p.w_er = (const float*)d_in[11];
  p.w_gate = (const float*)d_in[12];
  p.w_up = (const float*)d_in[13];
  p.w_down = (const float*)d_in[14];
  p.ln2_g = (const float*)d_in[15];
  p.ln2_b = (const float*)d_in[16];
  p.out = (float*)d_out;
  char* ws = (char*)d_ws;
  size_t off = 0;
  auto take = [&](size_t bytes) { char* r = ws + off; off += (bytes + 255) & ~(size_t)255; return r; };
  p.P = (u16*)take((size_t)NTOK * INC * 2);
  p.LF = (float*)take((size_t)NTOK * 512 * 4);
  p.GA = (float*)take((size_t)NTOK * 16 * 4);
  p.Z = (float*)take((size_t)NTOK * DM * 4);
  p.O = (u16*)take((size_t)NTOK * DM * 2);
  p.X1 = (float*)take((size_t)NTOK * DM * 4);
  p.X1B = (u16*)take((size_t)NTOK * DM * 2);
  p.cnt = (int*)take(256);
  p.tok_e = (int*)take((size_t)NTOK * 2 * 4);
  p.tok_pos = (int*)take((size_t)NTOK * 2 * 4);
  p.list_tok = (int*)take((size_t)NEXP * CAP * 4);
  p.list_gate = (float*)take((size_t)NEXP * CAP * 4);
  p.bar = (unsigned*)take((XCD_BAR_WORDS + 2048) * 4);
  p.XB = p.O;
  p.WgT = (u16*)take((size_t)NEXP * DEXP * DM * 2);
  p.WuT = (u16*)take((size_t)NEXP * DEXP * DM * 2);
  p.IMGH = (char*)p.X1;
  p.IMGG = (char*)p.Z;
  p.WinT = (u16*)take((size_t)INC * DM * 2);
  p.WoutT = (u16*)take((size_t)DM * DM * 2);
  p.use_cg = 0; p.pad_ = 0;
  p.H = p.P;
  p.Y = p.P + (size_t)32768 * DEXP;

#if SINGLE
  static int grid_blocks = 0;
  if (!grid_blocks) {
    int dev = 0, cus = 0, per_cu = 0;
    hipGetDevice(&dev);
    hipDeviceGetAttribute(&cus, hipDeviceAttributeMultiprocessorCount, dev);
    if (hipFuncSetAttribute((const void*)fwd_megakernel, hipFuncAttributeMaxDynamicSharedMemorySize, SMEM_BYTES) != hipSuccess)
      fprintf(stderr, "hipFuncSetAttribute failed\n");
    hipOccupancyMaxActiveBlocksPerMultiprocessor(&per_cu, fwd_megakernel, 256, SMEM_BYTES);
    if (per_cu > 2) per_cu = 2;
    grid_blocks = cus * per_cu;
  }
  hipMemsetAsync(p.bar, 0, (XCD_BAR_WORDS + 2048) * 4, stream);
  void* args[] = {&p};
  hipError_t e = hipLaunchCooperativeKernel((void*)fwd_megakernel, dim3(grid_blocks), dim3(256), args, SMEM_BYTES, stream);
  if (e != hipSuccess) fprintf(stderr, "cooperative launch failed: %s (grid %d)\n", hipGetErrorString(e), grid_blocks);
#else
  const int G = 512;
  kA<<<G, 256, 0, stream>>>(p);
  kB<<<64, 256, 0, stream>>>(p);
  kC<<<G, 256, 0, stream>>>(p);
  kD<<<G, 256, 0, stream>>>(p);
  kE1<<<G, 256, 0, stream>>>(p);
  kE2<<<G, 256, 0, stream>>>(p);
  kF<<<G, 256, 0, stream>>>(p);
#endif
}
```

```cpp
#include <hip/hip_runtime.h>
#include <hip/hip_cooperative_groups.h>
#include <cstdio>
namespace cg = cooperative_groups;

#ifndef SINGLE
#define SINGLE 1
#endif

typedef unsigned short u16;
typedef __attribute__((ext_vector_type(8))) short bf16x8;
typedef __attribute__((ext_vector_type(4))) short bf16x4;
typedef __attribute__((ext_vector_type(4))) float f32x4;
typedef __bf16 bf16x2_t __attribute__((ext_vector_type(2)));
typedef float f32x2_t __attribute__((ext_vector_type(2)));
typedef unsigned u32x4 __attribute__((ext_vector_type(4)));
typedef unsigned u32x2 __attribute__((ext_vector_type(2)));

constexpr int NTOK = 16384;
constexpr int SEQ = 2048;
constexpr int DM = 1024;
constexpr int INC = 3600;
constexpr int NEXP = 64;
constexpr int DEXP = 512;
constexpr int CAP = 32768;
constexpr float ALPHA = 1.189207115002721f;
constexpr float LN_EPS = 1e-5f;

struct Params {
  const float *x, *w_in, *w_a2, *b_a, *lb, *norm_h, *norm_g, *w_out, *ln1_g, *ln1_b, *w_gr, *w_er,
      *w_gate, *w_up, *w_down, *ln2_g, *ln2_b;
  float* out;
  u16* P;
  float* LF;
  float* GA;
  float* Z;
  u16* O;
  float* X1;
  u16* X1B;
  u16* H;
  u16* Y;
  int* cnt;
  int* tok_e;
  int* tok_pos;
  int* list_tok;
  float* list_gate;
  u16* XB;
  u16* WinT;
  u16* WoutT;
  u16* WgT;
  u16* WuT;
  char* IMGH;
  char* IMGG;
  unsigned* bar;
  int use_cg; int pad_;
};

__device__ __forceinline__ unsigned pack2(float a, float b) {
  f32x2_t f = {a, b};
  bf16x2_t h = __builtin_convertvector(f, bf16x2_t);
  return *(unsigned*)&h;
}
__device__ __forceinline__ u16 f2bf(float a) {
  __bf16 h = (__bf16)a;
  return *(u16*)&h;
}
__device__ __forceinline__ float bf2f(u16 v) { return __uint_as_float(((unsigned)v) << 16); }
__device__ __forceinline__ float bflo(unsigned v) { return __uint_as_float(v << 16); }
__device__ __forceinline__ float bfhi(unsigned v) { return __uint_as_float(v & 0xffff0000u); }
__device__ __forceinline__ float sigmoidf(float x) { return 1.f / (1.f + __expf(-x)); }
__device__ __forceinline__ float siluf(float x) { return x / (1.f + __expf(-x)); }


constexpr int QW_BASE = 3456;
__device__ __forceinline__ unsigned my_xcc_id() { return (unsigned)__builtin_amdgcn_s_getreg((3 << 11) | 20) & 7u; }
template <class F>
__device__ __forceinline__ void xcd_queue_run(unsigned* qwords, int nper, char* smem_aux, F fn) {
  volatile int* slot = (volatile int*)smem_aux;
  const unsigned x = my_xcc_id();
  for (int dj = 0; dj < 8; dj++) {
    const int j = (int)((x + dj) & 7u);
    for (;;) {
      __syncthreads();
      if (threadIdx.x == 0) *slot = (int)__hip_atomic_fetch_add(qwords + 64 * j, 1u, __ATOMIC_RELAXED, __HIP_MEMORY_SCOPE_AGENT);
      __syncthreads();
      const int q = *slot;
      if (q >= nper) break;
      fn(j, q);
    }
  }
}

constexpr int BM = 128, BN = 128, BK = 64, LDT = 64;
constexpr int GEMM_SMEM = (BM + BN) * LDT * 2;

template <bool ABF, bool BBF, class RowF, class ColF, class Epi>
__device__ __forceinline__ void gemm_tile(char* smem, int K, RowF rowptr, ColF colptr, int ldb, Epi epi) {
  u16* As0 = (u16*)smem;
  const int tid = threadIdx.x, lane = tid & 63, w = tid >> 6, wm = w >> 1, wn = w & 1;
  const int l15 = lane & 15, kg = lane >> 4, swz = (l15 >> 1) & 7;
  f32x4 acc[4][4];
#pragma unroll
  for (int i = 0; i < 4; i++)
#pragma unroll
    for (int j = 0; j < 4; j++) acc[i][j] = f32x4{0.f, 0.f, 0.f, 0.f};

  constexpr int NA = ABF ? 4 : 8;
  const int ar0 = ABF ? (tid >> 3) : (tid >> 4);
  const int ac = ABF ? (tid & 7) * 8 : (tid & 15) * 4;
  constexpr int ARS = ABF ? 32 : 16;
  const char* ap[NA];
#pragma unroll
  for (int i = 0; i < NA; i++) ap[i] = (const char*)rowptr(ar0 + ARS * i) + ac * (ABF ? 2 : 4);
  const int bc = tid & 127, kh = tid >> 7;
  const float* bp = BBF ? nullptr : ((const float*)colptr(bc) + (size_t)(kh * 32) * ldb);
  const int br0 = tid >> 3, bcc = (tid & 7) * 8;
  const char* bq[4];
  if (BBF) {
#pragma unroll
    for (int i = 0; i < 4; i++) bq[i] = (const char*)colptr(br0 + 32 * i) + bcc * 2;
  }

  u32x4 ra[NA];
  float rb[BBF ? 1 : 32];
  u32x4 rbb[BBF ? 4 : 1];
  auto gload = [&](int k0) {
#pragma unroll
    for (int i = 0; i < NA; i++) ra[i] = *(const u32x4*)(ap[i] + (size_t)k0 * (ABF ? 2 : 4));
    if (BBF) {
#pragma unroll
      for (int i = 0; i < 4; i++) rbb[BBF ? i : 0] = *(const u32x4*)(bq[i] + (size_t)k0 * 2);
    } else {
      const float* b = bp + (size_t)k0 * ldb;
#pragma unroll
      for (int j = 0; j < 32; j++) rb[BBF ? 0 : j] = b[(size_t)j * ldb];
    }
  };
  auto sstore = [&](int buf) {
    u16* As = As0 + buf * (GEMM_SMEM / 2);
    u16* Bs = As + BM * LDT;
#pragma unroll
    for (int i = 0; i < NA; i++) {
      if (ABF) {
        { const int row = ar0 + ARS * i; *(u32x4*)&As[row * LDT + (((ac >> 3) ^ ((row >> 1) & 7)) << 3)] = ra[i]; }
      } else {
        u32x2 v;
        v[0] = pack2(__uint_as_float(ra[i][0]), __uint_as_float(ra[i][1]));
        v[1] = pack2(__uint_as_float(ra[i][2]), __uint_as_float(ra[i][3]));
        { const int row = ar0 + ARS * i; *(u32x2*)&As[row * LDT + (((ac >> 3) ^ ((row >> 1) & 7)) << 3) + (ac & 4)] = v; }
      }
    }
    if (BBF) {
#pragma unroll
      for (int i = 0; i < 4; i++) { const int row = br0 + 32 * i; *(u32x4*)&Bs[row * LDT + (((bcc >> 3) ^ ((row >> 1) & 7)) << 3)] = rbb[BBF ? i : 0]; }
    } else {
#pragma unroll
      for (int j = 0; j < 4; j++) {
        u32x4 v;
        v[0] = pack2(rb[BBF ? 0 : 8 * j + 0], rb[BBF ? 0 : 8 * j + 1]);
        v[1] = pack2(rb[BBF ? 0 : 8 * j + 2], rb[BBF ? 0 : 8 * j + 3]);
        v[2] = pack2(rb[BBF ? 0 : 8 * j + 4], rb[BBF ? 0 : 8 * j + 5]);
        v[3] = pack2(rb[BBF ? 0 : 8 * j + 6], rb[BBF ? 0 : 8 * j + 7]);
        *(u32x4*)&Bs[bc * LDT + (((kh * 4 + j) ^ ((bc >> 1) & 7)) << 3)] = v;
      }
    }
  };

  gload(0);
  sstore(0);
  __syncthreads();
  int cur = 0;
  for (int k0 = 0; k0 < K; k0 += BK) {
    if (k0 + BK < K) gload(k0 + BK);
    const u16* As = As0 + cur * (GEMM_SMEM / 2);
    const u16* Bs = As + BM * LDT;
    {
      bf16x8 af[2][4], bfr[2][4];
#pragma unroll
      for (int ks = 0; ks < 2; ks++) {
#pragma unroll
        for (int mi = 0; mi < 4; mi++) af[ks][mi] = *(const bf16x8*)&As[(wm * 64 + mi * 16 + l15) * LDT + (((ks * 4 + kg) ^ swz) << 3)];
#pragma unroll
        for (int ni = 0; ni < 4; ni++) bfr[ks][ni] = *(const bf16x8*)&Bs[(wn * 64 + ni * 16 + l15) * LDT + (((ks * 4 + kg) ^ swz) << 3)];
      }
      __builtin_amdgcn_sched_barrier(0);
#pragma unroll
      for (int ks = 0; ks < 2; ks++)
#pragma unroll
        for (int mi = 0; mi < 4; mi++)
#pragma unroll
          for (int ni = 0; ni < 4; ni++)
            acc[mi][ni] = __builtin_amdgcn_mfma_f32_16x16x32_bf16(bfr[ks][ni], af[ks][mi], acc[mi][ni], 0, 0, 0);
      __builtin_amdgcn_sched_barrier(0);
    }
    if (k0 + BK < K) sstore(cur ^ 1);
    __syncthreads();
    cur ^= 1;
  }
  epi(acc, wm * 64 + l15, wn * 64 + kg * 4);
}


__device__ void transpose_tile(const float* W, int ld, int N, int k0, int n0, u16* WT, int K, char* smem) {
  u16* T = (u16*)smem;
  const int tid = threadIdx.x;
  __syncthreads();
  {
    const int r = tid >> 4, c4 = (tid & 15) * 4;
#pragma unroll
    for (int i = 0; i < 4; i++) {
      const int k = r + 16 * i;
      float4 v = make_float4(0.f, 0.f, 0.f, 0.f);
      if (n0 + c4 < N) v = *(const float4*)&W[(size_t)(k0 + k) * ld + n0 + c4];
      T[(c4 + 0) * 72 + k] = f2bf(v.x); T[(c4 + 1) * 72 + k] = f2bf(v.y);
      T[(c4 + 2) * 72 + k] = f2bf(v.z); T[(c4 + 3) * 72 + k] = f2bf(v.w);
    }
  }
  __syncthreads();
  {
    const int n = tid >> 2, seg = (tid & 3) * 16;
    if (n0 + n < N) {
      u32x4 a = *(const u32x4*)&T[n * 72 + seg], b = *(const u32x4*)&T[n * 72 + seg + 8];
      *(u32x4*)&WT[(size_t)(n0 + n) * K + k0 + seg] = a;
      *(u32x4*)&WT[(size_t)(n0 + n) * K + k0 + seg + 8] = b;
    }
  }
}
__device__ void phaseP0(const Params& p, char* smem) {
  if (blockIdx.x == 0 && threadIdx.x < 64) p.cnt[threadIdx.x] = 0;
  constexpr int NTI = 57 * 16, NTO = 16 * 16;
  for (int u = blockIdx.x; u < NTI + NTO; u += gridDim.x) {
    if (u < NTI) transpose_tile(p.w_in, INC, INC, (u % 16) * 64, (u / 16) * 64, p.WinT, DM, smem);
    else { const int v = u - NTI; transpose_tile(p.w_out, DM, DM, (v % 16) * 64, (v / 16) * 64, p.WoutT, DM, smem); }
  }
  const size_t n4 = (size_t)NTOK * DM / 4;
  for (size_t i = blockIdx.x * (size_t)256 + threadIdx.x; i < n4; i += (size_t)gridDim.x * 256) {
    float4 v = ((const float4*)p.x)[i];
    uint2 o; o.x = pack2(v.x, v.y); o.y = pack2(v.z, v.w);
    ((uint2*)p.XB)[i] = o;
  }
}

__device__ void phaseA(const Params& p, char* smem) {
  xcd_queue_run(p.bar + QW_BASE, 464, smem + 2 * GEMM_SMEM + 800, [&](int j, int q) {
    const int pj = j >> 1, odd = j & 1;
    int mt, nt;
    if (q < 384) { mt = q / 3; nt = 7 * pj + odd * 4 + q % 3; }
    else if (q < 448) { mt = odd * 64 + (q - 384); nt = 7 * pj + 3; }
    else { mt = 16 * j + (q - 448); nt = 28; }
    const int m0 = mt * 128, n0 = nt * 128;
    const u16* xa = p.XB + (size_t)m0 * DM;
    auto rowf = [&](int r) { return (const void*)(xa + (size_t)r * DM); };
    auto colf = [&](int c) { int n = n0 + c; if (n > INC - 1) n = INC - 1; return (const void*)(p.WinT + (size_t)n * DM); };
    auto epi = [&](f32x4 (&acc)[4][4], int mb, int nb) {
#pragma unroll
      for (int mi = 0; mi < 4; mi++)
#pragma unroll
        for (int ni = 0; ni < 4; ni++) {
          const int m = m0 + mb + mi * 16, n = n0 + nb + ni * 16;
          f32x4 v = acc[mi][ni];
          if (n >= INC) continue;
          if (n >= 512 && n < 1024) {
            const int c = n - 512;
            float lf[4], kf[4];
#pragma unroll
            for (int r = 0; r < 4; r++) {
              float lbv = sigmoidf(p.lb[c + r] - p.lb[512 + c + r]);
              float sg = sigmoidf(v[r]);
              float f = lbv + (1.f - lbv) * sg;
              lf[r] = __logf(f);
              kf[r] = (1.f - lbv) * (1.f - sg);
            }
            *(float4*)&p.LF[(size_t)m * 512 + c] = make_float4(lf[0], lf[1], lf[2], lf[3]);
            uint2 o; o.x = pack2(kf[0], kf[1]); o.y = pack2(kf[2], kf[3]);
            *(uint2*)&p.P[(size_t)m * INC + n] = o;
          } else if (n >= 3072 && n < 3088) {
            *(float4*)&p.GA[(size_t)m * 16 + (n - 3072)] = make_float4(v[0], v[1], v[2], v[3]);
          } else {
            if (n < 512) { v *= 0.08838834764831845f; }
            else if ((n >= 1536 && n < 2048) || n >= 3088) {
#pragma unroll
              for (int r = 0; r < 4; r++) v[r] = siluf(v[r]);
            } else if (n >= 2048 && n < 2304) { v *= 0.125f; }
            uint2 o; o.x = pack2(v[0], v[1]); o.y = pack2(v[2], v[3]);
            *(uint2*)&p.P[(size_t)m * INC + n] = o;
          }
        }
    };
    gemm_tile<true, true>(smem, DM, rowf, colf, INC, epi);
  });
}

__device__ __forceinline__ float dpp_scan_add(float x) {
  int xi;
  xi = __builtin_amdgcn_update_dpp(0, __float_as_int(x), 0x111, 0xf, 0xf, true); x += __int_as_float(xi);
  xi = __builtin_amdgcn_update_dpp(0, __float_as_int(x), 0x112, 0xf, 0xf, true); x += __int_as_float(xi);
  xi = __builtin_amdgcn_update_dpp(0, __float_as_int(x), 0x114, 0xf, 0xf, true); x += __int_as_float(xi);
  xi = __builtin_amdgcn_update_dpp(0, __float_as_int(x), 0x118, 0xf, 0xf, true); x += __int_as_float(xi);
  return x;
}


__device__ __forceinline__ float dpp_row_bcast15(float x) {
  return __int_as_float(__builtin_amdgcn_update_dpp(0, __float_as_int(x), 0x15F, 0xf, 0xf, false));
}
__device__ __forceinline__ float dpp_row_sum(float x) {
  x += __int_as_float(__builtin_amdgcn_update_dpp(0, __float_as_int(x), 0x128, 0xf, 0xf, false));
  x += __int_as_float(__builtin_amdgcn_update_dpp(0, __float_as_int(x), 0x124, 0xf, 0xf, false));
  x += __int_as_float(__builtin_amdgcn_update_dpp(0, __float_as_int(x), 0x122, 0xf, 0xf, false));
  x += __int_as_float(__builtin_amdgcn_update_dpp(0, __float_as_int(x), 0x121, 0xf, 0xf, false));
  return x;
}

#define STAGE() do { __builtin_amdgcn_sched_barrier(0); asm volatile("s_nop 15\n\ts_nop 15" ::: "memory"); __builtin_amdgcn_sched_barrier(0); } while (0)
template <int DK, bool HG, int MODE>
__device__ void recur_unit(const Params& p, char* smem, int b, int h, char* img, int nstart, int nstep) {
  constexpr int IMG = (2 * 16 * (DK + 8) + DK * 20 + 128 * 20) * 2 + DK * 4;
  constexpr int NIM = (IMG + 4095) / 4096;
  constexpr int KPT = DK / 16;
  constexpr int NKS = DK / 32;
  constexpr int NKT = DK / 16;
  constexpr int LQ = DK + 8;
  u16* Qt = (u16*)smem;
  u16* Kt = Qt + 16 * LQ;
  u16* KhT = Kt + 16 * LQ;
  u16* VT = KhT + DK * 20;
  float* Gch = (float*)(VT + 128 * 20);
  float* SS = Gch + DK;
  float* Wa = SS + 64;
  u16* GT = (u16*)(smem + 20480);
  u16* OT = (u16*)(smem + 24832);

  const int tid = threadIdx.x, lane = tid & 63, w = tid >> 6, l15 = lane & 15, kg = lane >> 4;
  const int t = tid & 15, kgp = tid >> 4, k0 = kgp * KPT;
  const int qcol = HG ? (h * 128) : (2048 + h * 64);
  const int kcol = HG ? (512 + h * 128) : (2304 + h * 64);
  const int vcol = HG ? (1024 + h * 128) : (2560 + h * 128);
  const int gcol = HG ? (1536 + h * 128) : (3088 + h * 128);
  const int ocol = HG ? (h * 128) : (512 + h * 128);
  const float* gain = HG ? p.norm_h : p.norm_g;

  float ba[KPT];
  if (!HG && MODE == 1) {
    __syncthreads();
    for (int i = tid; i < 16 * 64; i += 256) Wa[i] = p.w_a2[(i >> 6) * 256 + h * 64 + (i & 63)];
#pragma unroll
    for (int i = 0; i < KPT; i++) ba[i] = p.b_a[h * 64 + k0 + i];
    __syncthreads();
  }
  const float g0 = gain[h * 128 + w * 32 + l15], g1 = gain[h * 128 + w * 32 + 16 + l15];

  f32x4 S[NKT][2];
#pragma unroll
  for (int i = 0; i < NKT; i++) { S[i][0] = f32x4{0, 0, 0, 0}; S[i][1] = f32x4{0, 0, 0, 0}; }

  float4 pl[4];
  uint4 pq, pk, pv;
  u16 psg[8];
  u32x4 imA[NIM], imB[NIM];
  u16 psgB[8];
  auto prefetch = [&](int n, u32x4 (&im)[NIM], u16 (&psg)[8]) {
    if (MODE == 2) {
      const char* src = img + (size_t)n * IMG;
#pragma unroll
      for (int i = 0; i < NIM; i++) if (tid * 16 + 4096 * i < IMG) im[i] = *(const u32x4*)(src + tid * 16 + 4096 * i);
      {
        const u32x4 g = *(const u32x4*)(p.P + ((size_t)b * SEQ + n * 16 + (tid >> 4)) * INC + gcol + (tid & 15) * 8);
        psg[0] = (u16)(g[0] & 0xffff); psg[1] = (u16)(g[0] >> 16); psg[2] = (u16)(g[1] & 0xffff); psg[3] = (u16)(g[1] >> 16);
        psg[4] = (u16)(g[2] & 0xffff); psg[5] = (u16)(g[2] >> 16); psg[6] = (u16)(g[3] & 0xffff); psg[7] = (u16)(g[3] >> 16);
      }
      return;
    }
    const size_t tok = (size_t)b * SEQ + n * 16 + t;
    const u16* prow = p.P + tok * INC;
    if (HG) {
      pl[0] = *(const float4*)&p.LF[tok * 512 + h * 128 + k0];
      pl[1] = *(const float4*)&p.LF[tok * 512 + h * 128 + k0 + 4];
      pq = *(const uint4*)&prow[qcol + k0];
      pk = *(const uint4*)&prow[kcol + k0];
    } else {
#pragma unroll
      for (int i = 0; i < 4; i++) pl[i] = *(const float4*)&p.GA[tok * 16 + 4 * i];
      uint2 a = *(const uint2*)&prow[qcol + k0];
      uint2 c = *(const uint2*)&prow[kcol + k0];
      pq.x = a.x; pq.y = a.y; pk.x = c.x; pk.y = c.y;
    }
    pv = *(const uint4*)&prow[vcol + kgp * 8];
  };

  constexpr int PFD = (MODE == 2) ? 2 : 1;
  auto step = [&](int n, u32x4 (&im)[NIM], u16 (&psg)[8]) {
    float sgate[8];
    if (MODE == 2) {
#pragma unroll
      for (int i = 0; i < NIM; i++) if (tid * 16 + 4096 * i < IMG) *(u32x4*)(smem + tid * 16 + 4096 * i) = im[i];
      {
        u32x4 g;
        g[0] = (unsigned)psg[0] | ((unsigned)psg[1] << 16); g[1] = (unsigned)psg[2] | ((unsigned)psg[3] << 16);
        g[2] = (unsigned)psg[4] | ((unsigned)psg[5] << 16); g[3] = (unsigned)psg[6] | ((unsigned)psg[7] << 16);
        *(u32x4*)&GT[(tid >> 4) * 136 + (tid & 15) * 8] = g;
      }
      __builtin_amdgcn_sched_barrier(0);
      if (n + PFD * nstep < SEQ / 16) prefetch(n + PFD * nstep, im, psg);
      __builtin_amdgcn_sched_barrier(0);
    } else {
    float lg[KPT], qv[KPT], kv[KPT];
    if (HG) {
      lg[0] = pl[0].x; lg[1] = pl[0].y; lg[2] = pl[0].z; lg[3] = pl[0].w;
      if (KPT > 4) { lg[4 % KPT] = pl[1].x; lg[5 % KPT] = pl[1].y; lg[6 % KPT] = pl[1].z; lg[7 % KPT] = pl[1].w; }
    } else {
      float ga[16] = {pl[0].x, pl[0].y, pl[0].z, pl[0].w, pl[1].x, pl[1].y, pl[1].z, pl[1].w,
                      pl[2].x, pl[2].y, pl[2].z, pl[2].w, pl[3].x, pl[3].y, pl[3].z, pl[3].w};
      float z[4] = {ba[0], ba[1], ba[2], ba[3]};
#pragma unroll
      for (int r = 0; r < 16; r++) {
        float4 wv = *(const float4*)&Wa[r * 64 + k0];
        z[0] += ga[r] * wv.x; z[1] += ga[r] * wv.y; z[2] += ga[r] * wv.z; z[3] += ga[r] * wv.w;
      }
#pragma unroll
      for (int i = 0; i < 4; i++) {
        float sp = fmaxf(-z[i], 0.f) + __logf(1.f + __expf(-fabsf(z[i])));
        lg[i] = -sp * (1.f / 16.f);
      }
    }
    {
      unsigned qq[4] = {pq.x, pq.y, pq.z, pq.w}, kk[4] = {pk.x, pk.y, pk.z, pk.w};
#pragma unroll
      for (int i = 0; i < KPT / 2; i++) {
        qv[2 * i] = bflo(qq[i]); qv[2 * i + 1] = bfhi(qq[i]);
        kv[2 * i] = bflo(kk[i]); kv[2 * i + 1] = bfhi(kk[i]);
      }
    }
    {
      unsigned vv[4] = {pv.x, pv.y, pv.z, pv.w};
#pragma unroll
      for (int i = 0; i < 4; i++) {
        VT[(kgp * 8 + 2 * i) * 20 + t] = (u16)(vv[i] & 0xffff);
        VT[(kgp * 8 + 2 * i + 1) * 20 + t] = (u16)(vv[i] >> 16);
      }
    }
    __builtin_amdgcn_sched_barrier(0);
    if (n + nstep < SEQ / 16) prefetch(n + nstep, im, psg);
    __builtin_amdgcn_sched_barrier(0);
    float qt[KPT], kt[KPT], kh[KPT];
#pragma unroll
    for (int i = 0; i < KPT; i++) {
      float bcum = dpp_scan_add(lg[i]);
      float bl = dpp_row_bcast15(bcum);
      qt[i] = qv[i] * __expf(bcum);
      kt[i] = kv[i] * __expf(-bcum);
      kh[i] = kv[i] * __expf(bl - bcum);
      if (t == 15) Gch[k0 + i] = __expf(bl);
      KhT[(k0 + i) * 20 + t] = f2bf(kh[i]);
    }
    if (KPT == 8) {
      uint4 a, c;
      a.x = pack2(qt[0], qt[1]); a.y = pack2(qt[2], qt[3]); a.z = pack2(qt[4 % KPT], qt[5 % KPT]); a.w = pack2(qt[6 % KPT], qt[7 % KPT]);
      c.x = pack2(kt[0], kt[1]); c.y = pack2(kt[2], kt[3]); c.z = pack2(kt[4 % KPT], kt[5 % KPT]); c.w = pack2(kt[6 % KPT], kt[7 % KPT]);
      *(uint4*)&Qt[t * LQ + k0] = a;
      *(uint4*)&Kt[t * LQ + k0] = c;
    } else {
      uint2 a, c;
      a.x = pack2(qt[0], qt[1]); a.y = pack2(qt[2], qt[3]);
      c.x = pack2(kt[0], kt[1]); c.y = pack2(kt[2], kt[3]);
      *(uint2*)&Qt[t * LQ + k0] = a;
      *(uint2*)&Kt[t * LQ + k0] = c;
    }
    }
    __syncthreads();
    if (MODE == 1) {
      char* dst = img + (size_t)n * IMG;
#pragma unroll
      for (int i = 0; i < NIM; i++) if (tid * 16 + 4096 * i < IMG) *(u32x4*)(dst + tid * 16 + 4096 * i) = *(const u32x4*)(smem + tid * 16 + 4096 * i);
      __syncthreads();
      return;
    }

    STAGE();
    f32x4 sc = f32x4{0, 0, 0, 0};
    bf16x8 qf[NKS];
#pragma unroll
    for (int st = 0; st < NKS; st++) {
      bf16x4 q0 = *(const bf16x4*)&Qt[l15 * LQ + 32 * st + kg * 4];
      bf16x4 q1 = *(const bf16x4*)&Qt[l15 * LQ + 32 * st + 16 + kg * 4];
      bf16x4 c0 = *(const bf16x4*)&Kt[l15 * LQ + 32 * st + kg * 4];
      bf16x4 c1 = *(const bf16x4*)&Kt[l15 * LQ + 32 * st + 16 + kg * 4];
      qf[st] = bf16x8{q0[0], q0[1], q0[2], q0[3], q1[0], q1[1], q1[2], q1[3]};
      bf16x8 kf = bf16x8{c0[0], c0[1], c0[2], c0[3], c1[0], c1[1], c1[2], c1[3]};
      sc = __builtin_amdgcn_mfma_f32_16x16x32_bf16(kf, qf[st], sc, 0, 0, 0);
    }
    STAGE();
#pragma unroll
    for (int r = 0; r < 4; r++) if (kg * 4 + r > l15) sc[r] = 0.f;
    bf16x4 pA;
    {
      unsigned a = pack2(sc[0], sc[1]), c = pack2(sc[2], sc[3]);
      pA = bf16x4{(short)(a & 0xffff), (short)(a >> 16), (short)(c & 0xffff), (short)(c >> 16)};
    }
    bf16x4 vf[2];
    f32x4 o[2], oin[2];
    bf16x8 sbv[2][NKS];
#pragma unroll
    for (int vt = 0; vt < 2; vt++) {
      vf[vt] = *(const bf16x4*)&VT[(w * 32 + vt * 16 + l15) * 20 + kg * 4];
#pragma unroll
      for (int st = 0; st < NKS; st++) {
        unsigned s0 = pack2(S[2 * st][vt][0], S[2 * st][vt][1]), s1 = pack2(S[2 * st][vt][2], S[2 * st][vt][3]);
        unsigned s2 = pack2(S[2 * st + 1][vt][0], S[2 * st + 1][vt][1]), s3 = pack2(S[2 * st + 1][vt][2], S[2 * st + 1][vt][3]);
        sbv[vt][st] = bf16x8{(short)(s0 & 0xffff), (short)(s0 >> 16), (short)(s1 & 0xffff), (short)(s1 >> 16),
                           (short)(s2 & 0xffff), (short)(s2 >> 16), (short)(s3 & 0xffff), (short)(s3 >> 16)};
      }
    }
    STAGE();
#pragma unroll
    for (int vt = 0; vt < 2; vt++) {
      o[vt] = __builtin_amdgcn_mfma_f32_16x16x16bf16_1k(pA, vf[vt], f32x4{0, 0, 0, 0}, 0, 0, 0);
      oin[vt] = f32x4{0, 0, 0, 0};
#pragma unroll
      for (int st = 0; st < NKS; st++) oin[vt] = __builtin_amdgcn_mfma_f32_16x16x32_bf16(qf[st], sbv[vt][st], oin[vt], 0, 0, 0);
    }
    STAGE();
    bf16x4 khf[NKT];
#pragma unroll
    for (int kt2 = 0; kt2 < NKT; kt2++) {
      khf[kt2] = *(const bf16x4*)&KhT[(16 * kt2 + l15) * 20 + kg * 4];
      float4 g4 = *(const float4*)&Gch[16 * kt2 + kg * 4];
      f32x4 gv = f32x4{g4.x, g4.y, g4.z, g4.w};
      S[kt2][0] *= gv; S[kt2][1] *= gv;
    }
    STAGE();
#pragma unroll
    for (int kt2 = 0; kt2 < NKT; kt2++) {
#pragma unroll
      for (int vt = 0; vt < 2; vt++)
        S[kt2][vt] = __builtin_amdgcn_mfma_f32_16x16x16bf16_1k(khf[kt2], vf[vt], S[kt2][vt], 0, 0, 0);
    }
    STAGE();
    float ss[4];
#pragma unroll
    for (int r = 0; r < 4; r++) {
      o[0][r] += oin[0][r]; o[1][r] += oin[1][r];
      float s = o[0][r] * o[0][r] + o[1][r] * o[1][r];
      s = dpp_row_sum(s);
      ss[r] = s;
    }
    if (l15 == 0) *(float4*)&SS[w * 16 + kg * 4] = make_float4(ss[0], ss[1], ss[2], ss[3]);
    __syncthreads();
    {
      float4 a0 = *(const float4*)&SS[0 * 16 + kg * 4], a1 = *(const float4*)&SS[1 * 16 + kg * 4];
      float4 a2 = *(const float4*)&SS[2 * 16 + kg * 4], a3 = *(const float4*)&SS[3 * 16 + kg * 4];
      float tot[4] = {a0.x + a1.x + a2.x + a3.x, a0.y + a1.y + a2.y + a3.y, a0.z + a1.z + a2.z + a3.z, a0.w + a1.w + a2.w + a3.w};
#pragma unroll
      for (int r = 0; r < 4; r++) {
        const float rstd = rsqrtf(tot[r] * (1.f / 128.f) + LN_EPS);
        const int li = (kg * 4 + r) * 136 + w * 32 + l15;
        sgate[r] = bf2f(GT[li]); sgate[4 + r] = bf2f(GT[li + 16]);
        OT[li] = f2bf(o[0][r] * rstd * g0 * sgate[r]);
        OT[li + 16] = f2bf(o[1][r] * rstd * g1 * sgate[4 + r]);
      }
    }
    __syncthreads();
    *(u32x4*)(p.O + ((size_t)b * SEQ + n * 16 + (tid >> 4)) * DM + ocol + (tid & 15) * 8) = *(const u32x4*)&OT[(tid >> 4) * 136 + (tid & 15) * 8];
  };
  if (MODE == 2) {
    prefetch(0, imA, psg);
    prefetch(1, imB, psgB);
    for (int n = 0; n < SEQ / 16; n += 2) { step(n, imA, psg); step(n + 1, imB, psgB); }
  } else {
    prefetch(nstart, imA, psg);
    for (int n = nstart; n < SEQ / 16; n += nstep) step(n, imA, psg);
  }
}

constexpr size_t IMGH_SZ = (2 * 16 * 136 + 128 * 20 + 128 * 20) * 2 + 128 * 4;
constexpr size_t IMGG_SZ = (2 * 16 * 72 + 64 * 20 + 128 * 20) * 2 + 64 * 4;
__device__ void phaseB0(const Params& p, char* smem) {
  const int nparts = gridDim.x >> 6;
  if ((int)blockIdx.x >= nparts * 64) return;
  const int u = blockIdx.x & 63, part = blockIdx.x >> 6;
  __syncthreads();
  if (u < 32) recur_unit<128, true, 1>(p, smem, u >> 2, u & 3, p.IMGH + (size_t)u * 128 * IMGH_SZ, part, nparts);
  else recur_unit<64, false, 1>(p, smem, (u - 32) >> 2, u & 3, p.IMGG + (size_t)(u - 32) * 128 * IMGG_SZ, part, nparts);
}
__device__ void phaseB(const Params& p, char* smem) {
  if (blockIdx.x >= 64) {
    const int nb = gridDim.x - 64;
    for (int u = blockIdx.x - 64; u < NEXP * 2 * 128; u += nb) {
      const int tile = u & 127, mat = (u >> 7) & 1, e = u >> 8;
      const float* W = (mat ? p.w_up : p.w_gate) + (size_t)e * DM * DEXP;
      u16* WT = (mat ? p.WuT : p.WgT) + (size_t)e * DEXP * DM;
      transpose_tile(W, DEXP, DEXP, (tile & 15) * 64, (tile >> 4) * 64, WT, DM, smem);
    }
    return;
  }
  for (int u = blockIdx.x; u < 64; u += gridDim.x) {
    __syncthreads();
    if (u < 32) recur_unit<128, true, 2>(p, smem, u >> 2, u & 3, p.IMGH + (size_t)u * 128 * IMGH_SZ, 0, 1);
    else recur_unit<64, false, 2>(p, smem, (u - 32) >> 2, u & 3, p.IMGG + (size_t)(u - 32) * 128 * IMGG_SZ, 0, 1);
  }
}

__device__ void phaseC(const Params& p, char* smem) {
  xcd_queue_run(p.bar + QW_BASE + 512, 128, smem + 2 * GEMM_SMEM + 800, [&](int j, int q) {
    const int mt = q, nt = j;
    const int m0 = mt * 128, n0 = nt * 128;
    auto rowf = [&](int r) { return (const void*)(p.O + (size_t)(m0 + r) * DM); };
    auto colf = [&](int c) { return (const void*)(p.WoutT + (size_t)(n0 + c) * DM); };
    auto epi = [&](f32x4 (&acc)[4][4], int mb, int nb) {
#pragma unroll
      for (int mi = 0; mi < 4; mi++)
#pragma unroll
        for (int ni = 0; ni < 4; ni++) {
          const size_t idx = (size_t)(m0 + mb + mi * 16) * DM + n0 + nb + ni * 16;
          float4 xv = *(const float4*)&p.x[idx];
          f32x4 v = acc[mi][ni];
          *(float4*)&p.Z[idx] = make_float4(ALPHA * xv.x + v[0], ALPHA * xv.y + v[1], ALPHA * xv.z + v[2], ALPHA * xv.w + v[3]);
        }
    };
    gemm_tile<true, true>(smem, DM, rowf, colf, DM, epi);
  });
}

__device__ __forceinline__ float wave_sum(float v) {
  v = dpp_row_sum(v);
  const int vi = __float_as_int(v);
  return (__int_as_float(__builtin_amdgcn_readlane(vi, 0)) + __int_as_float(__builtin_amdgcn_readlane(vi, 16))) +
         (__int_as_float(__builtin_amdgcn_readlane(vi, 32)) + __int_as_float(__builtin_amdgcn_readlane(vi, 48)));
}

__device__ __forceinline__ void ln_row(const float* zin, const float* g, const float* bb, int lane, float4 (&o)[4]) {
  float4 v[4];
  float s = 0.f;
#pragma unroll
  for (int i = 0; i < 4; i++) { v[i] = *(const float4*)&zin[lane * 4 + 256 * i]; s += v[i].x + v[i].y + v[i].z + v[i].w; }
  const float mu = wave_sum(s) * (1.f / 1024.f);
  float q = 0.f;
#pragma unroll
  for (int i = 0; i < 4; i++) {
    v[i].x -= mu; v[i].y -= mu; v[i].z -= mu; v[i].w -= mu;
    q += v[i].x * v[i].x + v[i].y * v[i].y + v[i].z * v[i].z + v[i].w * v[i].w;
  }
  const float rstd = rsqrtf(wave_sum(q) * (1.f / 1024.f) + LN_EPS);
#pragma unroll
  for (int i = 0; i < 4; i++) {
    float4 gg = *(const float4*)&g[lane * 4 + 256 * i], b4 = *(const float4*)&bb[lane * 4 + 256 * i];
    o[i] = make_float4(v[i].x * rstd * gg.x + b4.x, v[i].y * rstd * gg.y + b4.y, v[i].z * rstd * gg.z + b4.z, v[i].w * rstd * gg.w + b4.w);
  }
}

__device__ void phaseD(const Params& p, char* smem) {
  float* part = (float*)smem;
  float* logits = part + 4 * 16 * 80;
  const int tid = threadIdx.x, lane = tid & 63, w = tid >> 6, l15 = lane & 15, kg = lane >> 4;
  for (int g = blockIdx.x; g < NTOK / 16; g += gridDim.x) {
    const int row0 = g * 16;
    for (int i = 0; i < 4; i++) {
      const int row = row0 + w * 4 + i;
      float4 o[4];
      ln_row(p.Z + (size_t)row * DM, p.ln1_g, p.ln1_b, lane, o);
#pragma unroll
      for (int j = 0; j < 4; j++) {
        *(float4*)&p.X1[(size_t)row * DM + lane * 4 + 256 * j] = o[j];
        uint2 h; h.x = pack2(o[j].x, o[j].y); h.y = pack2(o[j].z, o[j].w);
        *(uint2*)&p.X1B[(size_t)row * DM + lane * 4 + 256 * j] = h;
      }
    }
    asm volatile("s_waitcnt vmcnt(0)" ::: "memory");
    __syncthreads();
    f32x4 acc[5];
#pragma unroll
    for (int i = 0; i < 5; i++) acc[i] = f32x4{0, 0, 0, 0};
    const float* xrow = p.X1 + (size_t)(row0 + l15) * DM + 256 * w + 4 * kg;
    for (int it = 0; it < 16; it++) {
      float4 a4 = *(const float4*)&xrow[16 * it];
      const float av[4] = {a4.x, a4.y, a4.z, a4.w};
      const int kb = 256 * w + 16 * it + 4 * kg;
#pragma unroll
      for (int i = 0; i < 4; i++) {
        const float* we = p.w_er + (size_t)(kb + i) * 64 + l15;
#pragma unroll
        for (int nt = 0; nt < 4; nt++)
          acc[nt] = __builtin_amdgcn_mfma_f32_16x16x4f32(av[i], we[16 * nt], acc[nt], 0, 0, 0);
        float wg = (l15 < 8) ? p.w_gr[(size_t)(kb + i) * 8 + l15] : 0.f;
        acc[4] = __builtin_amdgcn_mfma_f32_16x16x4f32(av[i], wg, acc[4], 0, 0, 0);
      }
    }
#pragma unroll
    for (int nt = 0; nt < 5; nt++)
#pragma unroll
      for (int r = 0; r < 4; r++) part[(w * 16 + kg * 4 + r) * 80 + nt * 16 + l15] = acc[nt][r];
    __syncthreads();
    for (int idx = tid; idx < 16 * 72; idx += 256) {
      const int r = idx / 72, c = idx % 72;
      logits[r * 72 + c] = part[(0 * 16 + r) * 80 + c] + part[(1 * 16 + r) * 80 + c] + part[(2 * 16 + r) * 80 + c] + part[(3 * 16 + r) * 80 + c];
    }
    __syncthreads();
    if (tid < 16) {
      const float* L = logits + tid * 72;
      const int tok = row0 + tid;
      float gm = L[64]; int gi = 0;
      for (int i = 1; i < 8; i++) if (L[64 + i] > gm) { gm = L[64 + i]; gi = i; }
      float gs = 0.f;
      for (int i = 0; i < 8; i++) gs += expf(L[64 + i] - gm);
      const float pg = 1.f / gs;
      const float* E = L + gi * 8;
      float em = E[0]; int i1 = 0;
      for (int i = 1; i < 8; i++) if (E[i] > em) { em = E[i]; i1 = i; }
      float e2 = -3.0e38f; int i2 = 0;
      for (int i = 0; i < 8; i++) if (i != i1 && E[i] > e2) { e2 = E[i]; i2 = i; }
      const float p1 = 1.f, p2 = expf(e2 - em);
      const float gt1 = pg * p1 / (p1 + p2), gt2 = pg * p2 / (p1 + p2);
      const int ex1 = gi * 8 + i1, ex2 = gi * 8 + i2;
      const int pos1 = atomicAdd(&p.cnt[ex1], 1);
      const int pos2 = atomicAdd(&p.cnt[ex2], 1);
      p.list_tok[ex1 * CAP + pos1] = tok; p.list_gate[ex1 * CAP + pos1] = gt1;
      p.list_tok[ex2 * CAP + pos2] = tok; p.list_gate[ex2 * CAP + pos2] = gt2;
      p.tok_e[tok * 2] = ex1; p.tok_e[tok * 2 + 1] = ex2;
      p.tok_pos[tok * 2] = pos1; p.tok_pos[tok * 2 + 1] = pos2;
    }
    __syncthreads();
  }
}

__device__ __forceinline__ void moe_prefix(const Params& p, int* s_off, int* s_rb) {
  __syncthreads();
  if (threadIdx.x == 0) {
    int o = 0, r = 0;
    for (int e = 0; e < NEXP; e++) {
      s_off[e] = o; s_rb[e] = r;
      int c = p.cnt[e];
      o += c; r += (c + 127) >> 7;
    }
    s_off[NEXP] = o; s_rb[NEXP] = r;
  }
  __syncthreads();
}

__device__ void phaseE1(const Params& p, char* smem) {
  int* s_off = (int*)(smem + 2 * GEMM_SMEM);
  int* s_rb = s_off + 72;
  moe_prefix(p, s_off, s_rb);
  xcd_queue_run(p.bar + QW_BASE + 1024, s_rb[NEXP], smem + 2 * GEMM_SMEM + 800, [&](int j, int q) {
    const int rbg = q, jt = j;
    int e = 0;
    while (s_rb[e + 1] <= rbg) e++;
    const int rb = rbg - s_rb[e];
    const int cnt = p.cnt[e];
    const int rows = min(128, cnt - rb * 128);
    const int* lt = p.list_tok + e * CAP + rb * 128;
    const int slot0 = s_off[e] + rb * 128;
    const int j0 = jt * 64;
    const u16* wg = p.WgT + (size_t)e * DEXP * DM;
    const u16* wu = p.WuT + (size_t)e * DEXP * DM;
    auto rowf = [&](int r) { int rr = r < rows ? r : 0; return (const void*)(p.X1B + (size_t)lt[rr] * DM); };
    auto colf = [&](int c) { return (const void*)(((c & 32) ? wu : wg) + (size_t)(j0 + (c >> 6) * 32 + (c & 31)) * DM); };
    auto epi = [&](f32x4 (&acc)[4][4], int mb, int nb) {
      const int wn = nb >> 6, kg4 = nb & 63;
#pragma unroll
      for (int mi = 0; mi < 4; mi++) {
        const int r = mb + mi * 16;
        if (r < rows) {
#pragma unroll
          for (int ni = 0; ni < 2; ni++) {
            f32x4 gv = acc[mi][ni], uv = acc[mi][ni + 2];
            uint2 o;
            o.x = pack2(siluf(gv[0]) * uv[0], siluf(gv[1]) * uv[1]);
            o.y = pack2(siluf(gv[2]) * uv[2], siluf(gv[3]) * uv[3]);
            *(uint2*)&p.H[(size_t)(slot0 + r) * DEXP + j0 + wn * 32 + ni * 16 + kg4] = o;
          }
        }
      }
    };
    gemm_tile<true, true>(smem, DM, rowf, colf, DEXP, epi);
  });
}

__device__ void phaseE2(const Params& p, char* smem) {
  int* s_off = (int*)(smem + 2 * GEMM_SMEM);
  int* s_rb = s_off + 72;
  moe_prefix(p, s_off, s_rb);
  xcd_queue_run(p.bar + QW_BASE + 1536, s_rb[NEXP], smem + 2 * GEMM_SMEM + 800, [&](int j, int q) {
    const int rbg = q, nt = j;
    int e = 0;
    while (s_rb[e + 1] <= rbg) e++;
    const int rb = rbg - s_rb[e];
    const int cnt = p.cnt[e];
    const int rows = min(128, cnt - rb * 128);
    const int slot0 = s_off[e] + rb * 128;
    const int n0 = nt * 128;
    const float* wd = p.w_down + (size_t)e * DEXP * DM;
    const float* lg = p.list_gate + e * CAP + rb * 128;
    auto rowf = [&](int r) { int rr = r < rows ? r : 0; return (const void*)(p.H + (size_t)(slot0 + rr) * DEXP); };
    auto colf = [&](int c) { return (const void*)(wd + n0 + c); };
    auto epi = [&](f32x4 (&acc)[4][4], int mb, int nb) {
#pragma unroll
      for (int mi = 0; mi < 4; mi++) {
        const int r = mb + mi * 16;
        if (r < rows) {
          const float gt = lg[r];
#pragma unroll
          for (int ni = 0; ni < 4; ni++) {
            f32x4 v = acc[mi][ni];
            uint2 o; o.x = pack2(gt * v[0], gt * v[1]); o.y = pack2(gt * v[2], gt * v[3]);
            *(uint2*)&p.Y[(size_t)(slot0 + r) * DM + n0 + nb + ni * 16] = o;
          }
        }
      }
    };
    gemm_tile<true, false>(smem, DEXP, rowf, colf, DM, epi);
  });
}

__device__ void phaseF(const Params& p, char* smem) {
  int* s_off = (int*)(smem + 2 * GEMM_SMEM);
  int* s_rb = s_off + 72;
  moe_prefix(p, s_off, s_rb);
  const int tid = threadIdx.x, lane = tid & 63, w = tid >> 6;
  for (int row = blockIdx.x * 4 + w; row < NTOK; row += gridDim.x * 4) {
    const int s0 = s_off[p.tok_e[row * 2]] + p.tok_pos[row * 2];
    const int s1 = s_off[p.tok_e[row * 2 + 1]] + p.tok_pos[row * 2 + 1];
    float4 v[4];
    float s = 0.f;
#pragma unroll
    for (int i = 0; i < 4; i++) {
      const int c = lane * 4 + 256 * i;
      float4 xv = *(const float4*)&p.X1[(size_t)row * DM + c];
      uint2 ya = *(const uint2*)&p.Y[(size_t)s0 * DM + c];
      uint2 yb = *(const uint2*)&p.Y[(size_t)s1 * DM + c];
      v[i].x = ALPHA * xv.x + (bflo(ya.x) + bflo(yb.x));
      v[i].y = ALPHA * xv.y + (bfhi(ya.x) + bfhi(yb.x));
      v[i].z = ALPHA * xv.z + (bflo(ya.y) + bflo(yb.y));
      v[i].w = ALPHA * xv.w + (bfhi(ya.y) + bfhi(yb.y));
      s += v[i].x + v[i].y + v[i].z + v[i].w;
    }
    const float mu = wave_sum(s) * (1.f / 1024.f);
    float q = 0.f;
#pragma unroll
    for (int i = 0; i < 4; i++) {
      v[i].x -= mu; v[i].y -= mu; v[i].z -= mu; v[i].w -= mu;
      q += v[i].x * v[i].x + v[i].y * v[i].y + v[i].z * v[i].z + v[i].w * v[i].w;
    }
    const float rstd = rsqrtf(wave_sum(q) * (1.f / 1024.f) + LN_EPS);
#pragma unroll
    for (int i = 0; i < 4; i++) {
      const int c = lane * 4 + 256 * i;
      float4 gg = *(const float4*)&p.ln2_g[c], b4 = *(const float4*)&p.ln2_b[c];
      *(float4*)&p.out[(size_t)row * DM + c] =
          make_float4(v[i].x * rstd * gg.x + b4.x, v[i].y * rstd * gg.y + b4.y, v[i].z * rstd * gg.z + b4.z, v[i].w * rstd * gg.w + b4.w);
    }
  }
}


#define XB_TMO      128
#define XB_XCNT(j)  (256  + 64 * (j))
#define XB_XSUB(j)  (1280 + 64 * (j))
#define XB_XGEN(j)  (2304 + 64 * (j))
#define XB_TOP      3328
#define XB_TOPGEN   3392
#define XCD_BAR_WORDS 3456
#define XB_SPIN_CAP (1u << 18)
#define LAS __attribute__((address_space(3)))
__device__ __forceinline__ unsigned xb_ld(unsigned* p)              { return __hip_atomic_load(p, __ATOMIC_RELAXED, __HIP_MEMORY_SCOPE_AGENT); }
__device__ __forceinline__ unsigned xb_add(unsigned* p, unsigned v) { return __hip_atomic_fetch_add(p, v, __ATOMIC_RELAXED, __HIP_MEMORY_SCOPE_AGENT); }
__device__ __forceinline__ unsigned xb_xcc_id() { return (unsigned)__builtin_amdgcn_s_getreg((3 << 11) | 20) & 0xFu; }
#define XB_SPIN(cond, bar) do { unsigned _sp = 0; while (cond) { __builtin_amdgcn_s_sleep(1); \
    if ((++_sp & 255u) == 0u) { if (xb_ld(&(bar)[XB_TMO])) break; if (_sp > XB_SPIN_CAP) { atomicAdd(&(bar)[XB_TMO], 1u); break; } } } } while (0)
struct XcdBarrier { unsigned* bar; unsigned x; volatile LAS unsigned* st; };
__device__ __forceinline__ XcdBarrier xcd_barrier_post(unsigned* bar, volatile LAS unsigned* st) {
  XcdBarrier b; b.bar = bar; b.x = xb_xcc_id(); b.st = st;
  if (threadIdx.x == 0) (void)xb_add(&bar[XB_XCNT(b.x)], 1u);
  return b;
}
__device__ __forceinline__ void xcd_barrier_complete(unsigned* bar, unsigned x, unsigned& nloc, unsigned& nx) {
  const unsigned G = gridDim.x * gridDim.y * gridDim.z;
  unsigned sum, cnt, mine, sp = 0u;
  for (;;) {
    sum = 0u; cnt = 0u; mine = 0u;
#pragma unroll
    for (unsigned j = 0; j < 16; ++j) { const unsigned c = xb_ld(&bar[XB_XCNT(j)]); sum += c; cnt += (c > 0u) ? 1u : 0u; mine = (j == x) ? c : mine; }
    if (sum == G) break;
    __builtin_amdgcn_s_sleep(1);
    if ((++sp & 255u) == 0u) { if (xb_ld(&bar[XB_TMO])) break; if (sp > XB_SPIN_CAP) { atomicAdd(&bar[XB_TMO], 1u); break; } }
  }
  nloc = mine > 0u ? mine : 1u; nx = cnt > 0u ? cnt : 1u;
}
__device__ __forceinline__ void xcd_barrier(const XcdBarrier& b) {
  asm volatile("s_waitcnt vmcnt(0)" ::: "memory");
  __syncthreads();
  if (threadIdx.x == 0) {
    unsigned* bar = b.bar;
    __builtin_amdgcn_s_waitcnt(0);
    unsigned nloc = b.st[0], nx = b.st[1];
    if (nloc == 0u) { xcd_barrier_complete(bar, b.x, nloc, nx); b.st[0] = nloc; b.st[1] = nx; }
    const unsigned old = xb_add(&bar[XB_XSUB(b.x)], 1u);
    const unsigned gen = old / nloc;
    if (old + 1u == (gen + 1u) * nloc) {
      __builtin_amdgcn_fence(__ATOMIC_RELEASE, "agent");
      asm volatile("s_waitcnt vmcnt(0)" ::: "memory");
      const unsigned og = xb_add(&bar[XB_TOP], 1u);
      const unsigned tg = og / nx;
      if (og + 1u == (tg + 1u) * nx) xb_add(&bar[XB_TOPGEN], 1u);
      else XB_SPIN(xb_ld(&bar[XB_TOPGEN]) == tg, bar);
      __builtin_amdgcn_fence(__ATOMIC_ACQUIRE, "agent");
      xb_add(&bar[XB_XGEN(b.x)], 1u);
      asm volatile("s_waitcnt vmcnt(0)" ::: "memory");
    } else {
      XB_SPIN(xb_ld(&bar[XB_XGEN(b.x)]) == gen, bar);
      __builtin_amdgcn_fence(__ATOMIC_ACQUIRE, "agent");
      asm volatile("s_waitcnt vmcnt(0)" ::: "memory");
    }
  }
  __syncthreads();
}

constexpr int AUX_OFF = 2 * GEMM_SMEM;
constexpr int SMEM_BYTES = AUX_OFF + 1024;

#if SINGLE
__global__ void __launch_bounds__(256, 2) fwd_megakernel(Params p) {
  extern __shared__ __attribute__((aligned(16))) char smem[];
  cg::grid_group grid = cg::this_grid();
  volatile LAS unsigned* st = (volatile LAS unsigned*)(smem + AUX_OFF + 768);
  if (threadIdx.x < 2) st[threadIdx.x] = 0u;
  __syncthreads();
  XcdBarrier xb = xcd_barrier_post(p.bar, st);
  if (p.use_cg) grid.sync();
  phaseP0(p, smem);
  xcd_barrier(xb);
  phaseA(p, smem);
  xcd_barrier(xb);
  phaseB0(p, smem);
  xcd_barrier(xb);
  phaseB(p, smem);
  xcd_barrier(xb);
  phaseC(p, smem);
  xcd_barrier(xb);
  phaseD(p, smem);
  xcd_barrier(xb);
  phaseE1(p, smem);
  xcd_barrier(xb);
  phaseE2(p, smem);
  xcd_barrier(xb);
  phaseF(p, smem);
}
#else
#define PHASE_KERNEL(NAME, FN)                                             \
  __global__ void __launch_bounds__(256, 2) NAME(Params p) {                  \
    __shared__ __attribute__((aligned(16))) char smem[SMEM_BYTES];         \
    FN(p, smem);                                                           \
  }
PHASE_KERNEL(kA, phaseA)
PHASE_KERNEL(kB, phaseB)
PHASE_KERNEL(kC, phaseC)
PHASE_KERNEL(kD, phaseD)
PHASE_KERNEL(kE1, phaseE1)
PHASE_KERNEL(kE2, phaseE2)
PHASE_KERNEL(kF, phaseF)
#endif

extern "C" void kernel_launch(void* const* d_in, const int* in_sizes, int n_in, void* d_out, int out_size,
                              void* d_ws, size_t ws_size, hipStream_t stream) {
  Params p{};
  p.x = (const float*)d_in[0];
  p.w_in = (const float*)d_in[1];
  p.w_a2 = (const float*)d_in[2];
  p.b_a = (const float*)d_in[3];
  p.lb = (const float*)d_in[4];
  p.norm_h = (const float*)d_in[5];
  p.norm_g = (const float*)d_in[6];
  p.w_out = (const float*)d_in[7];
  p.ln1_g = (const float*)d_in[8];
  p.ln1_b = (const float*)d_in[9];
  p.w_gr = (const float*)d_in[10];
  p.w_er = (const float*)d_in[11];
  p.w_gate = (const float*)d_in[12];
  p.w_up = (const float*)d_in[13];
  p.w_down = (const float*)d_in[14];
  p.ln2_g = (const float*)d_in[15];
  p.ln2_b = (const float*)d_in[16];
  p.out = (float*)d_out;
  char* ws = (char*)d_ws;
  size_t off = 0;
  auto take = [&](size_t bytes) { char* r = ws + off; off += (bytes + 255) & ~(size_t)255; return r; };
  p.P = (u16*)take((size_t)NTOK * INC * 2);
  p.LF = (float*)take((size_t)NTOK * 512 * 4);
  p.GA = (float*)take((size_t)NTOK * 16 * 4);
  p.Z = (float*)take((size_t)NTOK * DM * 4);
  p.O = (u16*)take((size_t)NTOK * DM * 2);
  p.X1 = (float*)take((size_t)NTOK * DM * 4);
  p.X1B = (u16*)take((size_t)NTOK * DM * 2);
  p.cnt = (int*)take(256);
  p.tok_e = (int*)take((size_t)NTOK * 2 * 4);
  p.tok_pos = (int*)take((size_t)NTOK * 2 * 4);
  p.list_tok = (int*)take((size_t)NEXP * CAP * 4);
  p.list_gate = (float*)take((size_t)NEXP * CAP * 4);
  p.bar = (unsigned*)take((XCD_BAR_WORDS + 2048) * 4);
  p.XB = p.O;
  p.WgT = (u16*)take((size_t)NEXP * DEXP * DM * 2);
  p.WuT = (u16*)take((size_t)NEXP * DEXP * DM * 2);
  p.IMGH = (char*)p.X1;
  p.IMGG = (char*)p.Z;
  p.WinT = (u16*)take((size_t)INC * DM * 2);
  p.WoutT = (u16*)take((size_t)DM * DM * 2);
  p.use_cg = 0; p.pad_ = 0;
  p.H = p.P;
  p.Y = p.P + (size_t)32768 * DEXP;

#if SINGLE
  static int grid_blocks = 0;
  if (!grid_blocks) {
    int dev = 0, cus = 0, per_cu = 0;
    hipGetDevice(&dev);
    hipDeviceGetAttribute(&cus, hipDeviceAttributeMultiprocessorCount, dev);
    if (hipFuncSetAttribute((const void*)fwd_megakernel, hipFuncAttributeMaxDynamicSharedMemorySize, SMEM_BYTES) != hipSuccess)
      fprintf(stderr, "hipFuncSetAttribute failed\n");
    hipOccupancyMaxActiveBlocksPerMultiprocessor(&per_cu, fwd_megakernel, 256, SMEM_BYTES);
    if (per_cu > 2) per_cu = 2;
    grid_blocks = cus * per_cu;
  }
  hipMemsetAsync(p.bar, 0, (XCD_BAR_WORDS + 2048) * 4, stream);
  void* args[] = {&p};
  hipError_t e = hipLaunchCooperativeKernel((void*)fwd_megakernel, dim3(grid_blocks), dim3(256), args, SMEM_BYTES, stream);
  if (e != hipSuccess) fprintf(stderr, "cooperative launch failed: %s (grid %d)\n", hipGetErrorString(e), grid_blocks);
#else
  const int G = 512;
  kA<<<G, 256, 0, stream>>>(p);
  kB<<<64, 256, 0, stream>>>(p);
  kC<<<G, 256, 0, stream>>>(p);
  kD<<<G, 256, 0, stream>>>(p);
  kE1<<<G, 256, 0, stream>>>(p);
  kE2<<<G, 256, 0, stream>>>(p);
  kF<<<G, 256, 0, stream>>>(p);
#endif
}
```

```cpp
#include <hip/hip_runtime.h>
#include <hip/hip_cooperative_groups.h>
#include <cstdio>
namespace cg = cooperative_groups;

#ifndef SINGLE
#define SINGLE 1
#endif

typedef unsigned short u16;
typedef __attribute__((ext_vector_type(8))) short bf16x8;
typedef __attribute__((ext_vector_type(4))) short bf16x4;
typedef __attribute__((ext_vector_type(4))) float f32x4;
typedef __bf16 bf16x2_t __attribute__((ext_vector_type(2)));
typedef float f32x2_t __attribute__((ext_vector_type(2)));
typedef unsigned u32x4 __attribute__((ext_vector_type(4)));
typedef unsigned u32x2 __attribute__((ext_vector_type(2)));

constexpr int NTOK = 16384;
constexpr int SEQ = 2048;
constexpr int DM = 1024;
constexpr int INC = 3600;
constexpr int NEXP = 64;
constexpr int DEXP = 512;
constexpr int CAP = 32768;
constexpr float ALPHA = 1.189207115002721f;
constexpr float LN_EPS = 1e-5f;

struct Params {
  const float *x, *w_in, *w_a2, *b_a, *lb, *norm_h, *norm_g, *w_out, *ln1_g, *ln1_b, *w_gr, *w_er,
      *w_gate, *w_up, *w_down, *ln2_g, *ln2_b;
  float* out;
  u16* P;
  float* LF;
  float* GA;
  float* Z;
  u16* O;
  float* X1;
  u16* X1B;
  u16* H;
  u16* Y;
  int* cnt;
  int* tok_e;
  int* tok_pos;
  int* list_tok;
  float* list_gate;
  u16* XB;
  u16* WinT;
  u16* WoutT;
  u16* WgT;
  u16* WuT;
  char* IMGH;
  char* IMGG;
  unsigned* bar;
  int use_cg; int pad_;
};

__device__ __forceinline__ unsigned pack2(float a, float b) {
  f32x2_t f = {a, b};
  bf16x2_t h = __builtin_convertvector(f, bf16x2_t);
  return *(unsigned*)&h;
}
__device__ __forceinline__ u16 f2bf(float a) {
  __bf16 h = (__bf16)a;
  return *(u16*)&h;
}
__device__ __forceinline__ float bf2f(u16 v) { return __uint_as_float(((unsigned)v) << 16); }
__device__ __forceinline__ float bflo(unsigned v) { return __uint_as_float(v << 16); }
__device__ __forceinline__ float bfhi(unsigned v) { return __uint_as_float(v & 0xffff0000u); }
__device__ __forceinline__ float sigmoidf(float x) { return 1.f / (1.f + __expf(-x)); }
__device__ __forceinline__ float siluf(float x) { return x / (1.f + __expf(-x)); }


constexpr int QW_BASE = 3456;
__device__ __forceinline__ unsigned my_xcc_id() { return (unsigned)__builtin_amdgcn_s_getreg((3 << 11) | 20) & 7u; }
template <class F>
__device__ __forceinline__ void xcd_queue_run(unsigned* qwords, int nper, char* smem_aux, F fn) {
  volatile int* slot = (volatile int*)smem_aux;
  const unsigned x = my_xcc_id();
  for (int dj = 0; dj < 8; dj++) {
    const int j = (int)((x + dj) & 7u);
    for (;;) {
      __syncthreads();
      if (threadIdx.x == 0) *slot = (int)__hip_atomic_fetch_add(qwords + 64 * j, 1u, __ATOMIC_RELAXED, __HIP_MEMORY_SCOPE_AGENT);
      __syncthreads();
      const int q = *slot;
      if (q >= nper) break;
      fn(j, q);
    }
  }
}

constexpr int BM = 128, BN = 128, BK = 64, LDT = 64;
constexpr int GEMM_SMEM = (BM + BN) * LDT * 2;

template <bool ABF, bool BBF, class RowF, class ColF, class Epi>
__device__ __forceinline__ void gemm_tile(char* smem, int K, RowF rowptr, ColF colptr, int ldb, Epi epi) {
  u16* As0 = (u16*)smem;
  const int tid = threadIdx.x, lane = tid & 63, w = tid >> 6, wm = w >> 1, wn = w & 1;
  const int l15 = lane & 15, kg = lane >> 4, swz = (l15 >> 1) & 7;
  f32x4 acc[4][4];
#pragma unroll
  for (int i = 0; i < 4; i++)
#pragma unroll
    for (int j = 0; j < 4; j++) acc[i][j] = f32x4{0.f, 0.f, 0.f, 0.f};

  constexpr int NA = ABF ? 4 : 8;
  const int ar0 = ABF ? (tid >> 3) : (tid >> 4);
  const int ac = ABF ? (tid & 7) * 8 : (tid & 15) * 4;
  constexpr int ARS = ABF ? 32 : 16;
  const char* ap[NA];
#pragma unroll
  for (int i = 0; i < NA; i++) ap[i] = (const char*)rowptr(ar0 + ARS * i) + ac * (ABF ? 2 : 4);
  const int bc = tid & 127, kh = tid >> 7;
  const float* bp = BBF ? nullptr : ((const float*)colptr(bc) + (size_t)(kh * 32) * ldb);
  const int br0 = tid >> 3, bcc = (tid & 7) * 8;
  const char* bq[4];
  if (BBF) {
#pragma unroll
    for (int i = 0; i < 4; i++) bq[i] = (const char*)colptr(br0 + 32 * i) + bcc * 2;
  }

  u32x4 ra[NA];
  float rb[BBF ? 1 : 32];
  u32x4 rbb[BBF ? 4 : 1];
  auto gload = [&](int k0) {
#pragma unroll
    for (int i = 0; i < NA; i++) ra[i] = *(const u32x4*)(ap[i] + (size_t)k0 * (ABF ? 2 : 4));
    if (BBF) {
#pragma unroll
      for (int i = 0; i < 4; i++) rbb[BBF ? i : 0] = *(const u32x4*)(bq[i] + (size_t)k0 * 2);
    } else {
      const float* b = bp + (size_t)k0 * ldb;
#pragma unroll
      for (int j = 0; j < 32; j++) rb[BBF ? 0 : j] = b[(size_t)j * ldb];
    }
  };
  auto sstore = [&](int buf) {
    u16* As = As0 + buf * (GEMM_SMEM / 2);
    u16* Bs = As + BM * LDT;
#pragma unroll
    for (int i = 0; i < NA; i++) {
      if (ABF) {
        { const int row = ar0 + ARS * i; *(u32x4*)&As[row * LDT + (((ac >> 3) ^ ((row >> 1) & 7)) << 3)] = ra[i]; }
      } else {
        u32x2 v;
        v[0] = pack2(__uint_as_float(ra[i][0]), __uint_as_float(ra[i][1]));
        v[1] = pack2(__uint_as_float(ra[i][2]), __uint_as_float(ra[i][3]));
        { const int row = ar0 + ARS * i; *(u32x2*)&As[row * LDT + (((ac >> 3) ^ ((row >> 1) & 7)) << 3) + (ac & 4)] = v; }
      }
    }
    if (BBF) {
#pragma unroll
      for (int i = 0; i < 4; i++) { const int row = br0 + 32 * i; *(u32x4*)&Bs[row * LDT + (((bcc >> 3) ^ ((row >> 1) & 7)) << 3)] = rbb[BBF ? i : 0]; }
    } else {
#pragma unroll
      for (int j = 0; j < 4; j++) {
        u32x4 v;
        v[0] = pack2(rb[BBF ? 0 : 8 * j + 0], rb[BBF ? 0 : 8 * j + 1]);
        v[1] = pack2(rb[BBF ? 0 : 8 * j + 2], rb[BBF ? 0 : 8 * j + 3]);
        v[2] = pack2(rb[BBF ? 0 : 8 * j + 4], rb[BBF ? 0 : 8 * j + 5]);
        v[3] = pack2(rb[BBF ? 0 : 8 * j + 6], rb[BBF ? 0 : 8 * j + 7]);
        *(u32x4*)&Bs[bc * LDT + (((kh * 4 + j) ^ ((bc >> 1) & 7)) << 3)] = v;
      }
    }
  };

  gload(0);
  sstore(0);
  __syncthreads();
  int cur = 0;
  for (int k0 = 0; k0 < K; k0 += BK) {
    if (k0 + BK < K) gload(k0 + BK);
    const u16* As = As0 + cur * (GEMM_SMEM / 2);
    const u16* Bs = As + BM * LDT;
    {
      bf16x8 af[2][4], bfr[2][4];
#pragma unroll
      for (int ks = 0; ks < 2; ks++) {
#pragma unroll
        for (int mi = 0; mi < 4; mi++) af[ks][mi] = *(const bf16x8*)&As[(wm * 64 + mi * 16 + l15) * LDT + (((ks * 4 + kg) ^ swz) << 3)];
#pragma unroll
        for (int ni = 0; ni < 4; ni++) bfr[ks][ni] = *(const bf16x8*)&Bs[(wn * 64 + ni * 16 + l15) * LDT + (((ks * 4 + kg) ^ swz) << 3)];
      }
      __builtin_amdgcn_sched_barrier(0);
#pragma unroll
      for (int ks = 0; ks < 2; ks++)
#pragma unroll
        for (int mi = 0; mi < 4; mi++)
#pragma unroll
          for (int ni = 0; ni < 4; ni++)
            acc[mi][ni] = __builtin_amdgcn_mfma_f32_16x16x32_bf16(bfr[ks][ni], af[ks][mi], acc[mi][ni], 0, 0, 0);
      __builtin_amdgcn_sched_barrier(0);
    }
    if (k0 + BK < K) sstore(cur ^ 1);
    __syncthreads();
    cur ^= 1;
  }
  epi(acc, wm * 64 + l15, wn * 64 + kg * 4);
}


__device__ void transpose_tile(const float* W, int ld, int N, int k0, int n0, u16* WT, int K, char* smem) {
  u16* T = (u16*)smem;
  const int tid = threadIdx.x;
  __syncthreads();
  {
    const int r = tid >> 4, c4 = (tid & 15) * 4;
#pragma unroll
    for (int i = 0; i < 4; i++) {
      const int k = r + 16 * i;
      float4 v = make_float4(0.f, 0.f, 0.f, 0.f);
      if (n0 + c4 < N) v = *(const float4*)&W[(size_t)(k0 + k) * ld + n0 + c4];
      T[(c4 + 0) * 72 + k] = f2bf(v.x); T[(c4 + 1) * 72 + k] = f2bf(v.y);
      T[(c4 + 2) * 72 + k] = f2bf(v.z); T[(c4 + 3) * 72 + k] = f2bf(v.w);
    }
  }
  __syncthreads();
  {
    const int n = tid >> 2, seg = (tid & 3) * 16;
    if (n0 + n < N) {
      u32x4 a = *(const u32x4*)&T[n * 72 + seg], b = *(const u32x4*)&T[n * 72 + seg + 8];
      *(u32x4*)&WT[(size_t)(n0 + n) * K + k0 + seg] = a;
      *(u32x4*)&WT[(size_t)(n0 + n) * K + k0 + seg + 8] = b;
    }
  }
}
__device__ void phaseP0(const Params& p, char* smem) {
  if (blockIdx.x == 0 && threadIdx.x < 64) p.cnt[threadIdx.x] = 0;
  constexpr int NTI = 57 * 16, NTO = 16 * 16;
  for (int u = blockIdx.x; u < NTI + NTO; u += gridDim.x) {
    if (u < NTI) transpose_tile(p.w_in, INC, INC, (u % 16) * 64, (u / 16) * 64, p.WinT, DM, smem);
    else { const int v = u - NTI; transpose_tile(p.w_out, DM, DM, (v % 16) * 64, (v / 16) * 64, p.WoutT, DM, smem); }
  }
  const size_t n4 = (size_t)NTOK * DM / 4;
  for (size_t i = blockIdx.x * (size_t)256 + threadIdx.x; i < n4; i += (size_t)gridDim.x * 256) {
    float4 v = ((const float4*)p.x)[i];
    uint2 o; o.x = pack2(v.x, v.y); o.y = pack2(v.z, v.w);
    ((uint2*)p.XB)[i] = o;
  }
}

__device__ void phaseA(const Params& p, char* smem) {
  xcd_queue_run(p.bar + QW_BASE, 464, smem + 2 * GEMM_SMEM + 800, [&](int j, int q) {
    const int pj = j >> 1, odd = j & 1;
    int mt, nt;
    if (q < 384) { mt = q / 3; nt = 7 * pj + odd * 4 + q % 3; }
    else if (q < 448) { mt = odd * 64 + (q - 384); nt = 7 * pj + 3; }
    else { mt = 16 * j + (q - 448); nt = 28; }
    const int m0 = mt * 128, n0 = nt * 128;
    const u16* xa = p.XB + (size_t)m0 * DM;
    auto rowf = [&](int r) { return (const void*)(xa + (size_t)r * DM); };
    auto colf = [&](int c) { int n = n0 + c; if (n > INC - 1) n = INC - 1; return (const void*)(p.WinT + (size_t)n * DM); };
    auto epi = [&](f32x4 (&acc)[4][4], int mb, int nb) {
#pragma unroll
      for (int mi = 0; mi < 4; mi++)
#pragma unroll
        for (int ni = 0; ni < 4; ni++) {
          const int m = m0 + mb + mi * 16, n = n0 + nb + ni * 16;
          f32x4 v = acc[mi][ni];
          if (n >= INC) continue;
          if (n >= 512 && n < 1024) {
            const int c = n - 512;
            float lf[4], kf[4];
#pragma unroll
            for (int r = 0; r < 4; r++) {
              float lbv = sigmoidf(p.lb[c + r] - p.lb[512 + c + r]);
              float sg = sigmoidf(v[r]);
              float f = lbv + (1.f - lbv) * sg;
              lf[r] = __logf(f);
              kf[r] = (1.f - lbv) * (1.f - sg);
            }
            *(float4*)&p.LF[(size_t)m * 512 + c] = make_float4(lf[0], lf[1], lf[2], lf[3]);
            uint2 o; o.x = pack2(kf[0], kf[1]); o.y = pack2(kf[2], kf[3]);
            *(uint2*)&p.P[(size_t)m * INC + n] = o;
          } else if (n >= 3072 && n < 3088) {
            *(float4*)&p.GA[(size_t)m * 16 + (n - 3072)] = make_float4(v[0], v[1], v[2], v[3]);
          } else {
            if (n < 512) { v *= 0.08838834764831845f; }
            else if ((n >= 1536 && n < 2048) || n >= 3088) {
#pragma unroll
              for (int r = 0; r < 4; r++) v[r] = siluf(v[r]);
            } else if (n >= 2048 && n < 2304) { v *= 0.125f; }
            uint2 o; o.x = pack2(v[0], v[1]); o.y = pack2(v[2], v[3]);
            *(uint2*)&p.P[(size_t)m * INC + n] = o;
          }
        }
    };
    gemm_tile<true, true>(smem, DM, rowf, colf, INC, epi);
  });
}

__device__ __forceinline__ float dpp_scan_add(float x) {
  int xi;
  xi = __builtin_amdgcn_update_dpp(0, __float_as_int(x), 0x111, 0xf, 0xf, true); x += __int_as_float(xi);
  xi = __builtin_amdgcn_update_dpp(0, __float_as_int(x), 0x112, 0xf, 0xf, true); x += __int_as_float(xi);
  xi = __builtin_amdgcn_update_dpp(0, __float_as_int(x), 0x114, 0xf, 0xf, true); x += __int_as_float(xi);
  xi = __builtin_amdgcn_update_dpp(0, __float_as_int(x), 0x118, 0xf, 0xf, true); x += __int_as_float(xi);
  return x;
}


__device__ __forceinline__ float dpp_row_bcast15(float x) {
  return __int_as_float(__builtin_amdgcn_update_dpp(0, __float_as_int(x), 0x15F, 0xf, 0xf, false));
}
__device__ __forceinline__ float dpp_row_sum(float x) {
  x += __int_as_float(__builtin_amdgcn_update_dpp(0, __float_as_int(x), 0x128, 0xf, 0xf, false));
  x += __int_as_float(__builtin_amdgcn_update_dpp(0, __float_as_int(x), 0x124, 0xf, 0xf, false));
  x += __int_as_float(__builtin_amdgcn_update_dpp(0, __float_as_int(x), 0x122, 0xf, 0xf, false));
  x += __int_as_float(__builtin_amdgcn_update_dpp(0, __float_as_int(x), 0x121, 0xf, 0xf, false));
  return x;
}

#define STAGE() do { } while (0)
template <int DK, bool HG, int MODE>
__device__ void recur_unit(const Params& p, char* smem, int b, int h, char* img, int nstart, int nstep) {
  constexpr int IMG = (2 * 16 * (DK + 8) + DK * 20 + 128 * 20) * 2 + DK * 4;
  constexpr int NIM = (IMG + 4095) / 4096;
  constexpr int KPT = DK / 16;
  constexpr int NKS = DK / 32;
  constexpr int NKT = DK / 16;
  constexpr int LQ = DK + 8;
  u16* Qt = (u16*)smem;
  u16* Kt = Qt + 16 * LQ;
  u16* KhT = Kt + 16 * LQ;
  u16* VT = KhT + DK * 20;
  float* Gch = (float*)(VT + 128 * 20);
  float* SS = Gch + DK;
  float* Wa = SS + 64;
  u16* GT = (u16*)(smem + 20480);
  u16* OT = (u16*)(smem + 24832);

  const int tid = threadIdx.x, lane = tid & 63, w = tid >> 6, l15 = lane & 15, kg = lane >> 4;
  const int t = tid & 15, kgp = tid >> 4, k0 = kgp * KPT;
  const int qcol = HG ? (h * 128) : (2048 + h * 64);
  const int kcol = HG ? (512 + h * 128) : (2304 + h * 64);
  const int vcol = HG ? (1024 + h * 128) : (2560 + h * 128);
  const int gcol = HG ? (1536 + h * 128) : (3088 + h * 128);
  const int ocol = HG ? (h * 128) : (512 + h * 128);
  const float* gain = HG ? p.norm_h : p.norm_g;

  float ba[KPT];
  if (!HG && MODE == 1) {
    __syncthreads();
    for (int i = tid; i < 16 * 64; i += 256) Wa[i] = p.w_a2[(i >> 6) * 256 + h * 64 + (i & 63)];
#pragma unroll
    for (int i = 0; i < KPT; i++) ba[i] = p.b_a[h * 64 + k0 + i];
    __syncthreads();
  }
  const float g0 = gain[h * 128 + w * 32 + l15], g1 = gain[h * 128 + w * 32 + 16 + l15];

  f32x4 S[NKT][2];
#pragma unroll
  for (int i = 0; i < NKT; i++) { S[i][0] = f32x4{0, 0, 0, 0}; S[i][1] = f32x4{0, 0, 0, 0}; }

  float4 pl[4];
  uint4 pq, pk, pv;
  u16 psg[8];
  u32x4 imA[NIM], imB[NIM];
  u16 psgB[8];
  auto prefetch = [&](int n, u32x4 (&im)[NIM], u16 (&psg)[8]) {
    if (MODE == 2) {
      const char* src = img + (size_t)n * IMG;
#pragma unroll
      for (int i = 0; i < NIM; i++) if (tid * 16 + 4096 * i < IMG) im[i] = *(const u32x4*)(src + tid * 16 + 4096 * i);
      {
        const u32x4 g = *(const u32x4*)(p.P + ((size_t)b * SEQ + n * 16 + (tid >> 4)) * INC + gcol + (tid & 15) * 8);
        psg[0] = (u16)(g[0] & 0xffff); psg[1] = (u16)(g[0] >> 16); psg[2] = (u16)(g[1] & 0xffff); psg[3] = (u16)(g[1] >> 16);
        psg[4] = (u16)(g[2] & 0xffff); psg[5] = (u16)(g[2] >> 16); psg[6] = (u16)(g[3] & 0xffff); psg[7] = (u16)(g[3] >> 16);
      }
      return;
    }
    const size_t tok = (size_t)b * SEQ + n * 16 + t;
    const u16* prow = p.P + tok * INC;
    if (HG) {
      pl[0] = *(const float4*)&p.LF[tok * 512 + h * 128 + k0];
      pl[1] = *(const float4*)&p.LF[tok * 512 + h * 128 + k0 + 4];
      pq = *(const uint4*)&prow[qcol + k0];
      pk = *(const uint4*)&prow[kcol + k0];
    } else {
#pragma unroll
      for (int i = 0; i < 4; i++) pl[i] = *(const float4*)&p.GA[tok * 16 + 4 * i];
      uint2 a = *(const uint2*)&prow[qcol + k0];
      uint2 c = *(const uint2*)&prow[kcol + k0];
      pq.x = a.x; pq.y = a.y; pk.x = c.x; pk.y = c.y;
    }
    pv = *(const uint4*)&prow[vcol + kgp * 8];
  };

  constexpr int PFD = (MODE == 2) ? 2 : 1;
  auto step = [&](int n, u32x4 (&im)[NIM], u16 (&psg)[8]) {
    float sgate[8];
    if (MODE == 2) {
#pragma unroll
      for (int i = 0; i < NIM; i++) if (tid * 16 + 4096 * i < IMG) *(u32x4*)(smem + tid * 16 + 4096 * i) = im[i];
      {
        u32x4 g;
        g[0] = (unsigned)psg[0] | ((unsigned)psg[1] << 16); g[1] = (unsigned)psg[2] | ((unsigned)psg[3] << 16);
        g[2] = (unsigned)psg[4] | ((unsigned)psg[5] << 16); g[3] = (unsigned)psg[6] | ((unsigned)psg[7] << 16);
        *(u32x4*)&GT[(tid >> 4) * 136 + (tid & 15) * 8] = g;
      }
      __builtin_amdgcn_sched_barrier(0);
      if (n + PFD * nstep < SEQ / 16) prefetch(n + PFD * nstep, im, psg);
      __builtin_amdgcn_sched_barrier(0);
    } else {
    float lg[KPT], qv[KPT], kv[KPT];
    if (HG) {
      lg[0] = pl[0].x; lg[1] = pl[0].y; lg[2] = pl[0].z; lg[3] = pl[0].w;
      if (KPT > 4) { lg[4 % KPT] = pl[1].x; lg[5 % KPT] = pl[1].y; lg[6 % KPT] = pl[1].z; lg[7 % KPT] = pl[1].w; }
    } else {
      float ga[16] = {pl[0].x, pl[0].y, pl[0].z, pl[0].w, pl[1].x, pl[1].y, pl[1].z, pl[1].w,
                      pl[2].x, pl[2].y, pl[2].z, pl[2].w, pl[3].x, pl[3].y, pl[3].z, pl[3].w};
      float z[4] = {ba[0], ba[1], ba[2], ba[3]};
#pragma unroll
      for (int r = 0; r < 16; r++) {
        float4 wv = *(const float4*)&Wa[r * 64 + k0];
        z[0] += ga[r] * wv.x; z[1] += ga[r] * wv.y; z[2] += ga[r] * wv.z; z[3] += ga[r] * wv.w;
      }
#pragma unroll
      for (int i = 0; i < 4; i++) {
        float sp = fmaxf(-z[i], 0.f) + __logf(1.f + __expf(-fabsf(z[i])));
        lg[i] = -sp * (1.f / 16.f);
      }
    }
    {
      unsigned qq[4] = {pq.x, pq.y, pq.z, pq.w}, kk[4] = {pk.x, pk.y, pk.z, pk.w};
#pragma unroll
      for (int i = 0; i < KPT / 2; i++) {
        qv[2 * i] = bflo(qq[i]); qv[2 * i + 1] = bfhi(qq[i]);
        kv[2 * i] = bflo(kk[i]); kv[2 * i + 1] = bfhi(kk[i]);
      }
    }
    {
      unsigned vv[4] = {pv.x, pv.y, pv.z, pv.w};
#pragma unroll
      for (int i = 0; i < 4; i++) {
        VT[(kgp * 8 + 2 * i) * 20 + t] = (u16)(vv[i] & 0xffff);
        VT[(kgp * 8 + 2 * i + 1) * 20 + t] = (u16)(vv[i] >> 16);
      }
    }
    __builtin_amdgcn_sched_barrier(0);
    if (n + nstep < SEQ / 16) prefetch(n + nstep, im, psg);
    __builtin_amdgcn_sched_barrier(0);
    float qt[KPT], kt[KPT], kh[KPT];
#pragma unroll
    for (int i = 0; i < KPT; i++) {
      float bcum = dpp_scan_add(lg[i]);
      float bl = dpp_row_bcast15(bcum);
      qt[i] = qv[i] * __expf(bcum);
      kt[i] = kv[i] * __expf(-bcum);
      kh[i] = kv[i] * __expf(bl - bcum);
      if (t == 15) Gch[k0 + i] = __expf(bl);
      KhT[(k0 + i) * 20 + t] = f2bf(kh[i]);
    }
    if (KPT == 8) {
      uint4 a, c;
      a.x = pack2(qt[0], qt[1]); a.y = pack2(qt[2], qt[3]); a.z = pack2(qt[4 % KPT], qt[5 % KPT]); a.w = pack2(qt[6 % KPT], qt[7 % KPT]);
      c.x = pack2(kt[0], kt[1]); c.y = pack2(kt[2], kt[3]); c.z = pack2(kt[4 % KPT], kt[5 % KPT]); c.w = pack2(kt[6 % KPT], kt[7 % KPT]);
      *(uint4*)&Qt[t * LQ + k0] = a;
      *(uint4*)&Kt[t * LQ + k0] = c;
    } else {
      uint2 a, c;
      a.x = pack2(qt[0], qt[1]); a.y = pack2(qt[2], qt[3]);
      c.x = pack2(kt[0], kt[1]); c.y = pack2(kt[2], kt[3]);
      *(uint2*)&Qt[t * LQ + k0] = a;
      *(uint2*)&Kt[t * LQ + k0] = c;
    }
    }
    __syncthreads();
    if (MODE == 1) {
      char* dst = img + (size_t)n * IMG;
#pragma unroll
      for (int i = 0; i < NIM; i++) if (tid * 16 + 4096 * i < IMG) *(u32x4*)(dst + tid * 16 + 4096 * i) = *(const u32x4*)(smem + tid * 16 + 4096 * i);
      __syncthreads();
      return;
    }

    STAGE();
    f32x4 sc = f32x4{0, 0, 0, 0};
    bf16x8 qf[NKS];
#pragma unroll
    for (int st = 0; st < NKS; st++) {
      bf16x4 q0 = *(const bf16x4*)&Qt[l15 * LQ + 32 * st + kg * 4];
      bf16x4 q1 = *(const bf16x4*)&Qt[l15 * LQ + 32 * st + 16 + kg * 4];
      bf16x4 c0 = *(const bf16x4*)&Kt[l15 * LQ + 32 * st + kg * 4];
      bf16x4 c1 = *(const bf16x4*)&Kt[l15 * LQ + 32 * st + 16 + kg * 4];
      qf[st] = bf16x8{q0[0], q0[1], q0[2], q0[3], q1[0], q1[1], q1[2], q1[3]};
      bf16x8 kf = bf16x8{c0[0], c0[1], c0[2], c0[3], c1[0], c1[1], c1[2], c1[3]};
      sc = __builtin_amdgcn_mfma_f32_16x16x32_bf16(kf, qf[st], sc, 0, 0, 0);
    }
    STAGE();
#pragma unroll
    for (int r = 0; r < 4; r++) if (kg * 4 + r > l15) sc[r] = 0.f;
    bf16x4 pA;
    {
      unsigned a = pack2(sc[0], sc[1]), c = pack2(sc[2], sc[3]);
      pA = bf16x4{(short)(a & 0xffff), (short)(a >> 16), (short)(c & 0xffff), (short)(c >> 16)};
    }
    bf16x4 vf[2];
    f32x4 o[2], oin[2];
    bf16x8 sbv[2][NKS];
#pragma unroll
    for (int vt = 0; vt < 2; vt++) {
      vf[vt] = *(const bf16x4*)&VT[(w * 32 + vt * 16 + l15) * 20 + kg * 4];
#pragma unroll
      for (int st = 0; st < NKS; st++) {
        unsigned s0 = pack2(S[2 * st][vt][0], S[2 * st][vt][1]), s1 = pack2(S[2 * st][vt][2], S[2 * st][vt][3]);
        unsigned s2 = pack2(S[2 * st + 1][vt][0], S[2 * st + 1][vt][1]), s3 = pack2(S[2 * st + 1][vt][2], S[2 * st + 1][vt][3]);
        sbv[vt][st] = bf16x8{(short)(s0 & 0xffff), (short)(s0 >> 16), (short)(s1 & 0xffff), (short)(s1 >> 16),
                           (short)(s2 & 0xffff), (short)(s2 >> 16), (short)(s3 & 0xffff), (short)(s3 >> 16)};
      }
    }
    STAGE();
#pragma unroll
    for (int vt = 0; vt < 2; vt++) {
      o[vt] = __builtin_amdgcn_mfma_f32_16x16x16bf16_1k(pA, vf[vt], f32x4{0, 0, 0, 0}, 0, 0, 0);
      oin[vt] = f32x4{0, 0, 0, 0};
#pragma unroll
      for (int st = 0; st < NKS; st++) oin[vt] = __builtin_amdgcn_mfma_f32_16x16x32_bf16(qf[st], sbv[vt][st], oin[vt], 0, 0, 0);
    }
    STAGE();
    bf16x4 khf[NKT];
#pragma unroll
    for (int kt2 = 0; kt2 < NKT; kt2++) {
      khf[kt2] = *(const bf16x4*)&KhT[(16 * kt2 + l15) * 20 + kg * 4];
      float4 g4 = *(const float4*)&Gch[16 * kt2 + kg * 4];
      f32x4 gv = f32x4{g4.x, g4.y, g4.z, g4.w};
      S[kt2][0] *= gv; S[kt2][1] *= gv;
    }
    STAGE();
#pragma unroll
    for (int kt2 = 0; kt2 < NKT; kt2++) {
#pragma unroll
      for (int vt = 0; vt < 2; vt++)
        S[kt2][vt] = __builtin_amdgcn_mfma_f32_16x16x16bf16_1k(khf[kt2], vf[vt], S[kt2][vt], 0, 0, 0);
    }
    STAGE();
    float ss[4];
#pragma unroll
    for (int r = 0; r < 4; r++) {
      o[0][r] += oin[0][r]; o[1][r] += oin[1][r];
      float s = o[0][r] * o[0][r] + o[1][r] * o[1][r];
      s = dpp_row_sum(s);
      ss[r] = s;
    }
    if (l15 == 0) *(float4*)&SS[w * 16 + kg * 4] = make_float4(ss[0], ss[1], ss[2], ss[3]);
    __syncthreads();
    {
      float4 a0 = *(const float4*)&SS[0 * 16 + kg * 4], a1 = *(const float4*)&SS[1 * 16 + kg * 4];
      float4 a2 = *(const float4*)&SS[2 * 16 + kg * 4], a3 = *(const float4*)&SS[3 * 16 + kg * 4];
      float tot[4] = {a0.x + a1.x + a2.x + a3.x, a0.y + a1.y + a2.y + a3.y, a0.z + a1.z + a2.z + a3.z, a0.w + a1.w + a2.w + a3.w};
#pragma unroll
      for (int r = 0; r < 4; r++) {
        const float rstd = rsqrtf(tot[r] * (1.f / 128.f) + LN_EPS);
        const int li = (kg * 4 + r) * 136 + w * 32 + l15;
        sgate[r] = bf2f(GT[li]); sgate[4 + r] = bf2f(GT[li + 16]);
        OT[li] = f2bf(o[0][r] * rstd * g0 * sgate[r]);
        OT[li + 16] = f2bf(o[1][r] * rstd * g1 * sgate[4 + r]);
      }
    }
    __syncthreads();
    *(u32x4*)(p.O + ((size_t)b * SEQ + n * 16 + (tid >> 4)) * DM + ocol + (tid & 15) * 8) = *(const u32x4*)&OT[(tid >> 4) * 136 + (tid & 15) * 8];
  };
  if (MODE == 2) {
    prefetch(0, imA, psg);
    prefetch(1, imB, psgB);
    for (int n = 0; n < SEQ / 16; n += 2) { step(n, imA, psg); step(n + 1, imB, psgB); }
  } else {
    prefetch(nstart, imA, psg);
    for (int n = nstart; n < SEQ / 16; n += nstep) step(n, imA, psg);
  }
}

constexpr size_t IMGH_SZ = (2 * 16 * 136 + 128 * 20 + 128 * 20) * 2 + 128 * 4;
constexpr size_t IMGG_SZ = (2 * 16 * 72 + 64 * 20 + 128 * 20) * 2 + 64 * 4;
__device__ void phaseB0(const Params& p, char* smem) {
  const int nparts = gridDim.x >> 6;
  if ((int)blockIdx.x >= nparts * 64) return;
  const int u = blockIdx.x & 63, part = blockIdx.x >> 6;
  __syncthreads();
  if (u < 32) recur_unit<128, true, 1>(p, smem, u >> 2, u & 3, p.IMGH + (size_t)u * 128 * IMGH_SZ, part, nparts);
  else recur_unit<64, false, 1>(p, smem, (u - 32) >> 2, u & 3, p.IMGG + (size_t)(u - 32) * 128 * IMGG_SZ, part, nparts);
}
__device__ void phaseB(const Params& p, char* smem) {
  if (blockIdx.x >= 64) {
    const int nb = gridDim.x - 64;
    for (int u = blockIdx.x - 64; u < NEXP * 2 * 128; u += nb) {
      const int tile = u & 127, mat = (u >> 7) & 1, e = u >> 8;
      const float* W = (mat ? p.w_up : p.w_gate) + (size_t)e * DM * DEXP;
      u16* WT = (mat ? p.WuT : p.WgT) + (size_t)e * DEXP * DM;
      transpose_tile(W, DEXP, DEXP, (tile & 15) * 64, (tile >> 4) * 64, WT, DM, smem);
    }
    return;
  }
  for (int u = blockIdx.x; u < 64; u += gridDim.x) {
    __syncthreads();
    if (u < 32) recur_unit<128, true, 2>(p, smem, u >> 2, u & 3, p.IMGH + (size_t)u * 128 * IMGH_SZ, 0, 1);
    else recur_unit<64, false, 2>(p, smem, (u - 32) >> 2, u & 3, p.IMGG + (size_t)(u - 32) * 128 * IMGG_SZ, 0, 1);
  }
}

__device__ void phaseC(const Params& p, char* smem) {
  xcd_queue_run(p.bar + QW_BASE + 512, 128, smem + 2 * GEMM_SMEM + 800, [&](int j, int q) {
    const int mt = q, nt = j;
    const int m0 = mt * 128, n0 = nt * 128;
    auto rowf = [&](int r) { return (const void*)(p.O + (size_t)(m0 + r) * DM); };
    auto colf = [&](int c) { return (const void*)(p.WoutT + (size_t)(n0 + c) * DM); };
    auto epi = [&](f32x4 (&acc)[4][4], int mb, int nb) {
#pragma unroll
      for (int mi = 0; mi < 4; mi++)
#pragma unroll
        for (int ni = 0; ni < 4; ni++) {
          const size_t idx = (size_t)(m0 + mb + mi * 16) * DM + n0 + nb + ni * 16;
          float4 xv = *(const float4*)&p.x[idx];
          f32x4 v = acc[mi][ni];
          *(float4*)&p.Z[idx] = make_float4(ALPHA * xv.x + v[0], ALPHA * xv.y + v[1], ALPHA * xv.z + v[2], ALPHA * xv.w + v[3]);
        }
    };
    gemm_tile<true, true>(smem, DM, rowf, colf, DM, epi);
  });
}

__device__ __forceinline__ float wave_sum(float v) {
  v = dpp_row_sum(v);
  const int vi = __float_as_int(v);
  return (__int_as_float(__builtin_amdgcn_readlane(vi, 0)) + __int_as_float(__builtin_amdgcn_readlane(vi, 16))) +
         (__int_as_float(__builtin_amdgcn_readlane(vi, 32)) + __int_as_float(__builtin_amdgcn_readlane(vi, 48)));
}

__device__ __forceinline__ void ln_row(const float* zin, const float* g, const float* bb, int lane, float4 (&o)[4]) {
  float4 v[4];
  float s = 0.f;
#pragma unroll
  for (int i = 0; i < 4; i++) { v[i] = *(const float4*)&zin[lane * 4 + 256 * i]; s += v[i].x + v[i].y + v[i].z + v[i].w; }
  const float mu = wave_sum(s) * (1.f / 1024.f);
  float q = 0.f;
#pragma unroll
  for (int i = 0; i < 4; i++) {
    v[i].x -= mu; v[i].y -= mu; v[i].z -= mu; v[i].w -= mu;
    q += v[i].x * v[i].x + v[i].y * v[i].y + v[i].z * v[i].z + v[i].w * v[i].w;
  }
  const float rstd = rsqrtf(wave_sum(q) * (1.f / 1024.f) + LN_EPS);
#pragma unroll
  for (int i = 0; i < 4; i++) {
    float4 gg = *(const float4*)&g[lane * 4 + 256 * i], b4 = *(const float4*)&bb[lane * 4 + 256 * i];
    o[i] = make_float4(v[i].x * rstd * gg.x + b4.x, v[i].y * rstd * gg.y + b4.y, v[i].z * rstd * gg.z + b4.z, v[i].w * rstd * gg.w + b4.w);
  }
}

__device__ void phaseD(const Params& p, char* smem) {
  float* part = (float*)smem;
  float* logits = part + 4 * 16 * 80;
  const int tid = threadIdx.x, lane = tid & 63, w = tid >> 6, l15 = lane & 15, kg = lane >> 4;
  for (int g = blockIdx.x; g < NTOK / 16; g += gridDim.x) {
    const int row0 = g * 16;
    for (int i = 0; i < 4; i++) {
      const int row = row0 + w * 4 + i;
      float4 o[4];
      ln_row(p.Z + (size_t)row * DM, p.ln1_g, p.ln1_b, lane, o);
#pragma unroll
      for (int j = 0; j < 4; j++) {
        *(float4*)&p.X1[(size_t)row * DM + lane * 4 + 256 * j] = o[j];
        uint2 h; h.x = pack2(o[j].x, o[j].y); h.y = pack2(o[j].z, o[j].w);
        *(uint2*)&p.X1B[(size_t)row * DM + lane * 4 + 256 * j] = h;
      }
    }
    asm volatile("s_waitcnt vmcnt(0)" ::: "memory");
    __syncthreads();
    f32x4 acc[5];
#pragma unroll
    for (int i = 0; i < 5; i++) acc[i] = f32x4{0, 0, 0, 0};
    const float* xrow = p.X1 + (size_t)(row0 + l15) * DM + 256 * w + 4 * kg;
    for (int it = 0; it < 16; it++) {
      float4 a4 = *(const float4*)&xrow[16 * it];
      const float av[4] = {a4.x, a4.y, a4.z, a4.w};
      const int kb = 256 * w + 16 * it + 4 * kg;
#pragma unroll
      for (int i = 0; i < 4; i++) {
        const float* we = p.w_er + (size_t)(kb + i) * 64 + l15;
#pragma unroll
        for (int nt = 0; nt < 4; nt++)
          acc[nt] = __builtin_amdgcn_mfma_f32_16x16x4f32(av[i], we[16 * nt], acc[nt], 0, 0, 0);
        float wg = (l15 < 8) ? p.w_gr[(size_t)(kb + i) * 8 + l15] : 0.f;
        acc[4] = __builtin_amdgcn_mfma_f32_16x16x4f32(av[i], wg, acc[4], 0, 0, 0);
      }
    }
#pragma unroll
    for (int nt = 0; nt < 5; nt++)
#pragma unroll
      for (int r = 0; r < 4; r++) part[(w * 16 + kg * 4 + r) * 80 + nt * 16 + l15] = acc[nt][r];
    __syncthreads();
    for (int idx = tid; idx < 16 * 72; idx += 256) {
      const int r = idx / 72, c = idx % 72;
      logits[r * 72 + c] = part[(0 * 16 + r) * 80 + c] + part[(1 * 16 + r) * 80 + c] + part[(2 * 16 + r) * 80 + c] + part[(3 * 16 + r) * 80 + c];
    }
    __syncthreads();
    if (tid < 16) {
      const float* L = logits + tid * 72;
      const int tok = row0 + tid;
      float gm = L[64]; int gi = 0;
      for (int i = 1; i < 8; i++) if (L[64 + i] > gm) { gm = L[64 + i]; gi = i; }
      float gs = 0.f;
      for (int i = 0; i < 8; i++) gs += expf(L[64 + i] - gm);
      const float pg = 1.f / gs;
      const float* E = L + gi * 8;
      float em = E[0]; int i1 = 0;
      for (int i = 1; i < 8; i++) if (E[i] > em) { em = E[i]; i1 = i; }
      float e2 = -3.0e38f; int i2 = 0;
      for (int i = 0; i < 8; i++) if (i != i1 && E[i] > e2) { e2 = E[i]; i2 = i; }
      const float p1 = 1.f, p2 = expf(e2 - em);
      const float gt1 = pg * p1 / (p1 + p2), gt2 = pg * p2 / (p1 + p2);
      const int ex1 = gi * 8 + i1, ex2 = gi * 8 + i2;
      const int pos1 = atomicAdd(&p.cnt[ex1], 1);
      const int pos2 = atomicAdd(&p.cnt[ex2], 1);
      p.list_tok[ex1 * CAP + pos1] = tok; p.list_gate[ex1 * CAP + pos1] = gt1;
      p.list_tok[ex2 * CAP + pos2] = tok; p.list_gate[ex2 * CAP + pos2] = gt2;
      p.tok_e[tok * 2] = ex1; p.tok_e[tok * 2 + 1] = ex2;
      p.tok_pos[tok * 2] = pos1; p.tok_pos[tok * 2 + 1] = pos2;
    }
    __syncthreads();
  }
}

__device__ __forceinline__ void moe_prefix(const Params& p, int* s_off, int* s_rb) {
  __syncthreads();
  if (threadIdx.x == 0) {
    int o = 0, r = 0;
    for (int e = 0; e < NEXP; e++) {
      s_off[e] = o; s_rb[e] = r;
      int c = p.cnt[e];
      o += c; r += (c + 127) >> 7;
    }
    s_off[NEXP] = o; s_rb[NEXP] = r;
  }
  __syncthreads();
}

__device__ void phaseE1(const Params& p, char* smem) {
  int* s_off = (int*)(smem + 2 * GEMM_SMEM);
  int* s_rb = s_off + 72;
  moe_prefix(p, s_off, s_rb);
  xcd_queue_run(p.bar + QW_BASE + 1024, s_rb[NEXP], smem + 2 * GEMM_SMEM + 800, [&](int j, int q) {
    const int rbg = q, jt = j;
    int e = 0;
    while (s_rb[e + 1] <= rbg) e++;
    const int rb = rbg - s_rb[e];
    const int cnt = p.cnt[e];
    const int rows = min(128, cnt - rb * 128);
    const int* lt = p.list_tok + e * CAP + rb * 128;
    const int slot0 = s_off[e] + rb * 128;
    const int j0 = jt * 64;
    const u16* wg = p.WgT + (size_t)e * DEXP * DM;
    const u16* wu = p.WuT + (size_t)e * DEXP * DM;
    auto rowf = [&](int r) { int rr = r < rows ? r : 0; return (const void*)(p.X1B + (size_t)lt[rr] * DM); };
    auto colf = [&](int c) { return (const void*)(((c & 32) ? wu : wg) + (size_t)(j0 + (c >> 6) * 32 + (c & 31)) * DM); };
    auto epi = [&](f32x4 (&acc)[4][4], int mb, int nb) {
      const int wn = nb >> 6, kg4 = nb & 63;
#pragma unroll
      for (int mi = 0; mi < 4; mi++) {
        const int r = mb + mi * 16;
        if (r < rows) {
#pragma unroll
          for (int ni = 0; ni < 2; ni++) {
            f32x4 gv = acc[mi][ni], uv = acc[mi][ni + 2];
            uint2 o;
            o.x = pack2(siluf(gv[0]) * uv[0], siluf(gv[1]) * uv[1]);
            o.y = pack2(siluf(gv[2]) * uv[2], siluf(gv[3]) * uv[3]);
            *(uint2*)&p.H[(size_t)(slot0 + r) * DEXP + j0 + wn * 32 + ni * 16 + kg4] = o;
          }
        }
      }
    };
    gemm_tile<true, true>(smem, DM, rowf, colf, DEXP, epi);
  });
}

__device__ void phaseE2(const Params& p, char* smem) {
  int* s_off = (int*)(smem + 2 * GEMM_SMEM);
  int* s_rb = s_off + 72;
  moe_prefix(p, s_off, s_rb);
  xcd_queue_run(p.bar + QW_BASE + 1536, s_rb[NEXP], smem + 2 * GEMM_SMEM + 800, [&](int j, int q) {
    const int rbg = q, nt = j;
    int e = 0;
    while (s_rb[e + 1] <= rbg) e++;
    const int rb = rbg - s_rb[e];
    const int cnt = p.cnt[e];
    const int rows = min(128, cnt - rb * 128);
    const int slot0 = s_off[e] + rb * 128;
    const int n0 = nt * 128;
    const float* wd = p.w_down + (size_t)e * DEXP * DM;
    const float* lg = p.list_gate + e * CAP + rb * 128;
    auto rowf = [&](int r) { int rr = r < rows ? r : 0; return (const void*)(p.H + (size_t)(slot0 + rr) * DEXP); };
    auto colf = [&](int c) { return (const void*)(wd + n0 + c); };
    auto epi = [&](f32x4 (&acc)[4][4], int mb, int nb) {
#pragma unroll
      for (int mi = 0; mi < 4; mi++) {
        const int r = mb + mi * 16;
        if (r < rows) {
          const float gt = lg[r];
#pragma unroll
          for (int ni = 0; ni < 4; ni++) {
            f32x4 v = acc[mi][ni];
            uint2 o; o.x = pack2(gt * v[0], gt * v[1]); o.y = pack2(gt * v[2], gt * v[3]);
            *(uint2*)&p.Y[(size_t)(slot0 + r) * DM + n0 + nb + ni * 16] = o;
          }
        }
      }
    };
    gemm_tile<true, false>(smem, DEXP, rowf, colf, DM, epi);
  });
}

__device__ void phaseF(const Params& p, char* smem) {
  int* s_off = (int*)(smem + 2 * GEMM_SMEM);
  int* s_rb = s_off + 72;
  moe_prefix(p, s_off, s_rb);
  const int tid = threadIdx.x, lane = tid & 63, w = tid >> 6;
  for (int row = blockIdx.x * 4 + w; row < NTOK; row += gridDim.x * 4) {
    const int s0 = s_off[p.tok_e[row * 2]] + p.tok_pos[row * 2];
    const int s1 = s_off[p.tok_e[row * 2 + 1]] + p.tok_pos[row * 2 + 1];
    float4 v[4];
    float s = 0.f;
#pragma unroll
    for (int i = 0; i < 4; i++) {
      const int c = lane * 4 + 256 * i;
      float4 xv = *(const float4*)&p.X1[(size_t)row * DM + c];
      uint2 ya = *(const uint2*)&p.Y[(size_t)s0 * DM + c];
      uint2 yb = *(const uint2*)&p.Y[(size_t)s1 * DM + c];
      v[i].x = ALPHA * xv.x + (bflo(ya.x) + bflo(yb.x));
      v[i].y = ALPHA * xv.y + (bfhi(ya.x) + bfhi(yb.x));
      v[i].z = ALPHA * xv.z + (bflo(ya.y) + bflo(yb.y));
      v[i].w = ALPHA * xv.w + (bfhi(ya.y) + bfhi(yb.y));
      s += v[i].x + v[i].y + v[i].z + v[i].w;
    }
    const float mu = wave_sum(s) * (1.f / 1024.f);
    float q = 0.f;
#pragma unroll
    for (int i = 0; i < 4; i++) {
      v[i].x -= mu; v[i].y -= mu; v[i].z -= mu; v[i].w -= mu;
      q += v[i].x * v[i].x + v[i].y * v[i].y + v[i].z * v[i].z + v[i].w * v[i].w;
    }
    const float rstd = rsqrtf(wave_sum(q) * (1.f / 1024.f) + LN_EPS);
#pragma unroll
    for (int i = 0; i < 4; i++) {
      const int c = lane * 4 + 256 * i;
      float4 gg = *(const float4*)&p.ln2_g[c], b4 = *(const float4*)&p.ln2_b[c];
      *(float4*)&p.out[(size_t)row * DM + c] =
          make_float4(v[i].x * rstd * gg.x + b4.x, v[i].y * rstd * gg.y + b4.y, v[i].z * rstd * gg.z + b4.z, v[i].w * rstd * gg.w + b4.w);
    }
  }
}


#define XB_TMO      128
#define XB_XCNT(j)  (256  + 64 * (j))
#define XB_XSUB(j)  (1280 + 64 * (j))
#define XB_XGEN(j)  (2304 + 64 * (j))
#define XB_TOP      3328
#define XB_TOPGEN   3392
#define XCD_BAR_WORDS 3456
#define XB_SPIN_CAP (1u << 18)
#define LAS __attribute__((address_space(3)))
__device__ __forceinline__ unsigned xb_ld(unsigned* p)              { return __hip_atomic_load(p, __ATOMIC_RELAXED, __HIP_MEMORY_SCOPE_AGENT); }
__device__ __forceinline__ unsigned xb_add(unsigned* p, unsigned v) { return __hip_atomic_fetch_add(p, v, __ATOMIC_RELAXED, __HIP_MEMORY_SCOPE_AGENT); }
__device__ __forceinline__ unsigned xb_xcc_id() { return (unsigned)__builtin_amdgcn_s_getreg((3 << 11) | 20) & 0xFu; }
#define XB_SPIN(cond, bar) do { unsigned _sp = 0; while (cond) { __builtin_amdgcn_s_sleep(1); \
    if ((++_sp & 255u) == 0u) { if (xb_ld(&(bar)[XB_TMO])) break; if (_sp > XB_SPIN_CAP) { atomicAdd(&(bar)[XB_TMO], 1u); break; } } } } while (0)
struct XcdBarrier { unsigned* bar; unsigned x; volatile LAS unsigned* st; };
__device__ __forceinline__ XcdBarrier xcd_barrier_post(unsigned* bar, volatile LAS unsigned* st) {
  XcdBarrier b; b.bar = bar; b.x = xb_xcc_id(); b.st = st;
  if (threadIdx.x == 0) (void)xb_add(&bar[XB_XCNT(b.x)], 1u);
  return b;
}
__device__ __forceinline__ void xcd_barrier_complete(unsigned* bar, unsigned x, unsigned& nloc, unsigned& nx) {
  const unsigned G = gridDim.x * gridDim.y * gridDim.z;
  unsigned sum, cnt, mine, sp = 0u;
  for (;;) {
    sum = 0u; cnt = 0u; mine = 0u;
#pragma unroll
    for (unsigned j = 0; j < 16; ++j) { const unsigned c = xb_ld(&bar[XB_XCNT(j)]); sum += c; cnt += (c > 0u) ? 1u : 0u; mine = (j == x) ? c : mine; }
    if (sum == G) break;
    __builtin_amdgcn_s_sleep(1);
    if ((++sp & 255u) == 0u) { if (xb_ld(&bar[XB_TMO])) break; if (sp > XB_SPIN_CAP) { atomicAdd(&bar[XB_TMO], 1u); break; } }
  }
  nloc = mine > 0u ? mine : 1u; nx = cnt > 0u ? cnt : 1u;
}
__device__ __forceinline__ void xcd_barrier(const XcdBarrier& b) {
  asm volatile("s_waitcnt vmcnt(0)" ::: "memory");
  __syncthreads();
  if (threadIdx.x == 0) {
    unsigned* bar = b.bar;
    __builtin_amdgcn_s_waitcnt(0);
    unsigned nloc = b.st[0], nx = b.st[1];
    if (nloc == 0u) { xcd_barrier_complete(bar, b.x, nloc, nx); b.st[0] = nloc; b.st[1] = nx; }
    const unsigned old = xb_add(&bar[XB_XSUB(b.x)], 1u);
    const unsigned gen = old / nloc;
    if (old + 1u == (gen + 1u) * nloc) {
      __builtin_amdgcn_fence(__ATOMIC_RELEASE, "agent");
      asm volatile("s_waitcnt vmcnt(0)" ::: "memory");
      const unsigned og = xb_add(&bar[XB_TOP], 1u);
      const unsigned tg = og / nx;
      if (og + 1u == (tg + 1u) * nx) xb_add(&bar[XB_TOPGEN], 1u);
      else XB_SPIN(xb_ld(&bar[XB_TOPGEN]) == tg, bar);
      __builtin_amdgcn_fence(__ATOMIC_ACQUIRE, "agent");
      xb_add(&bar[XB_XGEN(b.x)], 1u);
      asm volatile("s_waitcnt vmcnt(0)" ::: "memory");
    } else {
      XB_SPIN(xb_ld(&bar[XB_XGEN(b.x)]) == gen, bar);
      __builtin_amdgcn_fence(__ATOMIC_ACQUIRE, "agent");
      asm volatile("s_waitcnt vmcnt(0)" ::: "memory");
    }
  }
  __syncthreads();
}

constexpr int AUX_OFF = 2 * GEMM_SMEM;
constexpr int SMEM_BYTES = AUX_OFF + 1024;

#if SINGLE
__global__ void __launch_bounds__(256, 2) fwd_megakernel(Params p) {
  extern __shared__ __attribute__((aligned(16))) char smem[];
  cg::grid_group grid = cg::this_grid();
  volatile LAS unsigned* st = (volatile LAS unsigned*)(smem + AUX_OFF + 768);
  if (threadIdx.x < 2) st[threadIdx.x] = 0u;
  __syncthreads();
  XcdBarrier xb = xcd_barrier_post(p.bar, st);
  if (p.use_cg) grid.sync();
  phaseP0(p, smem);
  xcd_barrier(xb);
  phaseA(p, smem);
  xcd_barrier(xb);
  phaseB0(p, smem);
  xcd_barrier(xb);
  phaseB(p, smem);
  xcd_barrier(xb);
  phaseC(p, smem);
  xcd_barrier(xb);
  phaseD(p, smem);
  xcd_barrier(xb);
  phaseE1(p, smem);
  xcd_barrier(xb);
  phaseE2(p, smem);
  xcd_barrier(xb);
  phaseF(p, smem);
}
#else
#define PHASE_KERNEL(NAME, FN)                                             \
  __global__ void __launch_bounds__(256, 2) NAME(Params p) {                  \
    __shared__ __attribute__((aligned(16))) char smem[SMEM_BYTES];         \
    FN(p, smem);                                                           \
  }
PHASE_KERNEL(kA, phaseA)
PHASE_KERNEL(kB, phaseB)
PHASE_KERNEL(kC, phaseC)
PHASE_KERNEL(kD, phaseD)
PHASE_KERNEL(kE1, phaseE1)
PHASE_KERNEL(kE2, phaseE2)
PHASE_KERNEL(kF, phaseF)
#endif

extern "C" void kernel_launch(void* const* d_in, const int* in_sizes, int n_in, void* d_out, int out_size,
                              void* d_ws, size_t ws_size, hipStream_t stream) {
  Params p{};
  p.x = (const float*)d_in[0];
  p.w_in = (const float*)d_in[1];
  p.w_a2 = (const float*)d_in[2];
  p.b_a = (const float*)d_in[3];
  p.lb = (const float*)d_in[4];
  p.norm_h = (const float*)d_in[5];
  p.norm_g = (const float*)d_in[6];
  p.w_out = (const float*)d_in[7];
  p.ln1_g = (const float*)d_in[8];
  p.ln1_b = (const float*)d_in[9];
  p.w_gr = (const float*)d_in[10];
  p.w_er = (const float*)d_in[11];
  p.w_gate = (const float*)d_in[12];
  p.w_up = (const float*)d_in[13];
  p.w_down = (const float*)d_in[14];
  p.ln2_g = (const float*)d_in[15];
  p.ln2_b = (const float*)d_in[16];
  p.out = (float*)d_out;
  char* ws = (char*)d_ws;
  size_t off = 0;
  auto take = [&](size_t bytes) { char* r = ws + off; off += (bytes + 255) & ~(size_t)255; return r; };
  p.P = (u16*)take((size_t)NTOK * INC * 2);
  p.LF = (float*)take((size_t)NTOK * 512 * 4);
  p.GA = (float*)take((size_t)NTOK * 16 * 4);
  p.Z = (float*)take((size_t)NTOK * DM * 4);
  p.O = (u16*)take((size_t)NTOK * DM * 2);
  p.X1 = (float*)take((size_t)NTOK * DM * 4);
  p.X1B = (u16*)take((size_t)NTOK * DM * 2);
  p.cnt = (int*)take(256);
  p.tok_e = (int*)take((size_t)NTOK * 2 * 4);
  p.tok_pos = (int*)take((size_t)NTOK * 2 * 4);
  p.list_tok = (int*)take((size_t)NEXP * CAP * 4);
  p.list_gate = (float*)take((size_t)NEXP * CAP * 4);
  p.bar = (unsigned*)take((XCD_BAR_WORDS + 2048) * 4);
  p.XB = p.O;
  p.WgT = (u16*)take((size_t)NEXP * DEXP * DM * 2);
  p.WuT = (u16*)take((size_t)NEXP * DEXP * DM * 2);
  p.IMGH = (char*)p.X1;
  p.IMGG = (char*)p.Z;
  p.WinT = (u16*)take((size_t)INC * DM * 2);
  p.WoutT = (u16*)take((size_t)DM * DM * 2);
  p.use_cg = 0; p.pad_ = 0;
  p.H = p.P;
  p.Y = p.P + (size_t)32768 * DEXP;

#if SINGLE
  static int grid_blocks = 0;
  if (!grid_blocks) {
    int dev = 0, cus = 0, per_cu = 0;
    hipGetDevice(&dev);
    hipDeviceGetAttribute(&cus, hipDeviceAttributeMultiprocessorCount, dev);
    if (hipFuncSetAttribute((const void*)fwd_megakernel, hipFuncAttributeMaxDynamicSharedMemorySize, SMEM_BYTES) != hipSuccess)
      fprintf(stderr, "hipFuncSetAttribute failed\n");
    hipOccupancyMaxActiveBlocksPerMultiprocessor(&per_cu, fwd_megakernel, 256, SMEM_BYTES);
    if (per_cu > 2) per_cu = 2;
    grid_blocks = cus * per_cu;
  }
  hipMemsetAsync(p.bar, 0, (XCD_BAR_WORDS + 2048) * 4, stream);
  void* args[] = {&p};
  hipError_t e = hipLaunchCooperativeKernel((void*)fwd_megakernel, dim3(grid_blocks), dim3(256), args, SMEM_BYTES, stream);
  if (e != hipSuccess) fprintf(stderr, "cooperative launch failed: %s (grid %d)\n", hipGetErrorString(e), grid_blocks);
#else
  const int G = 512;
  kA<<<G, 256, 0, stream>>>(p);
  kB<<<64, 256, 0, stream>>>(p);
  kC<<<G, 256, 0, stream>>>(p);
  kD<<<G, 256, 0, stream>>>(p);
  kE1<<<G, 256, 0, stream>>>(p);
  kE2<<<G, 256, 0, stream>>>(p);
  kF<<<G, 256, 0, stream>>>(p);
#endif
}
```

```cpp
#include <hip/hip_runtime.h>
#include <hip/hip_cooperative_groups.h>
#include <cstdio>
namespace cg = cooperative_groups;

#ifndef SINGLE
#define SINGLE 1
#endif

typedef unsigned short u16;
typedef __attribute__((ext_vector_type(8))) short bf16x8;
typedef __attribute__((ext_vector_type(4))) short bf16x4;
typedef __attribute__((ext_vector_type(4))) float f32x4;
typedef __bf16 bf16x2_t __attribute__((ext_vector_type(2)));
typedef float f32x2_t __attribute__((ext_vector_type(2)));
typedef unsigned u32x4 __attribute__((ext_vector_type(4)));
typedef unsigned u32x2 __attribute__((ext_vector_type(2)));

constexpr int NTOK = 16384;
constexpr int SEQ = 2048;
constexpr int DM = 1024;
constexpr int INC = 3600;
constexpr int NEXP = 64;
constexpr int DEXP = 512;
constexpr int CAP = 32768;
constexpr float ALPHA = 1.189207115002721f;
constexpr float LN_EPS = 1e-5f;

struct Params {
  const float *x, *w_in, *w_a2, *b_a, *lb, *norm_h, *norm_g, *w_out, *ln1_g, *ln1_b, *w_gr, *w_er,
      *w_gate, *w_up, *w_down, *ln2_g, *ln2_b;
  float* out;
  u16* P;
  float* LF;
  float* GA;
  float* Z;
  u16* O;
  float* X1;
  u16* X1B;
  u16* H;
  u16* Y;
  int* cnt;
  int* tok_e;
  int* tok_pos;
  int* list_tok;
  float* list_gate;
  u16* XB;
  u16* WinT;
  u16* WoutT;
  u16* WgT;
  u16* WuT;
  char* IMGH;
  char* IMGG;
  unsigned* bar;
  int use_cg; int pad_;
};

__device__ __forceinline__ unsigned pack2(float a, float b) {
  f32x2_t f = {a, b};
  bf16x2_t h = __builtin_convertvector(f, bf16x2_t);
  return *(unsigned*)&h;
}
__device__ __forceinline__ u16 f2bf(float a) {
  __bf16 h = (__bf16)a;
  return *(u16*)&h;
}
__device__ __forceinline__ float bf2f(u16 v) { return __uint_as_float(((unsigned)v) << 16); }
__device__ __forceinline__ float bflo(unsigned v) { return __uint_as_float(v << 16); }
__device__ __forceinline__ float bfhi(unsigned v) { return __uint_as_float(v & 0xffff0000u); }
__device__ __forceinline__ float sigmoidf(float x) { return 1.f / (1.f + __expf(-x)); }
__device__ __forceinline__ float siluf(float x) { return x / (1.f + __expf(-x)); }


constexpr int QW_BASE = 3456;
__device__ __forceinline__ unsigned my_xcc_id() { return (unsigned)__builtin_amdgcn_s_getreg((3 << 11) | 20) & 7u; }
template <class F>
__device__ __forceinline__ void xcd_queue_run(unsigned* qwords, int nper, char* smem_aux, F fn) {
  volatile int* slot = (volatile int*)smem_aux;
  const unsigned x = my_xcc_id();
  for (int dj = 0; dj < 8; dj++) {
    const int j = (int)((x + dj) & 7u);
    for (;;) {
      __syncthreads();
      if (threadIdx.x == 0) *slot = (int)__hip_atomic_fetch_add(qwords + 64 * j, 1u, __ATOMIC_RELAXED, __HIP_MEMORY_SCOPE_AGENT);
      __syncthreads();
      const int q = *slot;
      if (q >= nper) break;
      fn(j, q);
    }
  }
}

constexpr int BM = 128, BN = 128, BK = 64, LDT = 64;
constexpr int GEMM_SMEM = (BM + BN) * LDT * 2;

template <bool ABF, bool BBF, class RowF, class ColF, class Epi>
__device__ __forceinline__ void gemm_tile(char* smem, int K, RowF rowptr, ColF colptr, int ldb, Epi epi) {
  u16* As0 = (u16*)smem;
  const int tid = threadIdx.x, lane = tid & 63, w = tid >> 6, wm = w >> 1, wn = w & 1;
  const int l15 = lane & 15, kg = lane >> 4, swz = (l15 >> 1) & 7;
  f32x4 acc[4][4];
#pragma unroll
  for (int i = 0; i < 4; i++)
#pragma unroll
    for (int j = 0; j < 4; j++) acc[i][j] = f32x4{0.f, 0.f, 0.f, 0.f};

  constexpr int NA = ABF ? 4 : 8;
  const int ar0 = ABF ? (tid >> 3) : (tid >> 4);
  const int ac = ABF ? (tid & 7) * 8 : (tid & 15) * 4;
  constexpr int ARS = ABF ? 32 : 16;
  const char* ap[NA];
#pragma unroll
  for (int i = 0; i < NA; i++) ap[i] = (const char*)rowptr(ar0 + ARS * i) + ac * (ABF ? 2 : 4);
  const int bc = tid & 127, kh = tid >> 7;
  const float* bp = BBF ? nullptr : ((const float*)colptr(bc) + (size_t)(kh * 32) * ldb);
  const int br0 = tid >> 3, bcc = (tid & 7) * 8;
  const char* bq[4];
  if (BBF) {
#pragma unroll
    for (int i = 0; i < 4; i++) bq[i] = (const char*)colptr(br0 + 32 * i) + bcc * 2;
  }

  u32x4 ra[NA];
  float rb[BBF ? 1 : 32];
  u32x4 rbb[BBF ? 4 : 1];
  auto gload = [&](int k0) {
#pragma unroll
    for (int i = 0; i < NA; i++) ra[i] = *(const u32x4*)(ap[i] + (size_t)k0 * (ABF ? 2 : 4));
    if (BBF) {
#pragma unroll
      for (int i = 0; i < 4; i++) rbb[BBF ? i : 0] = *(const u32x4*)(bq[i] + (size_t)k0 * 2);
    } else {
      const float* b = bp + (size_t)k0 * ldb;
#pragma unroll
      for (int j = 0; j < 32; j++) rb[BBF ? 0 : j] = b[(size_t)j * ldb];
    }
  };
  auto sstore = [&](int buf) {
    u16* As = As0 + buf * (GEMM_SMEM / 2);
    u16* Bs = As + BM * LDT;
#pragma unroll
    for (int i = 0; i < NA; i++) {
      if (ABF) {
        { const int row = ar0 + ARS * i; *(u32x4*)&As[row * LDT + (((ac >> 3) ^ ((row >> 1) & 7)) << 3)] = ra[i]; }
      } else {
        u32x2 v;
        v[0] = pack2(__uint_as_float(ra[i][0]), __uint_as_float(ra[i][1]));
        v[1] = pack2(__uint_as_float(ra[i][2]), __uint_as_float(ra[i][3]));
        { const int row = ar0 + ARS * i; *(u32x2*)&As[row * LDT + (((ac >> 3) ^ ((row >> 1) & 7)) << 3) + (ac & 4)] = v; }
      }
    }
    if (BBF) {
#pragma unroll
      for (int i = 0; i < 4; i++) { const int row = br0 + 32 * i; *(u32x4*)&Bs[row * LDT + (((bcc >> 3) ^ ((row >> 1) & 7)) << 3)] = rbb[BBF ? i : 0]; }
    } else {
#pragma unroll
      for (int j = 0; j < 4; j++) {
        u32x4 v;
        v[0] = pack2(rb[BBF ? 0 : 8 * j + 0], rb[BBF ? 0 : 8 * j + 1]);
        v[1] = pack2(rb[BBF ? 0 : 8 * j + 2], rb[BBF ? 0 : 8 * j + 3]);
        v[2] = pack2(rb[BBF ? 0 : 8 * j + 4], rb[BBF ? 0 : 8 * j + 5]);
        v[3] = pack2(rb[BBF ? 0 : 8 * j + 6], rb[BBF ? 0 : 8 * j + 7]);
        *(u32x4*)&Bs[bc * LDT + (((kh * 4 + j) ^ ((bc >> 1) & 7)) << 3)] = v;
      }
    }
  };

  gload(0);
  sstore(0);
  __syncthreads();
  int cur = 0;
  for (int k0 = 0; k0 < K; k0 += BK) {
    if (k0 + BK < K) gload(k0 + BK);
    const u16* As = As0 + cur * (GEMM_SMEM / 2);
    const u16* Bs = As + BM * LDT;
    {
      bf16x8 af[2][4], bfr[2][4];
#pragma unroll
      for (int ks = 0; ks < 2; ks++) {
#pragma unroll
        for (int mi = 0; mi < 4; mi++) af[ks][mi] = *(const bf16x8*)&As[(wm * 64 + mi * 16 + l15) * LDT + (((ks * 4 + kg) ^ swz) << 3)];
#pragma unroll
        for (int ni = 0; ni < 4; ni++) bfr[ks][ni] = *(const bf16x8*)&Bs[(wn * 64 + ni * 16 + l15) * LDT + (((ks * 4 + kg) ^ swz) << 3)];
      }
      __builtin_amdgcn_sched_barrier(0);
#pragma unroll
      for (int ks = 0; ks < 2; ks++)
#pragma unroll
        for (int mi = 0; mi < 4; mi++)
#pragma unroll
          for (int ni = 0; ni < 4; ni++)
            acc[mi][ni] = __builtin_amdgcn_mfma_f32_16x16x32_bf16(bfr[ks][ni], af[ks][mi], acc[mi][ni], 0, 0, 0);
      __builtin_amdgcn_sched_barrier(0);
    }
    if (k0 + BK < K) sstore(cur ^ 1);
    __syncthreads();
    cur ^= 1;
  }
  epi(acc, wm * 64 + l15, wn * 64 + kg * 4);
}


__device__ void transpose_tile(const float* W, int ld, int N, int k0, int n0, u16* WT, int K, char* smem) {
  u16* T = (u16*)smem;
  const int tid = threadIdx.x;
  __syncthreads();
  {
    const int r = tid >> 4, c4 = (tid & 15) * 4;
#pragma unroll
    for (int i = 0; i < 4; i++) {
      const int k = r + 16 * i;
      float4 v = make_float4(0.f, 0.f, 0.f, 0.f);
      if (n0 + c4 < N) v = *(const float4*)&W[(size_t)(k0 + k) * ld + n0 + c4];
      T[(c4 + 0) * 72 + k] = f2bf(v.x); T[(c4 + 1) * 72 + k] = f2bf(v.y);
      T[(c4 + 2) * 72 + k] = f2bf(v.z); T[(c4 + 3) * 72 + k] = f2bf(v.w);
    }
  }
  __syncthreads();
  {
    const int n = tid >> 2, seg = (tid & 3) * 16;
    if (n0 + n < N) {
      u32x4 a = *(const u32x4*)&T[n * 72 + seg], b = *(const u32x4*)&T[n * 72 + seg + 8];
      *(u32x4*)&WT[(size_t)(n0 + n) * K + k0 + seg] = a;
      *(u32x4*)&WT[(size_t)(n0 + n) * K + k0 + seg + 8] = b;
    }
  }
}
__device__ void phaseP0(const Params& p, char* smem) {
  if (blockIdx.x == 0 && threadIdx.x < 64) p.cnt[threadIdx.x] = 0;
  constexpr int NTI = 57 * 16, NTO = 16 * 16;
  for (int u = blockIdx.x; u < NTI + NTO; u += gridDim.x) {
    if (u < NTI) transpose_tile(p.w_in, INC, INC, (u % 16) * 64, (u / 16) * 64, p.WinT, DM, smem);
    else { const int v = u - NTI; transpose_tile(p.w_out, DM, DM, (v % 16) * 64, (v / 16) * 64, p.WoutT, DM, smem); }
  }
  const size_t n4 = (size_t)NTOK * DM / 4;
  for (size_t i = blockIdx.x * (size_t)256 + threadIdx.x; i < n4; i += (size_t)gridDim.x * 256) {
    float4 v = ((const float4*)p.x)[i];
    uint2 o; o.x = pack2(v.x, v.y); o.y = pack2(v.z, v.w);
    ((uint2*)p.XB)[i] = o;
  }
}

__device__ void phaseA(const Params& p, char* smem) {
  xcd_queue_run(p.bar + QW_BASE, 464, smem + 2 * GEMM_SMEM + 800, [&](int j, int q) {
    const int pj = j >> 1, odd = j & 1;
    int mt, nt;
    if (q < 384) { mt = q / 3; nt = 7 * pj + odd * 4 + q % 3; }
    else if (q < 448) { mt = odd * 64 + (q - 384); nt = 7 * pj + 3; }
    else { mt = 16 * j + (q - 448); nt = 28; }
    const int m0 = mt * 128, n0 = nt * 128;
    const u16* xa = p.XB + (size_t)m0 * DM;
    auto rowf = [&](int r) { return (const void*)(xa + (size_t)r * DM); };
    auto colf = [&](int c) { int n = n0 + c; if (n > INC - 1) n = INC - 1; return (const void*)(p.WinT + (size_t)n * DM); };
    auto epi = [&](f32x4 (&acc)[4][4], int mb, int nb) {
#pragma unroll
      for (int mi = 0; mi < 4; mi++)
#pragma unroll
        for (int ni = 0; ni < 4; ni++) {
          const int m = m0 + mb + mi * 16, n = n0 + nb + ni * 16;
          f32x4 v = acc[mi][ni];
          if (n >= INC) continue;
          if (n >= 512 && n < 1024) {
            const int c = n - 512;
            float lf[4], kf[4];
#pragma unroll
            for (int r = 0; r < 4; r++) {
              float lbv = sigmoidf(p.lb[c + r] - p.lb[512 + c + r]);
              float sg = sigmoidf(v[r]);
              float f = lbv + (1.f - lbv) * sg;
              lf[r] = __logf(f);
              kf[r] = (1.f - lbv) * (1.f - sg);
            }
            *(float4*)&p.LF[(size_t)m * 512 + c] = make_float4(lf[0], lf[1], lf[2], lf[3]);
            uint2 o; o.x = pack2(kf[0], kf[1]); o.y = pack2(kf[2], kf[3]);
            *(uint2*)&p.P[(size_t)m * INC + n] = o;
          } else if (n >= 3072 && n < 3088) {
            *(float4*)&p.GA[(size_t)m * 16 + (n - 3072)] = make_float4(v[0], v[1], v[2], v[3]);
          } else {
            if (n < 512) { v *= 0.08838834764831845f; }
            else if ((n >= 1536 && n < 2048) || n >= 3088) {
#pragma unroll
              for (int r = 0; r < 4; r++) v[r] = siluf(v[r]);
            } else if (n >= 2048 && n < 2304) { v *= 0.125f; }
            uint2 o; o.x = pack2(v[0], v[1]); o.y = pack2(v[2], v[3]);
            *(uint2*)&p.P[(size_t)m * INC + n] = o;
          }
        }
    };
    gemm_tile<true, true>(smem, DM, rowf, colf, INC, epi);
  });
}

__device__ __forceinline__ float dpp_scan_add(float x) {
  int xi;
  xi = __builtin_amdgcn_update_dpp(0, __float_as_int(x), 0x111, 0xf, 0xf, true); x += __int_as_float(xi);
  xi = __builtin_amdgcn_update_dpp(0, __float_as_int(x), 0x112, 0xf, 0xf, true); x += __int_as_float(xi);
  xi = __builtin_amdgcn_update_dpp(0, __float_as_int(x), 0x114, 0xf, 0xf, true); x += __int_as_float(xi);
  xi = __builtin_amdgcn_update_dpp(0, __float_as_int(x), 0x118, 0xf, 0xf, true); x += __int_as_float(xi);
  return x;
}


__device__ __forceinline__ float dpp_row_bcast15(float x) {
  return __int_as_float(__builtin_amdgcn_update_dpp(0, __float_as_int(x), 0x15F, 0xf, 0xf, false));
}
__device__ __forceinline__ float dpp_row_sum(float x) {
  x += __int_as_float(__builtin_amdgcn_update_dpp(0, __float_as_int(x), 0x128, 0xf, 0xf, false));
  x += __int_as_float(__builtin_amdgcn_update_dpp(0, __float_as_int(x), 0x124, 0xf, 0xf, false));
  x += __int_as_float(__builtin_amdgcn_update_dpp(0, __float_as_int(x), 0x122, 0xf, 0xf, false));
  x += __int_as_float(__builtin_amdgcn_update_dpp(0, __float_as_int(x), 0x121, 0xf, 0xf, false));
  return x;
}

#define STAGE() do { } while (0)
template <int DK, bool HG, int MODE>
__device__ void recur_unit(const Params& p, char* smem, int b, int h, char* img, int nstart, int nstep) {
  constexpr int IMG = (2 * 16 * (DK + 8) + DK * 20 + 128 * 20) * 2 + DK * 4;
  constexpr int NIM = (IMG + 4095) / 4096;
  constexpr int KPT = DK / 16;
  constexpr int NKS = DK / 32;
  constexpr int NKT = DK / 16;
  constexpr int LQ = DK + 8;
  u16* Qt = (u16*)smem;
  u16* Kt = Qt + 16 * LQ;
  u16* KhT = Kt + 16 * LQ;
  u16* VT = KhT + DK * 20;
  float* Gch = (float*)(VT + 128 * 20);
  float* SS = Gch + DK;
  float* Wa = SS + 64;
  u16* GT = (u16*)(smem + 20480);
  u16* OT = (u16*)(smem + 24832);

  const int tid = threadIdx.x, lane = tid & 63, w = tid >> 6, l15 = lane & 15, kg = lane >> 4;
  const int t = tid & 15, kgp = tid >> 4, k0 = kgp * KPT;
  const int qcol = HG ? (h * 128) : (2048 + h * 64);
  const int kcol = HG ? (512 + h * 128) : (2304 + h * 64);
  const int vcol = HG ? (1024 + h * 128) : (2560 + h * 128);
  const int gcol = HG ? (1536 + h * 128) : (3088 + h * 128);
  const int ocol = HG ? (h * 128) : (512 + h * 128);
  const float* gain = HG ? p.norm_h : p.norm_g;

  float ba[KPT];
  if (!HG && MODE == 1) {
    __syncthreads();
    for (int i = tid; i < 16 * 64; i += 256) Wa[i] = p.w_a2[(i >> 6) * 256 + h * 64 + (i & 63)];
#pragma unroll
    for (int i = 0; i < KPT; i++) ba[i] = p.b_a[h * 64 + k0 + i];
    __syncthreads();
  }
  const float g0 = gain[h * 128 + w * 32 + l15], g1 = gain[h * 128 + w * 32 + 16 + l15];

  f32x4 S[NKT][2];
#pragma unroll
  for (int i = 0; i < NKT; i++) { S[i][0] = f32x4{0, 0, 0, 0}; S[i][1] = f32x4{0, 0, 0, 0}; }

  float4 pl[4];
  uint4 pq, pk, pv;
  u16 psg[8];
  u32x4 imA[NIM], imB[NIM];
  u16 psgB[8];
  auto prefetch = [&](int n, u32x4 (&im)[NIM], u16 (&psg)[8]) {
    if (MODE == 2) {
      const char* src = img + (size_t)n * IMG;
#pragma unroll
      for (int i = 0; i < NIM; i++) if (tid * 16 + 4096 * i < IMG) im[i] = *(const u32x4*)(src + tid * 16 + 4096 * i);
      {
        const u32x4 g = *(const u32x4*)(p.P + ((size_t)b * SEQ + n * 16 + (tid >> 4)) * INC + gcol + (tid & 15) * 8);
        psg[0] = (u16)(g[0] & 0xffff); psg[1] = (u16)(g[0] >> 16); psg[2] = (u16)(g[1] & 0xffff); psg[3] = (u16)(g[1] >> 16);
        psg[4] = (u16)(g[2] & 0xffff); psg[5] = (u16)(g[2] >> 16); psg[6] = (u16)(g[3] & 0xffff); psg[7] = (u16)(g[3] >> 16);
      }
      return;
    }
    const size_t tok = (size_t)b * SEQ + n * 16 + t;
    const u16* prow = p.P + tok * INC;
    if (HG) {
      pl[0] = *(const float4*)&p.LF[tok * 512 + h * 128 + k0];
      pl[1] = *(const float4*)&p.LF[tok * 512 + h * 128 + k0 + 4];
      pq = *(const uint4*)&prow[qcol + k0];
      pk = *(const uint4*)&prow[kcol + k0];
    } else {
#pragma unroll
      for (int i = 0; i < 4; i++) pl[i] = *(const float4*)&p.GA[tok * 16 + 4 * i];
      uint2 a = *(const uint2*)&prow[qcol + k0];
      uint2 c = *(const uint2*)&prow[kcol + k0];
      pq.x = a.x; pq.y = a.y; pk.x = c.x; pk.y = c.y;
    }
    pv = *(const uint4*)&prow[vcol + kgp * 8];
  };

  constexpr int PFD = (MODE == 2) ? 2 : 1;
  auto step = [&](int n, u32x4 (&im)[NIM], u16 (&psg)[8]) {
    float sgate[8];
    if (MODE == 2) {
#pragma unroll
      for (int i = 0; i < NIM; i++) if (tid * 16 + 4096 * i < IMG) *(u32x4*)(smem + tid * 16 + 4096 * i) = im[i];
      {
        u32x4 g;
        g[0] = (unsigned)psg[0] | ((unsigned)psg[1] << 16); g[1] = (unsigned)psg[2] | ((unsigned)psg[3] << 16);
        g[2] = (unsigned)psg[4] | ((unsigned)psg[5] << 16); g[3] = (unsigned)psg[6] | ((unsigned)psg[7] << 16);
        *(u32x4*)&GT[(tid >> 4) * 136 + (tid & 15) * 8] = g;
      }
      __builtin_amdgcn_sched_barrier(0);
      if (n + PFD * nstep < SEQ / 16) prefetch(n + PFD * nstep, im, psg);
      __builtin_amdgcn_sched_barrier(0);
    } else {
    float lg[KPT], qv[KPT], kv[KPT];
    if (HG) {
      lg[0] = pl[0].x; lg[1] = pl[0].y; lg[2] = pl[0].z; lg[3] = pl[0].w;
      if (KPT > 4) { lg[4 % KPT] = pl[1].x; lg[5 % KPT] = pl[1].y; lg[6 % KPT] = pl[1].z; lg[7 % KPT] = pl[1].w; }
    } else {
      float ga[16] = {pl[0].x, pl[0].y, pl[0].z, pl[0].w, pl[1].x, pl[1].y, pl[1].z, pl[1].w,
                      pl[2].x, pl[2].y, pl[2].z, pl[2].w, pl[3].x, pl[3].y, pl[3].z, pl[3].w};
      float z[4] = {ba[0], ba[1], ba[2], ba[3]};
#pragma unroll
      for (int r = 0; r < 16; r++) {
        float4 wv = *(const float4*)&Wa[r * 64 + k0];
        z[0] += ga[r] * wv.x; z[1] += ga[r] * wv.y; z[2] += ga[r] * wv.z; z[3] += ga[r] * wv.w;
      }
#pragma unroll
      for (int i = 0; i < 4; i++) {
        float sp = fmaxf(-z[i], 0.f) + __logf(1.f + __expf(-fabsf(z[i])));
        lg[i] = -sp * (1.f / 16.f);
      }
    }
    {
      unsigned qq[4] = {pq.x, pq.y, pq.z, pq.w}, kk[4] = {pk.x, pk.y, pk.z, pk.w};
#pragma unroll
      for (int i = 0; i < KPT / 2; i++) {
        qv[2 * i] = bflo(qq[i]); qv[2 * i + 1] = bfhi(qq[i]);
        kv[2 * i] = bflo(kk[i]); kv[2 * i + 1] = bfhi(kk[i]);
      }
    }
    {
      unsigned vv[4] = {pv.x, pv.y, pv.z, pv.w};
#pragma unroll
      for (int i = 0; i < 4; i++) {
        VT[(kgp * 8 + 2 * i) * 20 + t] = (u16)(vv[i] & 0xffff);
        VT[(kgp * 8 + 2 * i + 1) * 20 + t] = (u16)(vv[i] >> 16);
      }
    }
    __builtin_amdgcn_sched_barrier(0);
    if (n + nstep < SEQ / 16) prefetch(n + nstep, im, psg);
    __builtin_amdgcn_sched_barrier(0);
    float qt[KPT], kt[KPT], kh[KPT];
#pragma unroll
    for (int i = 0; i < KPT; i++) {
      float bcum = dpp_scan_add(lg[i]);
      float bl = dpp_row_bcast15(bcum);
      qt[i] = qv[i] * __expf(bcum);
      kt[i] = kv[i] * __expf(-bcum);
      kh[i] = kv[i] * __expf(bl - bcum);
      if (t == 15) Gch[k0 + i] = __expf(bl);
      KhT[(k0 + i) * 20 + t] = f2bf(kh[i]);
    }
    if (KPT == 8) {
      uint4 a, c;
      a.x = pack2(qt[0], qt[1]); a.y = pack2(qt[2], qt[3]); a.z = pack2(qt[4 % KPT], qt[5 % KPT]); a.w = pack2(qt[6 % KPT], qt[7 % KPT]);
      c.x = pack2(kt[0], kt[1]); c.y = pack2(kt[2], kt[3]); c.z = pack2(kt[4 % KPT], kt[5 % KPT]); c.w = pack2(kt[6 % KPT], kt[7 % KPT]);
      *(uint4*)&Qt[t * LQ + k0] = a;
      *(uint4*)&Kt[t * LQ + k0] = c;
    } else {
      uint2 a, c;
      a.x = pack2(qt[0], qt[1]); a.y = pack2(qt[2], qt[3]);
      c.x = pack2(kt[0], kt[1]); c.y = pack2(kt[2], kt[3]);
      *(uint2*)&Qt[t * LQ + k0] = a;
      *(uint2*)&Kt[t * LQ + k0] = c;
    }
    }
    __syncthreads();
    if (MODE == 1) {
      char* dst = img + (size_t)n * IMG;
#pragma unroll
      for (int i = 0; i < NIM; i++) if (tid * 16 + 4096 * i < IMG) *(u32x4*)(dst + tid * 16 + 4096 * i) = *(const u32x4*)(smem + tid * 16 + 4096 * i);
      __syncthreads();
      return;
    }

    STAGE();
    f32x4 sc = f32x4{0, 0, 0, 0};
    bf16x8 qf[NKS];
#pragma unroll
    for (int st = 0; st < NKS; st++) {
      bf16x4 q0 = *(const bf16x4*)&Qt[l15 * LQ + 32 * st + kg * 4];
      bf16x4 q1 = *(const bf16x4*)&Qt[l15 * LQ + 32 * st + 16 + kg * 4];
      bf16x4 c0 = *(const bf16x4*)&Kt[l15 * LQ + 32 * st + kg * 4];
      bf16x4 c1 = *(const bf16x4*)&Kt[l15 * LQ + 32 * st + 16 + kg * 4];
      qf[st] = bf16x8{q0[0], q0[1], q0[2], q0[3], q1[0], q1[1], q1[2], q1[3]};
      bf16x8 kf = bf16x8{c0[0], c0[1], c0[2], c0[3], c1[0], c1[1], c1[2], c1[3]};
      sc = __builtin_amdgcn_mfma_f32_16x16x32_bf16(kf, qf[st], sc, 0, 0, 0);
    }
    STAGE();
#pragma unroll
    for (int r = 0; r < 4; r++) if (kg * 4 + r > l15) sc[r] = 0.f;
    bf16x4 pA;
    {
      unsigned a = pack2(sc[0], sc[1]), c = pack2(sc[2], sc[3]);
      pA = bf16x4{(short)(a & 0xffff), (short)(a >> 16), (short)(c & 0xffff), (short)(c >> 16)};
    }
    bf16x4 vf[2];
    f32x4 o[2], oin[2];
    bf16x8 sbv[2][NKS];
#pragma unroll
    for (int vt = 0; vt < 2; vt++) {
      vf[vt] = *(const bf16x4*)&VT[(w * 32 + vt * 16 + l15) * 20 + kg * 4];
#pragma unroll
      for (int st = 0; st < NKS; st++) {
        unsigned s0 = pack2(S[2 * st][vt][0], S[2 * st][vt][1]), s1 = pack2(S[2 * st][vt][2], S[2 * st][vt][3]);
        unsigned s2 = pack2(S[2 * st + 1][vt][0], S[2 * st + 1][vt][1]), s3 = pack2(S[2 * st + 1][vt][2], S[2 * st + 1][vt][3]);
        sbv[vt][st] = bf16x8{(short)(s0 & 0xffff), (short)(s0 >> 16), (short)(s1 & 0xffff), (short)(s1 >> 16),
                           (short)(s2 & 0xffff), (short)(s2 >> 16), (short)(s3 & 0xffff), (short)(s3 >> 16)};
      }
    }
    STAGE();
#pragma unroll
    for (int vt = 0; vt < 2; vt++) {
      o[vt] = __builtin_amdgcn_mfma_f32_16x16x16bf16_1k(pA, vf[vt], f32x4{0, 0, 0, 0}, 0, 0, 0);
      oin[vt] = f32x4{0, 0, 0, 0};
#pragma unroll
      for (int st = 0; st < NKS; st++) oin[vt] = __builtin_amdgcn_mfma_f32_16x16x32_bf16(qf[st], sbv[vt][st], oin[vt], 0, 0, 0);
    }
    STAGE();
    bf16x4 khf[NKT];
#pragma unroll
    for (int kt2 = 0; kt2 < NKT; kt2++) {
      khf[kt2] = *(const bf16x4*)&KhT[(16 * kt2 + l15) * 20 + kg * 4];
      float4 g4 = *(const float4*)&Gch[16 * kt2 + kg * 4];
      f32x4 gv = f32x4{g4.x, g4.y, g4.z, g4.w};
      S[kt2][0] *= gv; S[kt2][1] *= gv;
    }
    STAGE();
#pragma unroll
    for (int kt2 = 0; kt2 < NKT; kt2++) {
#pragma unroll
      for (int vt = 0; vt < 2; vt++)
        S[kt2][vt] = __builtin_amdgcn_mfma_f32_16x16x16bf16_1k(khf[kt2], vf[vt], S[kt2][vt], 0, 0, 0);
    }
    STAGE();
    float ss[4];
#pragma unroll
    for (int r = 0; r < 4; r++) {
      o[0][r] += oin[0][r]; o[1][r] += oin[1][r];
      float s = o[0][r] * o[0][r] + o[1][r] * o[1][r];
      s = dpp_row_sum(s);
      ss[r] = s;
    }
    if (l15 == 0) *(float4*)&SS[w * 16 + kg * 4] = make_float4(ss[0], ss[1], ss[2], ss[3]);
    __syncthreads();
    {
      float4 a0 = *(const float4*)&SS[0 * 16 + kg * 4], a1 = *(const float4*)&SS[1 * 16 + kg * 4];
      float4 a2 = *(const float4*)&SS[2 * 16 + kg * 4], a3 = *(const float4*)&SS[3 * 16 + kg * 4];
      float tot[4] = {a0.x + a1.x + a2.x + a3.x, a0.y + a1.y + a2.y + a3.y, a0.z + a1.z + a2.z + a3.z, a0.w + a1.w + a2.w + a3.w};
#pragma unroll
      for (int r = 0; r < 4; r++) {
        const float rstd = rsqrtf(tot[r] * (1.f / 128.f) + LN_EPS);
        const int li = (kg * 4 + r) * 136 + w * 32 + l15;
        sgate[r] = bf2f(GT[li]); sgate[4 + r] = bf2f(GT[li + 16]);
        OT[li] = f2bf(o[0][r] * rstd * g0 * sgate[r]);
        OT[li + 16] = f2bf(o[1][r] * rstd * g1 * sgate[4 + r]);
      }
    }
    __syncthreads();
    *(u32x4*)(p.O + ((size_t)b * SEQ + n * 16 + (tid >> 4)) * DM + ocol + (tid & 15) * 8) = *(const u32x4*)&OT[(tid >> 4) * 136 + (tid & 15) * 8];
  };
  if (MODE == 2) {
    prefetch(0, imA, psg);
    prefetch(1, imB, psgB);
    for (int n = 0; n < SEQ / 16; n += 2) { step(n, imA, psg); step(n + 1, imB, psgB); }
  } else {
    prefetch(nstart, imA, psg);
    for (int n = nstart; n < SEQ / 16; n += nstep) step(n, imA, psg);
  }
}

constexpr size_t IMGH_SZ = (2 * 16 * 136 + 128 * 20 + 128 * 20) * 2 + 128 * 4;
constexpr size_t IMGG_SZ = (2 * 16 * 72 + 64 * 20 + 128 * 20) * 2 + 64 * 4;
__device__ void phaseB0(const Params& p, char* smem) {
  const int nparts = gridDim.x >> 6;
  if ((int)blockIdx.x >= nparts * 64) return;
  const int u = blockIdx.x & 63, part = blockIdx.x >> 6;
  __syncthreads();
  if (u < 32) recur_unit<128, true, 1>(p, smem, u >> 2, u & 3, p.IMGH + (size_t)u * 128 * IMGH_SZ, part, nparts);
  else recur_unit<64, false, 1>(p, smem, (u - 32) >> 2, u & 3, p.IMGG + (size_t)(u - 32) * 128 * IMGG_SZ, part, nparts);
}
__device__ void phaseB(const Params& p, char* smem) {
  if (blockIdx.x >= 64) {
    const int nb = gridDim.x - 64;
    for (int u = blockIdx.x - 64; u < NEXP * 2 * 128; u += nb) {
      const int tile = u & 127, mat = (u >> 7) & 1, e = u >> 8;
      const float* W = (mat ? p.w_up : p.w_gate) + (size_t)e * DM * DEXP;
      u16* WT = (mat ? p.WuT : p.WgT) + (size_t)e * DEXP * DM;
      transpose_tile(W, DEXP, DEXP, (tile & 15) * 64, (tile >> 4) * 64, WT, DM, smem);
    }
    return;
  }
  for (int u = blockIdx.x; u < 64; u += gridDim.x) {
    __syncthreads();
    if (u < 32) recur_unit<128, true, 2>(p, smem, u >> 2, u & 3, p.IMGH + (size_t)u * 128 * IMGH_SZ, 0, 1);
    else recur_unit<64, false, 2>(p, smem, (u - 32) >> 2, u & 3, p.IMGG + (size_t)(u - 32) * 128 * IMGG_SZ, 0, 1);
  }
}

__device__ void phaseC(const Params& p, char* smem) {
  xcd_queue_run(p.bar + QW_BASE + 512, 128, smem + 2 * GEMM_SMEM + 800, [&](int j, int q) {
    const int mt = q, nt = j;
    const int m0 = mt * 128, n0 = nt * 128;
    auto rowf = [&](int r) { return (const void*)(p.O + (size_t)(m0 + r) * DM); };
    auto colf = [&](int c) { return (const void*)(p.WoutT + (size_t)(n0 + c) * DM); };
    auto epi = [&](f32x4 (&acc)[4][4], int mb, int nb) {
#pragma unroll
      for (int mi = 0; mi < 4; mi++)
#pragma unroll
        for (int ni = 0; ni < 4; ni++) {
          const size_t idx = (size_t)(m0 + mb + mi * 16) * DM + n0 + nb + ni * 16;
          float4 xv = *(const float4*)&p.x[idx];
          f32x4 v = acc[mi][ni];
          *(float4*)&p.Z[idx] = make_float4(ALPHA * xv.x + v[0], ALPHA * xv.y + v[1], ALPHA * xv.z + v[2], ALPHA * xv.w + v[3]);
        }
    };
    gemm_tile<true, true>(smem, DM, rowf, colf, DM, epi);
  });
}

__device__ __forceinline__ float wave_sum(float v) {
  v = dpp_row_sum(v);
  const int vi = __float_as_int(v);
  return (__int_as_float(__builtin_amdgcn_readlane(vi, 0)) + __int_as_float(__builtin_amdgcn_readlane(vi, 16))) +
         (__int_as_float(__builtin_amdgcn_readlane(vi, 32)) + __int_as_float(__builtin_amdgcn_readlane(vi, 48)));
}

__device__ __forceinline__ void ln_row(const float* zin, const float* g, const float* bb, int lane, float4 (&o)[4]) {
  float4 v[4];
  float s = 0.f;
#pragma unroll
  for (int i = 0; i < 4; i++) { v[i] = *(const float4*)&zin[lane * 4 + 256 * i]; s += v[i].x + v[i].y + v[i].z + v[i].w; }
  const float mu = wave_sum(s) * (1.f / 1024.f);
  float q = 0.f;
#pragma unroll
  for (int i = 0; i < 4; i++) {
    v[i].x -= mu; v[i].y -= mu; v[i].z -= mu; v[i].w -= mu;
    q += v[i].x * v[i].x + v[i].y * v[i].y + v[i].z * v[i].z + v[i].w * v[i].w;
  }
  const float rstd = rsqrtf(wave_sum(q) * (1.f / 1024.f) + LN_EPS);
#pragma unroll
  for (int i = 0; i < 4; i++) {
    float4 gg = *(const float4*)&g[lane * 4 + 256 * i], b4 = *(const float4*)&bb[lane * 4 + 256 * i];
    o[i] = make_float4(v[i].x * rstd * gg.x + b4.x, v[i].y * rstd * gg.y + b4.y, v[i].z * rstd * gg.z + b4.z, v[i].w * rstd * gg.w + b4.w);
  }
}

__device__ void phaseD(const Params& p, char* smem) {
  float* part = (float*)smem;
  float* logits = part + 4 * 16 * 80;
  const int tid = threadIdx.x, lane = tid & 63, w = tid >> 6, l15 = lane & 15, kg = lane >> 4;
  for (int g = blockIdx.x; g < NTOK / 16; g += gridDim.x) {
    const int row0 = g * 16;
    {
      float4 v[4][4];
#pragma unroll
      for (int i = 0; i < 4; i++)
#pragma unroll
        for (int j = 0; j < 4; j++) v[i][j] = *(const float4*)&p.Z[(size_t)(row0 + w * 4 + i) * DM + lane * 4 + 256 * j];
#pragma unroll
      for (int i = 0; i < 4; i++) {
        const int row = row0 + w * 4 + i;
        float s = 0.f;
#pragma unroll
        for (int j = 0; j < 4; j++) s += v[i][j].x + v[i][j].y + v[i][j].z + v[i][j].w;
        const float mu = wave_sum(s) * (1.f / 1024.f);
        float q = 0.f;
#pragma unroll
        for (int j = 0; j < 4; j++) {
          v[i][j].x -= mu; v[i][j].y -= mu; v[i][j].z -= mu; v[i][j].w -= mu;
          q += v[i][j].x * v[i][j].x + v[i][j].y * v[i][j].y + v[i][j].z * v[i][j].z + v[i][j].w * v[i][j].w;
        }
        const float rstd = rsqrtf(wave_sum(q) * (1.f / 1024.f) + LN_EPS);
#pragma unroll
        for (int j = 0; j < 4; j++) {
          const float4 gg = *(const float4*)&p.ln1_g[lane * 4 + 256 * j], b4 = *(const float4*)&p.ln1_b[lane * 4 + 256 * j];
          const float4 o = make_float4(v[i][j].x * rstd * gg.x + b4.x, v[i][j].y * rstd * gg.y + b4.y, v[i][j].z * rstd * gg.z + b4.z, v[i][j].w * rstd * gg.w + b4.w);
          *(float4*)&p.X1[(size_t)row * DM + lane * 4 + 256 * j] = o;
          uint2 h; h.x = pack2(o.x, o.y); h.y = pack2(o.z, o.w);
          *(uint2*)&p.X1B[(size_t)row * DM + lane * 4 + 256 * j] = h;
        }
      }
    }
    asm volatile("s_waitcnt vmcnt(0)" ::: "memory");
    __syncthreads();
    f32x4 acc[5];
#pragma unroll
    for (int i = 0; i < 5; i++) acc[i] = f32x4{0, 0, 0, 0};
    const float* xrow = p.X1 + (size_t)(row0 + l15) * DM + 256 * w + 4 * kg;
    struct RB { float4 a; float we[4][4]; float wg[4]; };
    auto rload = [&](int it, RB& r) {
      r.a = *(const float4*)&xrow[16 * it];
      const int kb = 256 * w + 16 * it + 4 * kg;
#pragma unroll
      for (int i = 0; i < 4; i++) {
        const float* we = p.w_er + (size_t)(kb + i) * 64 + l15;
#pragma unroll
        for (int nt = 0; nt < 4; nt++) r.we[i][nt] = we[16 * nt];
        r.wg[i] = (l15 < 8) ? p.w_gr[(size_t)(kb + i) * 8 + l15] : 0.f;
      }
    };
    auto rcomp = [&](const RB& r) {
      const float av[4] = {r.a.x, r.a.y, r.a.z, r.a.w};
#pragma unroll
      for (int i = 0; i < 4; i++) {
#pragma unroll
        for (int nt = 0; nt < 4; nt++) acc[nt] = __builtin_amdgcn_mfma_f32_16x16x4f32(av[i], r.we[i][nt], acc[nt], 0, 0, 0);
        acc[4] = __builtin_amdgcn_mfma_f32_16x16x4f32(av[i], r.wg[i], acc[4], 0, 0, 0);
      }
    };
    {
      RB r0, r1;
      rload(0, r0);
      for (int it = 0; it < 16; it += 2) {
        rload(it + 1, r1);
        rcomp(r0);
        if (it + 2 < 16) rload(it + 2, r0);
        rcomp(r1);
      }
    }
#pragma unroll
    for (int nt = 0; nt < 5; nt++)
#pragma unroll
      for (int r = 0; r < 4; r++) part[(w * 16 + kg * 4 + r) * 80 + nt * 16 + l15] = acc[nt][r];
    __syncthreads();
    for (int idx = tid; idx < 16 * 72; idx += 256) {
      const int r = idx / 72, c = idx % 72;
      logits[r * 72 + c] = part[(0 * 16 + r) * 80 + c] + part[(1 * 16 + r) * 80 + c] + part[(2 * 16 + r) * 80 + c] + part[(3 * 16 + r) * 80 + c];
    }
    __syncthreads();
    if (tid < 16) {
      const float* L = logits + tid * 72;
      const int tok = row0 + tid;
      float gm = L[64]; int gi = 0;
      for (int i = 1; i < 8; i++) if (L[64 + i] > gm) { gm = L[64 + i]; gi = i; }
      float gs = 0.f;
      for (int i = 0; i < 8; i++) gs += expf(L[64 + i] - gm);
      const float pg = 1.f / gs;
      const float* E = L + gi * 8;
      float em = E[0]; int i1 = 0;
      for (int i = 1; i < 8; i++) if (E[i] > em) { em = E[i]; i1 = i; }
      float e2 = -3.0e38f; int i2 = 0;
      for (int i = 0; i < 8; i++) if (i != i1 && E[i] > e2) { e2 = E[i]; i2 = i; }
      const float p1 = 1.f, p2 = expf(e2 - em);
      const float gt1 = pg * p1 / (p1 + p2), gt2 = pg * p2 / (p1 + p2);
      const int ex1 = gi * 8 + i1, ex2 = gi * 8 + i2;
      const int pos1 = atomicAdd(&p.cnt[ex1], 1);
      const int pos2 = atomicAdd(&p.cnt[ex2], 1);
      p.list_tok[ex1 * CAP + pos1] = tok; p.list_gate[ex1 * CAP + pos1] = gt1;
      p.list_tok[ex2 * CAP + pos2] = tok; p.list_gate[ex2 * CAP + pos2] = gt2;
      p.tok_e[tok * 2] = ex1; p.tok_e[tok * 2 + 1] = ex2;
      p.tok_pos[tok * 2] = pos1; p.tok_pos[tok * 2 + 1] = pos2;
    }
    __syncthreads();
  }
}

__device__ __forceinline__ void moe_prefix(const Params& p, int* s_off, int* s_rb) {
  __syncthreads();
  if (threadIdx.x == 0) {
    int o = 0, r = 0;
    for (int e = 0; e < NEXP; e++) {
      s_off[e] = o; s_rb[e] = r;
      int c = p.cnt[e];
      o += c; r += (c + 127) >> 7;
    }
    s_off[NEXP] = o; s_rb[NEXP] = r;
  }
  __syncthreads();
}

__device__ void phaseE1(const Params& p, char* smem) {
  int* s_off = (int*)(smem + 2 * GEMM_SMEM);
  int* s_rb = s_off + 72;
  moe_prefix(p, s_off, s_rb);
  xcd_queue_run(p.bar + QW_BASE + 1024, s_rb[NEXP], smem + 2 * GEMM_SMEM + 800, [&](int j, int q) {
    const int rbg = q, jt = j;
    int e = 0;
    while (s_rb[e + 1] <= rbg) e++;
    const int rb = rbg - s_rb[e];
    const int cnt = p.cnt[e];
    const int rows = min(128, cnt - rb * 128);
    const int* lt = p.list_tok + e * CAP + rb * 128;
    const int slot0 = s_off[e] + rb * 128;
    const int j0 = jt * 64;
    const u16* wg = p.WgT + (size_t)e * DEXP * DM;
    const u16* wu = p.WuT + (size_t)e * DEXP * DM;
    auto rowf = [&](int r) { int rr = r < rows ? r : 0; return (const void*)(p.X1B + (size_t)lt[rr] * DM); };
    auto colf = [&](int c) { return (const void*)(((c & 32) ? wu : wg) + (size_t)(j0 + (c >> 6) * 32 + (c & 31)) * DM); };
    auto epi = [&](f32x4 (&acc)[4][4], int mb, int nb) {
      const int wn = nb >> 6, kg4 = nb & 63;
#pragma unroll
      for (int mi = 0; mi < 4; mi++) {
        const int r = mb + mi * 16;
        if (r < rows) {
#pragma unroll
          for (int ni = 0; ni < 2; ni++) {
            f32x4 gv = acc[mi][ni], uv = acc[mi][ni + 2];
            uint2 o;
            o.x = pack2(siluf(gv[0]) * uv[0], siluf(gv[1]) * uv[1]);
            o.y = pack2(siluf(gv[2]) * uv[2], siluf(gv[3]) * uv[3]);
            *(uint2*)&p.H[(size_t)(slot0 + r) * DEXP + j0 + wn * 32 + ni * 16 + kg4] = o;
          }
        }
      }
    };
    gemm_tile<true, true>(smem, DM, rowf, colf, DEXP, epi);
  });
}

__device__ void phaseE2(const Params& p, char* smem) {
  int* s_off = (int*)(smem + 2 * GEMM_SMEM);
  int* s_rb = s_off + 72;
  moe_prefix(p, s_off, s_rb);
  xcd_queue_run(p.bar + QW_BASE + 1536, s_rb[NEXP], smem + 2 * GEMM_SMEM + 800, [&](int j, int q) {
    const int rbg = q, nt = j;
    int e = 0;
    while (s_rb[e + 1] <= rbg) e++;
    const int rb = rbg - s_rb[e];
    const int cnt = p.cnt[e];
    const int rows = min(128, cnt - rb * 128);
    const int slot0 = s_off[e] + rb * 128;
    const int n0 = nt * 128;
    const float* wd = p.w_down + (size_t)e * DEXP * DM;
    const float* lg = p.list_gate + e * CAP + rb * 128;
    auto rowf = [&](int r) { int rr = r < rows ? r : 0; return (const void*)(p.H + (size_t)(slot0 + rr) * DEXP); };
    auto colf = [&](int c) { return (const void*)(wd + n0 + c); };
    auto epi = [&](f32x4 (&acc)[4][4], int mb, int nb) {
#pragma unroll
      for (int mi = 0; mi < 4; mi++) {
        const int r = mb + mi * 16;
        if (r < rows) {
          const float gt = lg[r];
#pragma unroll
          for (int ni = 0; ni < 4; ni++) {
            f32x4 v = acc[mi][ni];
            uint2 o; o.x = pack2(gt * v[0], gt * v[1]); o.y = pack2(gt * v[2], gt * v[3]);
            *(uint2*)&p.Y[(size_t)(slot0 + r) * DM + n0 + nb + ni * 16] = o;
          }
        }
      }
    };
    gemm_tile<true, false>(smem, DEXP, rowf, colf, DM, epi);
  });
}

__device__ void phaseF(const Params& p, char* smem) {
  int* s_off = (int*)(smem + 2 * GEMM_SMEM);
  int* s_rb = s_off + 72;
  moe_prefix(p, s_off, s_rb);
  const int tid = threadIdx.x, lane = tid & 63, w = tid >> 6;
  for (int rp = blockIdx.x * 4 + w; rp < NTOK / 2; rp += gridDim.x * 4) {
    int sl[2][2];
#pragma unroll
    for (int h = 0; h < 2; h++) {
      const int row = rp * 2 + h;
      const int2 te = *(const int2*)&p.tok_e[row * 2], tp = *(const int2*)&p.tok_pos[row * 2];
      sl[h][0] = s_off[te.x] + tp.x;
      sl[h][1] = s_off[te.y] + tp.y;
    }
    float4 v[2][4];
#pragma unroll
    for (int h = 0; h < 2; h++) {
      const int row = rp * 2 + h;
#pragma unroll
      for (int i = 0; i < 4; i++) {
        const int c = lane * 4 + 256 * i;
        const float4 xv = *(const float4*)&p.X1[(size_t)row * DM + c];
        const uint2 ya = *(const uint2*)&p.Y[(size_t)sl[h][0] * DM + c];
        const uint2 yb = *(const uint2*)&p.Y[(size_t)sl[h][1] * DM + c];
        v[h][i].x = ALPHA * xv.x + (bflo(ya.x) + bflo(yb.x));
        v[h][i].y = ALPHA * xv.y + (bfhi(ya.x) + bfhi(yb.x));
        v[h][i].z = ALPHA * xv.z + (bflo(ya.y) + bflo(yb.y));
        v[h][i].w = ALPHA * xv.w + (bfhi(ya.y) + bfhi(yb.y));
      }
    }
#pragma unroll
    for (int h = 0; h < 2; h++) {
      const int row = rp * 2 + h;
      float s = 0.f;
#pragma unroll
      for (int i = 0; i < 4; i++) s += v[h][i].x + v[h][i].y + v[h][i].z + v[h][i].w;
      const float mu = wave_sum(s) * (1.f / 1024.f);
      float q = 0.f;
#pragma unroll
      for (int i = 0; i < 4; i++) {
        v[h][i].x -= mu; v[h][i].y -= mu; v[h][i].z -= mu; v[h][i].w -= mu;
        q += v[h][i].x * v[h][i].x + v[h][i].y * v[h][i].y + v[h][i].z * v[h][i].z + v[h][i].w * v[h][i].w;
      }
      const float rstd = rsqrtf(wave_sum(q) * (1.f / 1024.f) + LN_EPS);
#pragma unroll
      for (int i = 0; i < 4; i++) {
        const int c = lane * 4 + 256 * i;
        const float4 gg = *(const float4*)&p.ln2_g[c], b4 = *(const float4*)&p.ln2_b[c];
        *(float4*)&p.out[(size_t)row * DM + c] =
            make_float4(v[h][i].x * rstd * gg.x + b4.x, v[h][i].y * rstd * gg.y + b4.y, v[h][i].z * rstd * gg.z + b4.z, v[h][i].w * rstd * gg.w + b4.w);
      }
    }
  }
}


#define XB_TMO      128
#define XB_XCNT(j)  (256  + 64 * (j))
#define XB_XSUB(j)  (1280 + 64 * (j))
#define XB_XGEN(j)  (2304 + 64 * (j))
#define XB_TOP      3328
#define XB_TOPGEN   3392
#define XCD_BAR_WORDS 3456
#define XB_SPIN_CAP (1u << 18)
#define LAS __attribute__((address_space(3)))
__device__ __forceinline__ unsigned xb_ld(unsigned* p)              { return __hip_atomic_load(p, __ATOMIC_RELAXED, __HIP_MEMORY_SCOPE_AGENT); }
__device__ __forceinline__ unsigned xb_add(unsigned* p, unsigned v) { return __hip_atomic_fetch_add(p, v, __ATOMIC_RELAXED, __HIP_MEMORY_SCOPE_AGENT); }
__device__ __forceinline__ unsigned xb_xcc_id() { return (unsigned)__builtin_amdgcn_s_getreg((3 << 11) | 20) & 0xFu; }
#define XB_SPIN(cond, bar) do { unsigned _sp = 0; while (cond) { __builtin_amdgcn_s_sleep(1); \
    if ((++_sp & 255u) == 0u) { if (xb_ld(&(bar)[XB_TMO])) break; if (_sp > XB_SPIN_CAP) { atomicAdd(&(bar)[XB_TMO], 1u); break; } } } } while (0)
struct XcdBarrier { unsigned* bar; unsigned x; volatile LAS unsigned* st; };
__device__ __forceinline__ XcdBarrier xcd_barrier_post(unsigned* bar, volatile LAS unsigned* st) {
  XcdBarrier b; b.bar = bar; b.x = xb_xcc_id(); b.st = st;
  if (threadIdx.x == 0) (void)xb_add(&bar[XB_XCNT(b.x)], 1u);
  return b;
}
__device__ __forceinline__ void xcd_barrier_complete(unsigned* bar, unsigned x, unsigned& nloc, unsigned& nx) {
  const unsigned G = gridDim.x * gridDim.y * gridDim.z;
  unsigned sum, cnt, mine, sp = 0u;
  for (;;) {
    sum = 0u; cnt = 0u; mine = 0u;
#pragma unroll
    for (unsigned j = 0; j < 16; ++j) { const unsigned c = xb_ld(&bar[XB_XCNT(j)]); sum += c; cnt += (c > 0u) ? 1u : 0u; mine = (j == x) ? c : mine; }
    if (sum == G) break;
    __builtin_amdgcn_s_sleep(1);
    if ((++sp & 255u) == 0u) { if (xb_ld(&bar[XB_TMO])) break; if (sp > XB_SPIN_CAP) { atomicAdd(&bar[XB_TMO], 1u); break; } }
  }
  nloc = mine > 0u ? mine : 1u; nx = cnt > 0u ? cnt : 1u;
}
__device__ __forceinline__ void xcd_barrier(const XcdBarrier& b) {
  asm volatile("s_waitcnt vmcnt(0)" ::: "memory");
  __syncthreads();
  if (threadIdx.x == 0) {
    unsigned* bar = b.bar;
    __builtin_amdgcn_s_waitcnt(0);
    unsigned nloc = b.st[0], nx = b.st[1];
    if (nloc == 0u) { xcd_barrier_complete(bar, b.x, nloc, nx); b.st[0] = nloc; b.st[1] = nx; }
    const unsigned old = xb_add(&bar[XB_XSUB(b.x)], 1u);
    const unsigned gen = old / nloc;
    if (old + 1u == (gen + 1u) * nloc) {
      __builtin_amdgcn_fence(__ATOMIC_RELEASE, "agent");
      asm volatile("s_waitcnt vmcnt(0)" ::: "memory");
      const unsigned og = xb_add(&bar[XB_TOP], 1u);
      const unsigned tg = og / nx;
      if (og + 1u == (tg + 1u) * nx) xb_add(&bar[XB_TOPGEN], 1u);
      else XB_SPIN(xb_ld(&bar[XB_TOPGEN]) == tg, bar);
      __builtin_amdgcn_fence(__ATOMIC_ACQUIRE, "agent");
      xb_add(&bar[XB_XGEN(b.x)], 1u);
      asm volatile("s_waitcnt vmcnt(0)" ::: "memory");
    } else {
      XB_SPIN(xb_ld(&bar[XB_XGEN(b.x)]) == gen, bar);
      __builtin_amdgcn_fence(__ATOMIC_ACQUIRE, "agent");
      asm volatile("s_waitcnt vmcnt(0)" ::: "memory");
    }
  }
  __syncthreads();
}

constexpr int AUX_OFF = 2 * GEMM_SMEM;
constexpr int SMEM_BYTES = AUX_OFF + 1024;

#if SINGLE
__global__ void __launch_bounds__(256, 2) fwd_megakernel(Params p) {
  extern __shared__ __attribute__((aligned(16))) char smem[];
  cg::grid_group grid = cg::this_grid();
  volatile LAS unsigned* st = (volatile LAS unsigned*)(smem + AUX_OFF + 768);
  if (threadIdx.x < 2) st[threadIdx.x] = 0u;
  __syncthreads();
  XcdBarrier xb = xcd_barrier_post(p.bar, st);
  if (p.use_cg) grid.sync();
  phaseP0(p, smem);
  xcd_barrier(xb);
  phaseA(p, smem);
  xcd_barrier(xb);
  phaseB0(p, smem);
  xcd_barrier(xb);
  phaseB(p, smem);
  xcd_barrier(xb);
  phaseC(p, smem);
  xcd_barrier(xb);
  phaseD(p, smem);
  xcd_barrier(xb);
  phaseE1(p, smem);
  xcd_barrier(xb);
  phaseE2(p, smem);
  xcd_barrier(xb);
  phaseF(p, smem);
}
#else
#define PHASE_KERNEL(NAME, FN)                                             \
  __global__ void __launch_bounds__(256, 2) NAME(Params p) {                  \
    __shared__ __attribute__((aligned(16))) char smem[SMEM_BYTES];         \
    FN(p, smem);                                                           \
  }
PHASE_KERNEL(kA, phaseA)
PHASE_KERNEL(kB, phaseB)
PHASE_KERNEL(kC, phaseC)
PHASE_KERNEL(kD, phaseD)
PHASE_KERNEL(kE1, phaseE1)
PHASE_KERNEL(kE2, phaseE2)
PHASE_KERNEL(kF, phaseF)
#endif

extern "C" void kernel_launch(void* const* d_in, const int* in_sizes, int n_in, void* d_out, int out_size,
                              void* d_ws, size_t ws_size, hipStream_t stream) {
  Params p{};
  p.x = (const float*)d_in[0];
  p.w_in = (const float*)d_in[1];
  p.w_a2 = (const float*)d_in[2];
  p.b_a = (const float*)d_in[3];
  p.lb = (const float*)d_in[4];
  p.norm_h = (const float*)d_in[5];
  p.norm_g = (const float*)d_in[6];
  p.w_out = (const float*)d_in[7];
  p.ln1_g = (const float*)d_in[8];
  p.ln1_b = (const float*)d_in[9];
  p.w_gr = (const float*)d_in[10];
  p.w_er = (const float*)d_in[11];
  p.w_gate = (const float*)d_in[12];
  p.w_up = (const float*)d_in[13];
  p.w_down = (const float*)d_in[14];
  p.ln2_g = (const float*)d_in[15];
  p.ln2_b = (const float*)d_in[16];
  p.out = (float*)d_out;
  char* ws = (char*)d_ws;
  size_t off = 0;
  auto take = [&](size_t bytes) { char* r = ws + off; off += (bytes + 255) & ~(size_t)255; return r; };
  p.P = (u16*)take((size_t)NTOK * INC * 2);
  p.LF = (float*)take((size_t)NTOK * 512 * 4);
  p.GA = (float*)take((size_t)NTOK * 16 * 4);
  p.Z = (float*)take((size_t)NTOK * DM * 4);
  p.O = (u16*)take((size_t)NTOK * DM * 2);
  p.X1 = (float*)take((size_t)NTOK * DM * 4);
  p.X1B = (u16*)take((size_t)NTOK * DM * 2);
  p.cnt = (int*)take(256);
  p.tok_e = (int*)take((size_t)NTOK * 2 * 4);
  p.tok_pos = (int*)take((size_t)NTOK * 2 * 4);
  p.list_tok = (int*)take((size_t)NEXP * CAP * 4);
  p.list_gate = (float*)take((size_t)NEXP * CAP * 4);
  p.bar = (unsigned*)take((XCD_BAR_WORDS + 2048) * 4);
  p.XB = p.O;
  p.WgT = (u16*)take((size_t)NEXP * DEXP * DM * 2);
  p.WuT = (u16*)take((size_t)NEXP * DEXP * DM * 2);
  p.IMGH = (char*)p.X1;
  p.IMGG = (char*)p.Z;
  p.WinT = (u16*)take((size_t)INC * DM * 2);
  p.WoutT = (u16*)take((size_t)DM * DM * 2);
  p.use_cg = 0; p.pad_ = 0;
  p.H = p.P;
  p.Y = p.P + (size_t)32768 * DEXP;

#if SINGLE
  static int grid_blocks = 0;
  if (!grid_blocks) {
    int dev = 0, cus = 0, per_cu = 0;
    hipGetDevice(&dev);
    hipDeviceGetAttribute(&cus, hipDeviceAttributeMultiprocessorCount, dev);
    if (hipFuncSetAttribute((const void*)fwd_megakernel, hipFuncAttributeMaxDynamicSharedMemorySize, SMEM_BYTES) != hipSuccess)
      fprintf(stderr, "hipFuncSetAttribute failed\n");
    hipOccupancyMaxActiveBlocksPerMultiprocessor(&per_cu, fwd_megakernel, 256, SMEM_BYTES);
    if (per_cu > 2) per_cu = 2;
    grid_blocks = cus * per_cu;
  }
  hipMemsetAsync(p.bar, 0, (XCD_BAR_WORDS + 2048) * 4, stream);
  void* args[] = {&p};
  hipError_t e = hipLaunchCooperativeKernel((void*)fwd_megakernel, dim3(grid_blocks), dim3(256), args, SMEM_BYTES, stream);
  if (e != hipSuccess) fprintf(stderr, "cooperative launch failed: %s (grid %d)\n", hipGetErrorString(e), grid_blocks);
#else
  const int G = 512;
  kA<<<G, 256, 0, stream>>>(p);
  kB<<<64, 256, 0, stream>>>(p);
  kC<<<G, 256, 0, stream>>>(p);
  kD<<<G, 256, 0, stream>>>(p);
  kE1<<<G, 256, 0, stream>>>(p);
  kE2<<<G, 256, 0, stream>>>(p);
  kF<<<G, 256, 0, stream>>>(p);
#endif
}
```

```cpp
#include <hip/hip_runtime.h>
#include <hip/hip_cooperative_groups.h>
#include <cstdio>
namespace cg = cooperative_groups;

#ifndef SINGLE
#define SINGLE 1
#endif

typedef unsigned short u16;
typedef __attribute__((ext_vector_type(8))) short bf16x8;
typedef __attribute__((ext_vector_type(4))) short bf16x4;
typedef __attribute__((ext_vector_type(4))) float f32x4;
typedef __bf16 bf16x2_t __attribute__((ext_vector_type(2)));
typedef float f32x2_t __attribute__((ext_vector_type(2)));
typedef unsigned u32x4 __attribute__((ext_vector_type(4)));
typedef unsigned u32x2 __attribute__((ext_vector_type(2)));

constexpr int NTOK = 16384;
constexpr int SEQ = 2048;
constexpr int DM = 1024;
constexpr int INC = 3600;
constexpr int NEXP = 64;
constexpr int DEXP = 512;
constexpr int CAP = 32768;
constexpr float ALPHA = 1.189207115002721f;
constexpr float LN_EPS = 1e-5f;

struct Params {
  const float *x, *w_in, *w_a2, *b_a, *lb, *norm_h, *norm_g, *w_out, *ln1_g, *ln1_b, *w_gr, *w_er,
      *w_gate, *w_up, *w_down, *ln2_g, *ln2_b;
  float* out;
  u16* P;
  float* LF;
  float* GA;
  float* Z;
  u16* O;
  float* X1;
  u16* X1B;
  u16* H;
  u16* Y;
  int* cnt;
  int* tok_e;
  int* tok_pos;
  int* list_tok;
  float* list_gate;
  u16* XB;
  u16* WinT;
  u16* WoutT;
  u16* WgT;
  u16* WuT;
  char* IMGH;
  char* IMGG;
  unsigned* bar;
  int use_cg; int pad_;
};

__device__ __forceinline__ unsigned pack2(float a, float b) {
  f32x2_t f = {a, b};
  bf16x2_t h = __builtin_convertvector(f, bf16x2_t);
  return *(unsigned*)&h;
}
__device__ __forceinline__ u16 f2bf(float a) {
  __bf16 h = (__bf16)a;
  return *(u16*)&h;
}
__device__ __forceinline__ float bf2f(u16 v) { return __uint_as_float(((unsigned)v) << 16); }
__device__ __forceinline__ float bflo(unsigned v) { return __uint_as_float(v << 16); }
__device__ __forceinline__ float bfhi(unsigned v) { return __uint_as_float(v & 0xffff0000u); }
__device__ __forceinline__ float sigmoidf(float x) { return 1.f / (1.f + __expf(-x)); }
__device__ __forceinline__ float siluf(float x) { return x / (1.f + __expf(-x)); }


constexpr int QW_BASE = 3456;
__device__ __forceinline__ unsigned my_xcc_id() { return (unsigned)__builtin_amdgcn_s_getreg((3 << 11) | 20) & 7u; }
template <class F>
__device__ __forceinline__ void xcd_queue_run(unsigned* qwords, int nper, char* smem_aux, F fn) {
  volatile int* slot = (volatile int*)smem_aux;
  const unsigned x = my_xcc_id();
  for (int dj = 0; dj < 8; dj++) {
    const int j = (int)((x + dj) & 7u);
    for (;;) {
      __syncthreads();
      if (threadIdx.x == 0) *slot = (int)__hip_atomic_fetch_add(qwords + 64 * j, 1u, __ATOMIC_RELAXED, __HIP_MEMORY_SCOPE_AGENT);
      __syncthreads();
      const int q = *slot;
      if (q >= nper) break;
      fn(j, q);
    }
  }
}

constexpr int BM = 128, BN = 128, BK = 64, LDT = 64;
constexpr int GEMM_SMEM = (BM + BN) * LDT * 2;

template <bool ABF, bool BBF, class RowF, class ColF, class Epi>
__device__ __forceinline__ void gemm_tile(char* smem, int K, RowF rowptr, ColF colptr, int ldb, Epi epi) {
  u16* As0 = (u16*)smem;
  const int tid = threadIdx.x, lane = tid & 63, w = tid >> 6, wm = w >> 1, wn = w & 1;
  const int l15 = lane & 15, kg = lane >> 4, swz = (l15 >> 1) & 7;
  f32x4 acc[4][4];
#pragma unroll
  for (int i = 0; i < 4; i++)
#pragma unroll
    for (int j = 0; j < 4; j++) acc[i][j] = f32x4{0.f, 0.f, 0.f, 0.f};

  constexpr int NA = ABF ? 4 : 8;
  const int ar0 = ABF ? (tid >> 3) : (tid >> 4);
  const int ac = ABF ? (tid & 7) * 8 : (tid & 15) * 4;
  constexpr int ARS = ABF ? 32 : 16;
  const char* ap[NA];
#pragma unroll
  for (int i = 0; i < NA; i++) ap[i] = (const char*)rowptr(ar0 + ARS * i) + ac * (ABF ? 2 : 4);
  const int bc = tid & 127, kh = tid >> 7;
  const float* bp = BBF ? nullptr : ((const float*)colptr(bc) + (size_t)(kh * 32) * ldb);
  const int br0 = tid >> 3, bcc = (tid & 7) * 8;
  const char* bq[4];
  if (BBF) {
#pragma unroll
    for (int i = 0; i < 4; i++) bq[i] = (const char*)colptr(br0 + 32 * i) + bcc * 2;
  }

  u32x4 ra[NA];
  float rb[BBF ? 1 : 32];
  u32x4 rbb[BBF ? 4 : 1];
  auto gload = [&](int k0) {
#pragma unroll
    for (int i = 0; i < NA; i++) ra[i] = *(const u32x4*)(ap[i] + (size_t)k0 * (ABF ? 2 : 4));
    if (BBF) {
#pragma unroll
      for (int i = 0; i < 4; i++) rbb[BBF ? i : 0] = *(const u32x4*)(bq[i] + (size_t)k0 * 2);
    } else {
      const float* b = bp + (size_t)k0 * ldb;
#pragma unroll
      for (int j = 0; j < 32; j++) rb[BBF ? 0 : j] = b[(size_t)j * ldb];
    }
  };
  auto sstore = [&](int buf) {
    u16* As = As0 + buf * (GEMM_SMEM / 2);
    u16* Bs = As + BM * LDT;
#pragma unroll
    for (int i = 0; i < NA; i++) {
      if (ABF) {
        { const int row = ar0 + ARS * i; *(u32x4*)&As[row * LDT + (((ac >> 3) ^ ((row >> 1) & 7)) << 3)] = ra[i]; }
      } else {
        u32x2 v;
        v[0] = pack2(__uint_as_float(ra[i][0]), __uint_as_float(ra[i][1]));
        v[1] = pack2(__uint_as_float(ra[i][2]), __uint_as_float(ra[i][3]));
        { const int row = ar0 + ARS * i; *(u32x2*)&As[row * LDT + (((ac >> 3) ^ ((row >> 1) & 7)) << 3) + (ac & 4)] = v; }
      }
    }
    if (BBF) {
#pragma unroll
      for (int i = 0; i < 4; i++) { const int row = br0 + 32 * i; *(u32x4*)&Bs[row * LDT + (((bcc >> 3) ^ ((row >> 1) & 7)) << 3)] = rbb[BBF ? i : 0]; }
    } else {
#pragma unroll
      for (int j = 0; j < 4; j++) {
        u32x4 v;
        v[0] = pack2(rb[BBF ? 0 : 8 * j + 0], rb[BBF ? 0 : 8 * j + 1]);
        v[1] = pack2(rb[BBF ? 0 : 8 * j + 2], rb[BBF ? 0 : 8 * j + 3]);
        v[2] = pack2(rb[BBF ? 0 : 8 * j + 4], rb[BBF ? 0 : 8 * j + 5]);
        v[3] = pack2(rb[BBF ? 0 : 8 * j + 6], rb[BBF ? 0 : 8 * j + 7]);
        *(u32x4*)&Bs[bc * LDT + (((kh * 4 + j) ^ ((bc >> 1) & 7)) << 3)] = v;
      }
    }
  };

  gload(0);
  sstore(0);
  __syncthreads();
  int cur = 0;
  for (int k0 = 0; k0 < K; k0 += BK) {
    if (k0 + BK < K) gload(k0 + BK);
    const u16* As = As0 + cur * (GEMM_SMEM / 2);
    const u16* Bs = As + BM * LDT;
    {
      bf16x8 af[2][4], bfr[2][4];
#pragma unroll
      for (int ks = 0; ks < 2; ks++) {
#pragma unroll
        for (int mi = 0; mi < 4; mi++) af[ks][mi] = *(const bf16x8*)&As[(wm * 64 + mi * 16 + l15) * LDT + (((ks * 4 + kg) ^ swz) << 3)];
#pragma unroll
        for (int ni = 0; ni < 4; ni++) bfr[ks][ni] = *(const bf16x8*)&Bs[(wn * 64 + ni * 16 + l15) * LDT + (((ks * 4 + kg) ^ swz) << 3)];
      }
      __builtin_amdgcn_sched_barrier(0);
#pragma unroll
      for (int ks = 0; ks < 2; ks++)
#pragma unroll
        for (int mi = 0; mi < 4; mi++)
#pragma unroll
          for (int ni = 0; ni < 4; ni++)
            acc[mi][ni] = __builtin_amdgcn_mfma_f32_16x16x32_bf16(bfr[ks][ni], af[ks][mi], acc[mi][ni], 0, 0, 0);
      __builtin_amdgcn_sched_barrier(0);
    }
    if (k0 + BK < K) sstore(cur ^ 1);
    __syncthreads();
    cur ^= 1;
  }
  epi(acc, wm * 64 + l15, wn * 64 + kg * 4);
}


__device__ void transpose_tile(const float* W, int ld, int N, int k0, int n0, u16* WT, int K, char* smem) {
  u16* T = (u16*)smem;
  const int tid = threadIdx.x;
  __syncthreads();
  {
    const int r = tid >> 4, c4 = (tid & 15) * 4;
#pragma unroll
    for (int i = 0; i < 4; i++) {
      const int k = r + 16 * i;
      float4 v = make_float4(0.f, 0.f, 0.f, 0.f);
      if (n0 + c4 < N) v = *(const float4*)&W[(size_t)(k0 + k) * ld + n0 + c4];
      T[(c4 + 0) * 72 + k] = f2bf(v.x); T[(c4 + 1) * 72 + k] = f2bf(v.y);
      T[(c4 + 2) * 72 + k] = f2bf(v.z); T[(c4 + 3) * 72 + k] = f2bf(v.w);
    }
  }
  __syncthreads();
  {
    const int n = tid >> 2, seg = (tid & 3) * 16;
    if (n0 + n < N) {
      u32x4 a = *(const u32x4*)&T[n * 72 + seg], b = *(const u32x4*)&T[n * 72 + seg + 8];
      *(u32x4*)&WT[(size_t)(n0 + n) * K + k0 + seg] = a;
      *(u32x4*)&WT[(size_t)(n0 + n) * K + k0 + seg + 8] = b;
    }
  }
}
__device__ void phaseP0(const Params& p, char* smem) {
  if (blockIdx.x == 0 && threadIdx.x < 64) p.cnt[threadIdx.x] = 0;
  constexpr int NTI = 57 * 16, NTO = 16 * 16;
  for (int u = blockIdx.x; u < NTI + NTO; u += gridDim.x) {
    if (u < NTI) transpose_tile(p.w_in, INC, INC, (u % 16) * 64, (u / 16) * 64, p.WinT, DM, smem);
    else { const int v = u - NTI; transpose_tile(p.w_out, DM, DM, (v % 16) * 64, (v / 16) * 64, p.WoutT, DM, smem); }
  }
  const size_t n4 = (size_t)NTOK * DM / 4;
  for (size_t i = blockIdx.x * (size_t)256 + threadIdx.x; i < n4; i += (size_t)gridDim.x * 256) {
    float4 v = ((const float4*)p.x)[i];
    uint2 o; o.x = pack2(v.x, v.y); o.y = pack2(v.z, v.w);
    ((uint2*)p.XB)[i] = o;
  }
}

__device__ void phaseA(const Params& p, char* smem) {
  xcd_queue_run(p.bar + QW_BASE, 464, smem + 2 * GEMM_SMEM + 800, [&](int j, int q) {
    const int pj = j >> 1, odd = j & 1;
    int mt, nt;
    if (q < 384) { mt = q / 3; nt = 7 * pj + odd * 4 + q % 3; }
    else if (q < 448) { mt = odd * 64 + (q - 384); nt = 7 * pj + 3; }
    else { mt = 16 * j + (q - 448); nt = 28; }
    const int m0 = mt * 128, n0 = nt * 128;
    const u16* xa = p.XB + (size_t)m0 * DM;
    auto rowf = [&](int r) { return (const void*)(xa + (size_t)r * DM); };
    auto colf = [&](int c) { int n = n0 + c; if (n > INC - 1) n = INC - 1; return (const void*)(p.WinT + (size_t)n * DM); };
    auto epi = [&](f32x4 (&acc)[4][4], int mb, int nb) {
#pragma unroll
      for (int mi = 0; mi < 4; mi++)
#pragma unroll
        for (int ni = 0; ni < 4; ni++) {
          const int m = m0 + mb + mi * 16, n = n0 + nb + ni * 16;
          f32x4 v = acc[mi][ni];
          if (n >= INC) continue;
          if (n >= 512 && n < 1024) {
            const int c = n - 512;
            float lf[4], kf[4];
#pragma unroll
            for (int r = 0; r < 4; r++) {
              float lbv = sigmoidf(p.lb[c + r] - p.lb[512 + c + r]);
              float sg = sigmoidf(v[r]);
              float f = lbv + (1.f - lbv) * sg;
              lf[r] = __logf(f);
              kf[r] = (1.f - lbv) * (1.f - sg);
            }
            *(float4*)&p.LF[(size_t)m * 512 + c] = make_float4(lf[0], lf[1], lf[2], lf[3]);
            uint2 o; o.x = pack2(kf[0], kf[1]); o.y = pack2(kf[2], kf[3]);
            *(uint2*)&p.P[(size_t)m * INC + n] = o;
          } else if (n >= 3072 && n < 3088) {
            *(float4*)&p.GA[(size_t)m * 16 + (n - 3072)] = make_float4(v[0], v[1], v[2], v[3]);
          } else {
            if (n < 512) { v *= 0.08838834764831845f; }
            else if ((n >= 1536 && n < 2048) || n >= 3088) {
#pragma unroll
              for (int r = 0; r < 4; r++) v[r] = siluf(v[r]);
            } else if (n >= 2048 && n < 2304) { v *= 0.125f; }
            uint2 o; o.x = pack2(v[0], v[1]); o.y = pack2(v[2], v[3]);
            *(uint2*)&p.P[(size_t)m * INC + n] = o;
          }
        }
    };
    gemm_tile<true, true>(smem, DM, rowf, colf, INC, epi);
  });
}

__device__ __forceinline__ float dpp_scan_add(float x) {
  int xi;
  xi = __builtin_amdgcn_update_dpp(0, __float_as_int(x), 0x111, 0xf, 0xf, true); x += __int_as_float(xi);
  xi = __builtin_amdgcn_update_dpp(0, __float_as_int(x), 0x112, 0xf, 0xf, true); x += __int_as_float(xi);
  xi = __builtin_amdgcn_update_dpp(0, __float_as_int(x), 0x114, 0xf, 0xf, true); x += __int_as_float(xi);
  xi = __builtin_amdgcn_update_dpp(0, __float_as_int(x), 0x118, 0xf, 0xf, true); x += __int_as_float(xi);
  return x;
}


__device__ __forceinline__ float dpp_row_bcast15(float x) {
  return __int_as_float(__builtin_amdgcn_update_dpp(0, __float_as_int(x), 0x15F, 0xf, 0xf, false));
}
__device__ __forceinline__ float dpp_row_sum(float x) {
  x += __int_as_float(__builtin_amdgcn_update_dpp(0, __float_as_int(x), 0x128, 0xf, 0xf, false));
  x += __int_as_float(__builtin_amdgcn_update_dpp(0, __float_as_int(x), 0x124, 0xf, 0xf, false));
  x += __int_as_float(__builtin_amdgcn_update_dpp(0, __float_as_int(x), 0x122, 0xf, 0xf, false));
  x += __int_as_float(__builtin_amdgcn_update_dpp(0, __float_as_int(x), 0x121, 0xf, 0xf, false));
  return x;
}

#define STAGE() do { } while (0)
__device__ void mid_barrier(const Params& p, char* smem);
__device__ void phaseC(const Params& p, char* smem, int which);
template <int DK, bool HG, int MODE>
__device__ void recur_unit(const Params& p, char* smem, int b, int h, char* img, int nstart, int nstep) {
  constexpr int IMG = (2 * 16 * (DK + 8) + DK * 20 + 128 * 20) * 2 + DK * 4;
  constexpr int NIM = (IMG + 4095) / 4096;
  constexpr int KPT = DK / 16;
  constexpr int NKS = DK / 32;
  constexpr int NKT = DK / 16;
  constexpr int LQ = DK + 8;
  u16* Qt = (u16*)smem;
  u16* Kt = Qt + 16 * LQ;
  u16* KhT = Kt + 16 * LQ;
  u16* VT = KhT + DK * 20;
  float* Gch = (float*)(VT + 128 * 20);
  float* SS = Gch + DK;
  float* Wa = SS + 64;
  u16* GT = (u16*)(smem + 20480);
  u16* OT = (u16*)(smem + 24832);

  const int tid = threadIdx.x, lane = tid & 63, w = tid >> 6, l15 = lane & 15, kg = lane >> 4;
  const int t = tid & 15, kgp = tid >> 4, k0 = kgp * KPT;
  const int qcol = HG ? (h * 128) : (2048 + h * 64);
  const int kcol = HG ? (512 + h * 128) : (2304 + h * 64);
  const int vcol = HG ? (1024 + h * 128) : (2560 + h * 128);
  const int gcol = HG ? (1536 + h * 128) : (3088 + h * 128);
  const int ocol = HG ? (h * 128) : (512 + h * 128);
  const float* gain = HG ? p.norm_h : p.norm_g;

  float ba[KPT];
  if (!HG && MODE == 1) {
    __syncthreads();
    for (int i = tid; i < 16 * 64; i += 256) Wa[i] = p.w_a2[(i >> 6) * 256 + h * 64 + (i & 63)];
#pragma unroll
    for (int i = 0; i < KPT; i++) ba[i] = p.b_a[h * 64 + k0 + i];
    __syncthreads();
  }
  const float g0 = gain[h * 128 + w * 32 + l15], g1 = gain[h * 128 + w * 32 + 16 + l15];

  f32x4 S[NKT][2];
#pragma unroll
  for (int i = 0; i < NKT; i++) { S[i][0] = f32x4{0, 0, 0, 0}; S[i][1] = f32x4{0, 0, 0, 0}; }

  float4 pl[4];
  uint4 pq, pk, pv;
  u16 psg[8];
  u32x4 imA[NIM], imB[NIM];
  u16 psgB[8];
  auto prefetch = [&](int n, u32x4 (&im)[NIM], u16 (&psg)[8]) {
    if (MODE == 2) {
      const char* src = img + (size_t)n * IMG;
#pragma unroll
      for (int i = 0; i < NIM; i++) if (tid * 16 + 4096 * i < IMG) im[i] = *(const u32x4*)(src + tid * 16 + 4096 * i);
      {
        const u32x4 g = *(const u32x4*)(p.P + ((size_t)b * SEQ + n * 16 + (tid >> 4)) * INC + gcol + (tid & 15) * 8);
        psg[0] = (u16)(g[0] & 0xffff); psg[1] = (u16)(g[0] >> 16); psg[2] = (u16)(g[1] & 0xffff); psg[3] = (u16)(g[1] >> 16);
        psg[4] = (u16)(g[2] & 0xffff); psg[5] = (u16)(g[2] >> 16); psg[6] = (u16)(g[3] & 0xffff); psg[7] = (u16)(g[3] >> 16);
      }
      return;
    }
    const size_t tok = (size_t)b * SEQ + n * 16 + t;
    const u16* prow = p.P + tok * INC;
    if (HG) {
      pl[0] = *(const float4*)&p.LF[tok * 512 + h * 128 + k0];
      pl[1] = *(const float4*)&p.LF[tok * 512 + h * 128 + k0 + 4];
      pq = *(const uint4*)&prow[qcol + k0];
      pk = *(const uint4*)&prow[kcol + k0];
    } else {
#pragma unroll
      for (int i = 0; i < 4; i++) pl[i] = *(const float4*)&p.GA[tok * 16 + 4 * i];
      uint2 a = *(const uint2*)&prow[qcol + k0];
      uint2 c = *(const uint2*)&prow[kcol + k0];
      pq.x = a.x; pq.y = a.y; pk.x = c.x; pk.y = c.y;
    }
    pv = *(const uint4*)&prow[vcol + kgp * 8];
  };

  constexpr int PFD = (MODE == 2) ? 2 : 1;
  auto step = [&](int n, u32x4 (&im)[NIM], u16 (&psg)[8]) {
    float sgate[8];
    if (MODE == 2) {
#pragma unroll
      for (int i = 0; i < NIM; i++) if (tid * 16 + 4096 * i < IMG) *(u32x4*)(smem + tid * 16 + 4096 * i) = im[i];
      {
        u32x4 g;
        g[0] = (unsigned)psg[0] | ((unsigned)psg[1] << 16); g[1] = (unsigned)psg[2] | ((unsigned)psg[3] << 16);
        g[2] = (unsigned)psg[4] | ((unsigned)psg[5] << 16); g[3] = (unsigned)psg[6] | ((unsigned)psg[7] << 16);
        *(u32x4*)&GT[(tid >> 4) * 136 + (tid & 15) * 8] = g;
      }
      __builtin_amdgcn_sched_barrier(0);
      if (n + PFD * nstep < SEQ / 16) prefetch(n + PFD * nstep, im, psg);
      __builtin_amdgcn_sched_barrier(0);
    } else {
    float lg[KPT], qv[KPT], kv[KPT];
    if (HG) {
      lg[0] = pl[0].x; lg[1] = pl[0].y; lg[2] = pl[0].z; lg[3] = pl[0].w;
      if (KPT > 4) { lg[4 % KPT] = pl[1].x; lg[5 % KPT] = pl[1].y; lg[6 % KPT] = pl[1].z; lg[7 % KPT] = pl[1].w; }
    } else {
      float ga[16] = {pl[0].x, pl[0].y, pl[0].z, pl[0].w, pl[1].x, pl[1].y, pl[1].z, pl[1].w,
                      pl[2].x, pl[2].y, pl[2].z, pl[2].w, pl[3].x, pl[3].y, pl[3].z, pl[3].w};
      float z[4] = {ba[0], ba[1], ba[2], ba[3]};
#pragma unroll
      for (int r = 0; r < 16; r++) {
        float4 wv = *(const float4*)&Wa[r * 64 + k0];
        z[0] += ga[r] * wv.x; z[1] += ga[r] * wv.y; z[2] += ga[r] * wv.z; z[3] += ga[r] * wv.w;
      }
#pragma unroll
      for (int i = 0; i < 4; i++) {
        float sp = fmaxf(-z[i], 0.f) + __logf(1.f + __expf(-fabsf(z[i])));
        lg[i] = -sp * (1.f / 16.f);
      }
    }
    {
      unsigned qq[4] = {pq.x, pq.y, pq.z, pq.w}, kk[4] = {pk.x, pk.y, pk.z, pk.w};
#pragma unroll
      for (int i = 0; i < KPT / 2; i++) {
        qv[2 * i] = bflo(qq[i]); qv[2 * i + 1] = bfhi(qq[i]);
        kv[2 * i] = bflo(kk[i]); kv[2 * i + 1] = bfhi(kk[i]);
      }
    }
    {
      unsigned vv[4] = {pv.x, pv.y, pv.z, pv.w};
#pragma unroll
      for (int i = 0; i < 4; i++) {
        VT[(kgp * 8 + 2 * i) * 20 + t] = (u16)(vv[i] & 0xffff);
        VT[(kgp * 8 + 2 * i + 1) * 20 + t] = (u16)(vv[i] >> 16);
      }
    }
    __builtin_amdgcn_sched_barrier(0);
    if (n + nstep < SEQ / 16) prefetch(n + nstep, im, psg);
    __builtin_amdgcn_sched_barrier(0);
    float qt[KPT], kt[KPT], kh[KPT];
#pragma unroll
    for (int i = 0; i < KPT; i++) {
      float bcum = dpp_scan_add(lg[i]);
      float bl = dpp_row_bcast15(bcum);
      qt[i] = qv[i] * __expf(bcum);
      kt[i] = kv[i] * __expf(-bcum);
      kh[i] = kv[i] * __expf(bl - bcum);
      if (t == 15) Gch[k0 + i] = __expf(bl);
      KhT[(k0 + i) * 20 + t] = f2bf(kh[i]);
    }
    if (KPT == 8) {
      uint4 a, c;
      a.x = pack2(qt[0], qt[1]); a.y = pack2(qt[2], qt[3]); a.z = pack2(qt[4 % KPT], qt[5 % KPT]); a.w = pack2(qt[6 % KPT], qt[7 % KPT]);
      c.x = pack2(kt[0], kt[1]); c.y = pack2(kt[2], kt[3]); c.z = pack2(kt[4 % KPT], kt[5 % KPT]); c.w = pack2(kt[6 % KPT], kt[7 % KPT]);
      *(uint4*)&Qt[t * LQ + k0] = a;
      *(uint4*)&Kt[t * LQ + k0] = c;
    } else {
      uint2 a, c;
      a.x = pack2(qt[0], qt[1]); a.y = pack2(qt[2], qt[3]);
      c.x = pack2(kt[0], kt[1]); c.y = pack2(kt[2], kt[3]);
      *(uint2*)&Qt[t * LQ + k0] = a;
      *(uint2*)&Kt[t * LQ + k0] = c;
    }
    }
    __syncthreads();
    if (MODE == 1) {
      char* dst = img + (size_t)n * IMG;
#pragma unroll
      for (int i = 0; i < NIM; i++) if (tid * 16 + 4096 * i < IMG) *(u32x4*)(dst + tid * 16 + 4096 * i) = *(const u32x4*)(smem + tid * 16 + 4096 * i);
      __syncthreads();
      return;
    }

    STAGE();
    f32x4 sc = f32x4{0, 0, 0, 0};
    bf16x8 qf[NKS];
#pragma unroll
    for (int st = 0; st < NKS; st++) {
      bf16x4 q0 = *(const bf16x4*)&Qt[l15 * LQ + 32 * st + kg * 4];
      bf16x4 q1 = *(const bf16x4*)&Qt[l15 * LQ + 32 * st + 16 + kg * 4];
      bf16x4 c0 = *(const bf16x4*)&Kt[l15 * LQ + 32 * st + kg * 4];
      bf16x4 c1 = *(const bf16x4*)&Kt[l15 * LQ + 32 * st + 16 + kg * 4];
      qf[st] = bf16x8{q0[0], q0[1], q0[2], q0[3], q1[0], q1[1], q1[2], q1[3]};
      bf16x8 kf = bf16x8{c0[0], c0[1], c0[2], c0[3], c1[0], c1[1], c1[2], c1[3]};
      sc = __builtin_amdgcn_mfma_f32_16x16x32_bf16(kf, qf[st], sc, 0, 0, 0);
    }
    STAGE();
#pragma unroll
    for (int r = 0; r < 4; r++) if (kg * 4 + r > l15) sc[r] = 0.f;
    bf16x4 pA;
    {
      unsigned a = pack2(sc[0], sc[1]), c = pack2(sc[2], sc[3]);
      pA = bf16x4{(short)(a & 0xffff), (short)(a >> 16), (short)(c & 0xffff), (short)(c >> 16)};
    }
    bf16x4 vf[2];
    f32x4 o[2], oin[2];
    bf16x8 sbv[2][NKS];
#pragma unroll
    for (int vt = 0; vt < 2; vt++) {
      vf[vt] = *(const bf16x4*)&VT[(w * 32 + vt * 16 + l15) * 20 + kg * 4];
#pragma unroll
      for (int st = 0; st < NKS; st++) {
        unsigned s0 = pack2(S[2 * st][vt][0], S[2 * st][vt][1]), s1 = pack2(S[2 * st][vt][2], S[2 * st][vt][3]);
        unsigned s2 = pack2(S[2 * st + 1][vt][0], S[2 * st + 1][vt][1]), s3 = pack2(S[2 * st + 1][vt][2], S[2 * st + 1][vt][3]);
        sbv[vt][st] = bf16x8{(short)(s0 & 0xffff), (short)(s0 >> 16), (short)(s1 & 0xffff), (short)(s1 >> 16),
                           (short)(s2 & 0xffff), (short)(s2 >> 16), (short)(s3 & 0xffff), (short)(s3 >> 16)};
      }
    }
    STAGE();
#pragma unroll
    for (int vt = 0; vt < 2; vt++) {
      o[vt] = __builtin_amdgcn_mfma_f32_16x16x16bf16_1k(pA, vf[vt], f32x4{0, 0, 0, 0}, 0, 0, 0);
      oin[vt] = f32x4{0, 0, 0, 0};
#pragma unroll
      for (int st = 0; st < NKS; st++) oin[vt] = __builtin_amdgcn_mfma_f32_16x16x32_bf16(qf[st], sbv[vt][st], oin[vt], 0, 0, 0);
    }
    STAGE();
    bf16x4 khf[NKT];
#pragma unroll
    for (int kt2 = 0; kt2 < NKT; kt2++) {
      khf[kt2] = *(const bf16x4*)&KhT[(16 * kt2 + l15) * 20 + kg * 4];
      float4 g4 = *(const float4*)&Gch[16 * kt2 + kg * 4];
      f32x4 gv = f32x4{g4.x, g4.y, g4.z, g4.w};
      S[kt2][0] *= gv; S[kt2][1] *= gv;
    }
    STAGE();
#pragma unroll
    for (int kt2 = 0; kt2 < NKT; kt2++) {
#pragma unroll
      for (int vt = 0; vt < 2; vt++)
        S[kt2][vt] = __builtin_amdgcn_mfma_f32_16x16x16bf16_1k(khf[kt2], vf[vt], S[kt2][vt], 0, 0, 0);
    }
    STAGE();
    float ss[4];
#pragma unroll
    for (int r = 0; r < 4; r++) {
      o[0][r] += oin[0][r]; o[1][r] += oin[1][r];
      float s = o[0][r] * o[0][r] + o[1][r] * o[1][r];
      s = dpp_row_sum(s);
      ss[r] = s;
    }
    if (l15 == 0) *(float4*)&SS[w * 16 + kg * 4] = make_float4(ss[0], ss[1], ss[2], ss[3]);
    __syncthreads();
    {
      float4 a0 = *(const float4*)&SS[0 * 16 + kg * 4], a1 = *(const float4*)&SS[1 * 16 + kg * 4];
      float4 a2 = *(const float4*)&SS[2 * 16 + kg * 4], a3 = *(const float4*)&SS[3 * 16 + kg * 4];
      float tot[4] = {a0.x + a1.x + a2.x + a3.x, a0.y + a1.y + a2.y + a3.y, a0.z + a1.z + a2.z + a3.z, a0.w + a1.w + a2.w + a3.w};
#pragma unroll
      for (int r = 0; r < 4; r++) {
        const float rstd = rsqrtf(tot[r] * (1.f / 128.f) + LN_EPS);
        const int li = (kg * 4 + r) * 136 + w * 32 + l15;
        sgate[r] = bf2f(GT[li]); sgate[4 + r] = bf2f(GT[li + 16]);
        OT[li] = f2bf(o[0][r] * rstd * g0 * sgate[r]);
        OT[li + 16] = f2bf(o[1][r] * rstd * g1 * sgate[4 + r]);
      }
    }
    __syncthreads();
    *(u32x4*)(p.O + ((size_t)b * SEQ + n * 16 + (tid >> 4)) * DM + ocol + (tid & 15) * 8) = *(const u32x4*)&OT[(tid >> 4) * 136 + (tid & 15) * 8];
  };
  if (MODE == 2) {
    prefetch(0, imA, psg);
    prefetch(1, imB, psgB);
    for (int n = 0; n < SEQ / 16; n += 2) {
      if (n == SEQ / 32) mid_barrier(p, smem);
      step(n, imA, psg); step(n + 1, imB, psgB);
    }
  } else {
    prefetch(nstart, imA, psg);
    for (int n = nstart; n < SEQ / 16; n += nstep) step(n, imA, psg);
  }
}

constexpr size_t IMGH_SZ = (2 * 16 * 136 + 128 * 20 + 128 * 20) * 2 + 128 * 4;
constexpr size_t IMGG_SZ = (2 * 16 * 72 + 64 * 20 + 128 * 20) * 2 + 64 * 4;
__device__ void phaseB0(const Params& p, char* smem) {
  const int nparts = gridDim.x >> 6;
  if ((int)blockIdx.x >= nparts * 64) return;
  const int u = blockIdx.x & 63, part = blockIdx.x >> 6;
  __syncthreads();
  if (u < 32) recur_unit<128, true, 1>(p, smem, u >> 2, u & 3, p.IMGH + (size_t)u * 128 * IMGH_SZ, part, nparts);
  else recur_unit<64, false, 1>(p, smem, (u - 32) >> 2, u & 3, p.IMGG + (size_t)(u - 32) * 128 * IMGG_SZ, part, nparts);
}
__device__ void phaseB(const Params& p, char* smem) {
  if (blockIdx.x >= 64) {
    const int nb = gridDim.x - 64;
    constexpr int NCV = NEXP * 2 * 128, NCV1 = 5632;
    auto conv = [&](int u) {
      const int tile = u & 127, mat = (u >> 7) & 1, e = u >> 8;
      const float* W = (mat ? p.w_up : p.w_gate) + (size_t)e * DM * DEXP;
      u16* WT = (mat ? p.WuT : p.WgT) + (size_t)e * DEXP * DM;
      transpose_tile(W, DEXP, DEXP, (tile & 15) * 64, (tile >> 4) * 64, WT, DM, smem);
    };
    int u = blockIdx.x - 64;
    for (; u < NCV1; u += nb) conv(u);
    mid_barrier(p, smem);
    phaseC(p, smem, 0);
    for (; u < NCV; u += nb) conv(u);
    return;
  }
  for (int u = blockIdx.x; u < 64; u += gridDim.x) {
    __syncthreads();
    if (u < 32) recur_unit<128, true, 2>(p, smem, u >> 2, u & 3, p.IMGH + (size_t)u * 128 * IMGH_SZ, 0, 1);
    else recur_unit<64, false, 2>(p, smem, (u - 32) >> 2, u & 3, p.IMGG + (size_t)(u - 32) * 128 * IMGG_SZ, 0, 1);
  }
}

__device__ void phaseC(const Params& p, char* smem, int which) {
  for (int half = 0; half <= which; half++)
  xcd_queue_run(p.bar + QW_BASE + 512 + 32 * half, 64, smem + 2 * GEMM_SMEM + 800, [&](int j, int q) {
    const int mt = (q >> 3) * 16 + half * 8 + (q & 7), nt = j;
    const int m0 = mt * 128, n0 = nt * 128;
    auto rowf = [&](int r) { return (const void*)(p.O + (size_t)(m0 + r) * DM); };
    auto colf = [&](int c) { return (const void*)(p.WoutT + (size_t)(n0 + c) * DM); };
    auto epi = [&](f32x4 (&acc)[4][4], int mb, int nb) {
#pragma unroll
      for (int mi = 0; mi < 4; mi++)
#pragma unroll
        for (int ni = 0; ni < 4; ni++) {
          const int m = m0 + mb + mi * 16;
          const size_t idx = (size_t)m * DM + n0 + nb + ni * 16;
          float4 xv = *(const float4*)&p.x[idx];
          f32x4 v = acc[mi][ni];
          float* zp = (half == 0) ? (p.LF + ((size_t)((m >> 11) * 1024 + (m & 1023))) * DM + n0 + nb + ni * 16) : (p.Z + idx);
          *(float4*)zp = make_float4(ALPHA * xv.x + v[0], ALPHA * xv.y + v[1], ALPHA * xv.z + v[2], ALPHA * xv.w + v[3]);
        }
    };
    gemm_tile<true, true>(smem, DM, rowf, colf, DM, epi);
  });
}

__device__ __forceinline__ float wave_sum(float v) {
  v = dpp_row_sum(v);
  const int vi = __float_as_int(v);
  return (__int_as_float(__builtin_amdgcn_readlane(vi, 0)) + __int_as_float(__builtin_amdgcn_readlane(vi, 16))) +
         (__int_as_float(__builtin_amdgcn_readlane(vi, 32)) + __int_as_float(__builtin_amdgcn_readlane(vi, 48)));
}

__device__ __forceinline__ void ln_row(const float* zin, const float* g, const float* bb, int lane, float4 (&o)[4]) {
  float4 v[4];
  float s = 0.f;
#pragma unroll
  for (int i = 0; i < 4; i++) { v[i] = *(const float4*)&zin[lane * 4 + 256 * i]; s += v[i].x + v[i].y + v[i].z + v[i].w; }
  const float mu = wave_sum(s) * (1.f / 1024.f);
  float q = 0.f;
#pragma unroll
  for (int i = 0; i < 4; i++) {
    v[i].x -= mu; v[i].y -= mu; v[i].z -= mu; v[i].w -= mu;
    q += v[i].x * v[i].x + v[i].y * v[i].y + v[i].z * v[i].z + v[i].w * v[i].w;
  }
  const float rstd = rsqrtf(wave_sum(q) * (1.f / 1024.f) + LN_EPS);
#pragma unroll
  for (int i = 0; i < 4; i++) {
    float4 gg = *(const float4*)&g[lane * 4 + 256 * i], b4 = *(const float4*)&bb[lane * 4 + 256 * i];
    o[i] = make_float4(v[i].x * rstd * gg.x + b4.x, v[i].y * rstd * gg.y + b4.y, v[i].z * rstd * gg.z + b4.z, v[i].w * rstd * gg.w + b4.w);
  }
}

__device__ void phaseD(const Params& p, char* smem) {
  float* part = (float*)smem;
  float* logits = part + 4 * 16 * 80;
  const int tid = threadIdx.x, lane = tid & 63, w = tid >> 6, l15 = lane & 15, kg = lane >> 4;
  for (int g = blockIdx.x; g < NTOK / 16; g += gridDim.x) {
    const int row0 = g * 16;
    {
      float4 v[4][4];
#pragma unroll
      for (int i = 0; i < 4; i++)
#pragma unroll
        for (int j = 0; j < 4; j++) {
          const int row = row0 + w * 4 + i;
          const float* zr = (row & 1024) ? (p.Z + (size_t)row * DM) : (p.LF + ((size_t)((row >> 11) * 1024 + (row & 1023))) * DM);
          v[i][j] = *(const float4*)&zr[lane * 4 + 256 * j];
        }
#pragma unroll
      for (int i = 0; i < 4; i++) {
        const int row = row0 + w * 4 + i;
        float s = 0.f;
#pragma unroll
        for (int j = 0; j < 4; j++) s += v[i][j].x + v[i][j].y + v[i][j].z + v[i][j].w;
        const float mu = wave_sum(s) * (1.f / 1024.f);
        float q = 0.f;
#pragma unroll
        for (int j = 0; j < 4; j++) {
          v[i][j].x -= mu; v[i][j].y -= mu; v[i][j].z -= mu; v[i][j].w -= mu;
          q += v[i][j].x * v[i][j].x + v[i][j].y * v[i][j].y + v[i][j].z * v[i][j].z + v[i][j].w * v[i][j].w;
        }
        const float rstd = rsqrtf(wave_sum(q) * (1.f / 1024.f) + LN_EPS);
#pragma unroll
        for (int j = 0; j < 4; j++) {
          const float4 gg = *(const float4*)&p.ln1_g[lane * 4 + 256 * j], b4 = *(const float4*)&p.ln1_b[lane * 4 + 256 * j];
          const float4 o = make_float4(v[i][j].x * rstd * gg.x + b4.x, v[i][j].y * rstd * gg.y + b4.y, v[i][j].z * rstd * gg.z + b4.z, v[i][j].w * rstd * gg.w + b4.w);
          *(float4*)&p.X1[(size_t)row * DM + lane * 4 + 256 * j] = o;
          uint2 h; h.x = pack2(o.x, o.y); h.y = pack2(o.z, o.w);
          *(uint2*)&p.X1B[(size_t)row * DM + lane * 4 + 256 * j] = h;
        }
      }
    }
    asm volatile("s_waitcnt vmcnt(0)" ::: "memory");
    __syncthreads();
    f32x4 acc[5];
#pragma unroll
    for (int i = 0; i < 5; i++) acc[i] = f32x4{0, 0, 0, 0};
    const float* xrow = p.X1 + (size_t)(row0 + l15) * DM + 256 * w + 4 * kg;
    struct RB { float4 a; float we[4][4]; float wg[4]; };
    auto rload = [&](int it, RB& r) {
      r.a = *(const float4*)&xrow[16 * it];
      const int kb = 256 * w + 16 * it + 4 * kg;
#pragma unroll
      for (int i = 0; i < 4; i++) {
        const float* we = p.w_er + (size_t)(kb + i) * 64 + l15;
#pragma unroll
        for (int nt = 0; nt < 4; nt++) r.we[i][nt] = we[16 * nt];
        r.wg[i] = (l15 < 8) ? p.w_gr[(size_t)(kb + i) * 8 + l15] : 0.f;
      }
    };
    auto rcomp = [&](const RB& r) {
      const float av[4] = {r.a.x, r.a.y, r.a.z, r.a.w};
#pragma unroll
      for (int i = 0; i < 4; i++) {
#pragma unroll
        for (int nt = 0; nt < 4; nt++) acc[nt] = __builtin_amdgcn_mfma_f32_16x16x4f32(av[i], r.we[i][nt], acc[nt], 0, 0, 0);
        acc[4] = __builtin_amdgcn_mfma_f32_16x16x4f32(av[i], r.wg[i], acc[4], 0, 0, 0);
      }
    };
    {
      RB r0, r1;
      rload(0, r0);
      for (int it = 0; it < 16; it += 2) {
        rload(it + 1, r1);
        rcomp(r0);
        if (it + 2 < 16) rload(it + 2, r0);
        rcomp(r1);
      }
    }
#pragma unroll
    for (int nt = 0; nt < 5; nt++)
#pragma unroll
      for (int r = 0; r < 4; r++) part[(w * 16 + kg * 4 + r) * 80 + nt * 16 + l15] = acc[nt][r];
    __syncthreads();
    for (int idx = tid; idx < 16 * 72; idx += 256) {
      const int r = idx / 72, c = idx % 72;
      logits[r * 72 + c] = part[(0 * 16 + r) * 80 + c] + part[(1 * 16 + r) * 80 + c] + part[(2 * 16 + r) * 80 + c] + part[(3 * 16 + r) * 80 + c];
    }
    __syncthreads();
    if (tid < 16) {
      const float* L = logits + tid * 72;
      const int tok = row0 + tid;
      float gm = L[64]; int gi = 0;
      for (int i = 1; i < 8; i++) if (L[64 + i] > gm) { gm = L[64 + i]; gi = i; }
      float gs = 0.f;
      for (int i = 0; i < 8; i++) gs += expf(L[64 + i] - gm);
      const float pg = 1.f / gs;
      const float* E = L + gi * 8;
      float em = E[0]; int i1 = 0;
      for (int i = 1; i < 8; i++) if (E[i] > em) { em = E[i]; i1 = i; }
      float e2 = -3.0e38f; int i2 = 0;
      for (int i = 0; i < 8; i++) if (i != i1 && E[i] > e2) { e2 = E[i]; i2 = i; }
      const float p1 = 1.f, p2 = expf(e2 - em);
      const float gt1 = pg * p1 / (p1 + p2), gt2 = pg * p2 / (p1 + p2);
      const int ex1 = gi * 8 + i1, ex2 = gi * 8 + i2;
      const int pos1 = atomicAdd(&p.cnt[ex1], 1);
      const int pos2 = atomicAdd(&p.cnt[ex2], 1);
      p.list_tok[ex1 * CAP + pos1] = tok; p.list_gate[ex1 * CAP + pos1] = gt1;
      p.list_tok[ex2 * CAP + pos2] = tok; p.list_gate[ex2 * CAP + pos2] = gt2;
      p.tok_e[tok * 2] = ex1; p.tok_e[tok * 2 + 1] = ex2;
      p.tok_pos[tok * 2] = pos1; p.tok_pos[tok * 2 + 1] = pos2;
    }
    __syncthreads();
  }
}

__device__ __forceinline__ void moe_prefix(const Params& p, int* s_off, int* s_rb) {
  __syncthreads();
  if (threadIdx.x == 0) {
    int o = 0, r = 0;
    for (int e = 0; e < NEXP; e++) {
      s_off[e] = o; s_rb[e] = r;
      int c = p.cnt[e];
      o += c; r += (c + 127) >> 7;
    }
    s_off[NEXP] = o; s_rb[NEXP] = r;
  }
  __syncthreads();
}

__device__ void phaseE1(const Params& p, char* smem) {
  int* s_off = (int*)(smem + 2 * GEMM_SMEM);
  int* s_rb = s_off + 72;
  moe_prefix(p, s_off, s_rb);
  xcd_queue_run(p.bar + QW_BASE + 1024, s_rb[NEXP], smem + 2 * GEMM_SMEM + 800, [&](int j, int q) {
    const int rbg = q, jt = j;
    int e = 0;
    while (s_rb[e + 1] <= rbg) e++;
    const int rb = rbg - s_rb[e];
    const int cnt = p.cnt[e];
    const int rows = min(128, cnt - rb * 128);
    const int* lt = p.list_tok + e * CAP + rb * 128;
    const int slot0 = s_off[e] + rb * 128;
    const int j0 = jt * 64;
    const u16* wg = p.WgT + (size_t)e * DEXP * DM;
    const u16* wu = p.WuT + (size_t)e * DEXP * DM;
    auto rowf = [&](int r) { int rr = r < rows ? r : 0; return (const void*)(p.X1B + (size_t)lt[rr] * DM); };
    auto colf = [&](int c) { return (const void*)(((c & 32) ? wu : wg) + (size_t)(j0 + (c >> 6) * 32 + (c & 31)) * DM); };
    auto epi = [&](f32x4 (&acc)[4][4], int mb, int nb) {
      const int wn = nb >> 6, kg4 = nb & 63;
#pragma unroll
      for (int mi = 0; mi < 4; mi++) {
        const int r = mb + mi * 16;
        if (r < rows) {
#pragma unroll
          for (int ni = 0; ni < 2; ni++) {
            f32x4 gv = acc[mi][ni], uv = acc[mi][ni + 2];
            uint2 o;
            o.x = pack2(siluf(gv[0]) * uv[0], siluf(gv[1]) * uv[1]);
            o.y = pack2(siluf(gv[2]) * uv[2], siluf(gv[3]) * uv[3]);
            *(uint2*)&p.H[(size_t)(slot0 + r) * DEXP + j0 + wn * 32 + ni * 16 + kg4] = o;
          }
        }
      }
    };
    gemm_tile<true, true>(smem, DM, rowf, colf, DEXP, epi);
  });
}

__device__ void phaseE2(const Params& p, char* smem) {
  int* s_off = (int*)(smem + 2 * GEMM_SMEM);
  int* s_rb = s_off + 72;
  moe_prefix(p, s_off, s_rb);
  xcd_queue_run(p.bar + QW_BASE + 1536, s_rb[NEXP], smem + 2 * GEMM_SMEM + 800, [&](int j, int q) {
    const int rbg = q, nt = j;
    int e = 0;
    while (s_rb[e + 1] <= rbg) e++;
    const int rb = rbg - s_rb[e];
    const int cnt = p.cnt[e];
    const int rows = min(128, cnt - rb * 128);
    const int slot0 = s_off[e] + rb * 128;
    const int n0 = nt * 128;
    const float* wd = p.w_down + (size_t)e * DEXP * DM;
    const float* lg = p.list_gate + e * CAP + rb * 128;
    auto rowf = [&](int r) { int rr = r < rows ? r : 0; return (const void*)(p.H + (size_t)(slot0 + rr) * DEXP); };
    auto colf = [&](int c) { return (const void*)(wd + n0 + c); };
    auto epi = [&](f32x4 (&acc)[4][4], int mb, int nb) {
#pragma unroll
      for (int mi = 0; mi < 4; mi++) {
        const int r = mb + mi * 16;
        if (r < rows) {
          const float gt = lg[r];
#pragma unroll
          for (int ni = 0; ni < 4; ni++) {
            f32x4 v = acc[mi][ni];
            uint2 o; o.x = pack2(gt * v[0], gt * v[1]); o.y = pack2(gt * v[2], gt * v[3]);
            *(uint2*)&p.Y[(size_t)(slot0 + r) * DM + n0 + nb + ni * 16] = o;
          }
        }
      }
    };
    gemm_tile<true, false>(smem, DEXP, rowf, colf, DM, epi);
  });
}

__device__ void phaseF(const Params& p, char* smem) {
  int* s_off = (int*)(smem + 2 * GEMM_SMEM);
  int* s_rb = s_off + 72;
  moe_prefix(p, s_off, s_rb);
  const int tid = threadIdx.x, lane = tid & 63, w = tid >> 6;
  for (int rp = blockIdx.x * 4 + w; rp < NTOK / 2; rp += gridDim.x * 4) {
    int sl[2][2];
#pragma unroll
    for (int h = 0; h < 2; h++) {
      const int row = rp * 2 + h;
      const int2 te = *(const int2*)&p.tok_e[row * 2], tp = *(const int2*)&p.tok_pos[row * 2];
      sl[h][0] = s_off[te.x] + tp.x;
      sl[h][1] = s_off[te.y] + tp.y;
    }
    float4 v[2][4];
#pragma unroll
    for (int h = 0; h < 2; h++) {
      const int row = rp * 2 + h;
#pragma unroll
      for (int i = 0; i < 4; i++) {
        const int c = lane * 4 + 256 * i;
        const float4 xv = *(const float4*)&p.X1[(size_t)row * DM + c];
        const uint2 ya = *(const uint2*)&p.Y[(size_t)sl[h][0] * DM + c];
        const uint2 yb = *(const uint2*)&p.Y[(size_t)sl[h][1] * DM + c];
        v[h][i].x = ALPHA * xv.x + (bflo(ya.x) + bflo(yb.x));
        v[h][i].y = ALPHA * xv.y + (bfhi(ya.x) + bfhi(yb.x));
        v[h][i].z = ALPHA * xv.z + (bflo(ya.y) + bflo(yb.y));
        v[h][i].w = ALPHA * xv.w + (bfhi(ya.y) + bfhi(yb.y));
      }
    }
#pragma unroll
    for (int h = 0; h < 2; h++) {
      const int row = rp * 2 + h;
      float s = 0.f;
#pragma unroll
      for (int i = 0; i < 4; i++) s += v[h][i].x + v[h][i].y + v[h][i].z + v[h][i].w;
      const float mu = wave_sum(s) * (1.f / 1024.f);
      float q = 0.f;
#pragma unroll
      for (int i = 0; i < 4; i++) {
        v[h][i].x -= mu; v[h][i].y -= mu; v[h][i].z -= mu; v[h][i].w -= mu;
        q += v[h][i].x * v[h][i].x + v[h][i].y * v[h][i].y + v[h][i].z * v[h][i].z + v[h][i].w * v[h][i].w;
      }
      const float rstd = rsqrtf(wave_sum(q) * (1.f / 1024.f) + LN_EPS);
#pragma unroll
      for (int i = 0; i < 4; i++) {
        const int c = lane * 4 + 256 * i;
        const float4 gg = *(const float4*)&p.ln2_g[c], b4 = *(const float4*)&p.ln2_b[c];
        *(float4*)&p.out[(size_t)row * DM + c] =
            make_float4(v[h][i].x * rstd * gg.x + b4.x, v[h][i].y * rstd * gg.y + b4.y, v[h][i].z * rstd * gg.z + b4.z, v[h][i].w * rstd * gg.w + b4.w);
      }
    }
  }
}


#define XB_TMO      128
#define XB_XCNT(j)  (256  + 64 * (j))
#define XB_XSUB(j)  (1280 + 64 * (j))
#define XB_XGEN(j)  (2304 + 64 * (j))
#define XB_TOP      3328
#define XB_TOPGEN   3392
#define XCD_BAR_WORDS 3456
#define XB_SPIN_CAP (1u << 18)
#define LAS __attribute__((address_space(3)))
__device__ __forceinline__ unsigned xb_ld(unsigned* p)              { return __hip_atomic_load(p, __ATOMIC_RELAXED, __HIP_MEMORY_SCOPE_AGENT); }
__device__ __forceinline__ unsigned xb_add(unsigned* p, unsigned v) { return __hip_atomic_fetch_add(p, v, __ATOMIC_RELAXED, __HIP_MEMORY_SCOPE_AGENT); }
__device__ __forceinline__ unsigned xb_xcc_id() { return (unsigned)__builtin_amdgcn_s_getreg((3 << 11) | 20) & 0xFu; }
#define XB_SPIN(cond, bar) do { unsigned _sp = 0; while (cond) { __builtin_amdgcn_s_sleep(1); \
    if ((++_sp & 255u) == 0u) { if (xb_ld(&(bar)[XB_TMO])) break; if (_sp > XB_SPIN_CAP) { atomicAdd(&(bar)[XB_TMO], 1u); break; } } } } while (0)
struct XcdBarrier { unsigned* bar; unsigned x; volatile LAS unsigned* st; };
__device__ __forceinline__ XcdBarrier xcd_barrier_post(unsigned* bar, volatile LAS unsigned* st) {
  XcdBarrier b; b.bar = bar; b.x = xb_xcc_id(); b.st = st;
  if (threadIdx.x == 0) (void)xb_add(&bar[XB_XCNT(b.x)], 1u);
  return b;
}
__device__ __forceinline__ void xcd_barrier_complete(unsigned* bar, unsigned x, unsigned& nloc, unsigned& nx) {
  const unsigned G = gridDim.x * gridDim.y * gridDim.z;
  unsigned sum, cnt, mine, sp = 0u;
  for (;;) {
    sum = 0u; cnt = 0u; mine = 0u;
#pragma unroll
    for (unsigned j = 0; j < 16; ++j) { const unsigned c = xb_ld(&bar[XB_XCNT(j)]); sum += c; cnt += (c > 0u) ? 1u : 0u; mine = (j == x) ? c : mine; }
    if (sum == G) break;
    __builtin_amdgcn_s_sleep(1);
    if ((++sp & 255u) == 0u) { if (xb_ld(&bar[XB_TMO])) break; if (sp > XB_SPIN_CAP) { atomicAdd(&bar[XB_TMO], 1u); break; } }
  }
  nloc = mine > 0u ? mine : 1u; nx = cnt > 0u ? cnt : 1u;
}
__device__ __forceinline__ void xcd_barrier(const XcdBarrier& b) {
  asm volatile("s_waitcnt vmcnt(0)" ::: "memory");
  __syncthreads();
  if (threadIdx.x == 0) {
    unsigned* bar = b.bar;
    __builtin_amdgcn_s_waitcnt(0);
    unsigned nloc = b.st[0], nx = b.st[1];
    if (nloc == 0u) { xcd_barrier_complete(bar, b.x, nloc, nx); b.st[0] = nloc; b.st[1] = nx; }
    const unsigned old = xb_add(&bar[XB_XSUB(b.x)], 1u);
    const unsigned gen = old / nloc;
    if (old + 1u == (gen + 1u) * nloc) {
      __builtin_amdgcn_fence(__ATOMIC_RELEASE, "agent");
      asm volatile("s_waitcnt vmcnt(0)" ::: "memory");
      const unsigned og = xb_add(&bar[XB_TOP], 1u);
      const unsigned tg = og / nx;
      if (og + 1u == (tg + 1u) * nx) xb_add(&bar[XB_TOPGEN], 1u);
      else XB_SPIN(xb_ld(&bar[XB_TOPGEN]) == tg, bar);
      __builtin_amdgcn_fence(__ATOMIC_ACQUIRE, "agent");
      xb_add(&bar[XB_XGEN(b.x)], 1u);
      asm volatile("s_waitcnt vmcnt(0)" ::: "memory");
    } else {
      XB_SPIN(xb_ld(&bar[XB_XGEN(b.x)]) == gen, bar);
      __builtin_amdgcn_fence(__ATOMIC_ACQUIRE, "agent");
      asm volatile("s_waitcnt vmcnt(0)" ::: "memory");
    }
  }
  __syncthreads();
}

__device__ void mid_barrier(const Params& p, char* smem) {
  XcdBarrier b; b.bar = p.bar; b.x = xb_xcc_id(); b.st = (volatile LAS unsigned*)(smem + 2 * GEMM_SMEM + 768);
  xcd_barrier(b);
}
constexpr int AUX_OFF = 2 * GEMM_SMEM;
constexpr int SMEM_BYTES = AUX_OFF + 1024;

#if SINGLE
__global__ void __launch_bounds__(256, 2) fwd_megakernel(Params p) {
  extern __shared__ __attribute__((aligned(16))) char smem[];
  cg::grid_group grid = cg::this_grid();
  volatile LAS unsigned* st = (volatile LAS unsigned*)(smem + AUX_OFF + 768);
  if (threadIdx.x < 2) st[threadIdx.x] = 0u;
  __syncthreads();
  XcdBarrier xb = xcd_barrier_post(p.bar, st);
  if (p.use_cg) grid.sync();
  phaseP0(p, smem);
  xcd_barrier(xb);
  phaseA(p, smem);
  xcd_barrier(xb);
  phaseB0(p, smem);
  xcd_barrier(xb);
  phaseB(p, smem);
  xcd_barrier(xb);
  phaseC(p, smem, 1);
  xcd_barrier(xb);
  phaseD(p, smem);
  xcd_barrier(xb);
  phaseE1(p, smem);
  xcd_barrier(xb);
  phaseE2(p, smem);
  xcd_barrier(xb);
  phaseF(p, smem);
}
#else
#define PHASE_KERNEL(NAME, FN)                                             \
  __global__ void __launch_bounds__(256, 2) NAME(Params p) {                  \
    __shared__ __attribute__((aligned(16))) char smem[SMEM_BYTES];         \
    FN(p, smem);                                                           \
  }
PHASE_KERNEL(kA, phaseA)
PHASE_KERNEL(kB, phaseB)
PHASE_KERNEL(kC, phaseC)
PHASE_KERNEL(kD, phaseD)
PHASE_KERNEL(kE1, phaseE1)
PHASE_KERNEL(kE2, phaseE2)
PHASE_KERNEL(kF, phaseF)
#endif

extern "C" void kernel_launch(void* const* d_in, const int* in_sizes, int n_in, void* d_out, int out_size,
                              void* d_ws, size_t ws_size, hipStream_t stream) {
  Params p{};
  p.x = (const float*)d_in[0];
  p.w_in = (const float*)d_in[1];
  p.w_a2 = (const float*)d_in[2];
  p.b_a = (const float*)d_in[3];
  p.lb = (const float*)d_in[4];
  p.norm_h = (const float*)d_in[5];
  p.norm_g = (const float*)d_in[6];
  p.w_out = (const float*)d_in[7];
  p.ln1_g = (const float*)d_in[8];
  p.ln1_b = (const float*)d_in[9];
  p.w_gr = (const float*)d_in[10];
  p.w_er = (const float*)d_in[11];
  p.w_gate = (const float*)d_in[12];
  p.w_up = (const float*)d_in[13];
  p.w_down = (const float*)d_in[14];
  p.ln2_g = (const float*)d_in[15];
  p.ln2_b = (const float*)d_in[16];
  p.out = (float*)d_out;
  char* ws = (char*)d_ws;
  size_t off = 0;
  auto take = [&](size_t bytes) { char* r = ws + off; off += (bytes + 255) & ~(size_t)255; return r; };
  p.P = (u16*)take((size_t)NTOK * INC * 2);
  p.LF = (float*)take((size_t)NTOK * 512 * 4);
  p.GA = (float*)take((size_t)NTOK * 16 * 4);
  p.Z = (float*)take((size_t)NTOK * DM * 4);
  p.O = (u16*)take((size_t)NTOK * DM * 2);
  p.X1 = (float*)take((size_t)NTOK * DM * 4);
  p.X1B = (u16*)take((size_t)NTOK * DM * 2);
  p.cnt = (int*)take(256);
  p.tok_e = (int*)take((size_t)NTOK * 2 * 4);
  p.tok_pos = (int*)take((size_t)NTOK * 2 * 4);
  p.list_tok = (int*)take((size_t)NEXP * CAP * 4);
  p.list_gate = (float*)take((size_t)NEXP * CAP * 4);
  p.bar = (unsigned*)take((XCD_BAR_WORDS + 2048) * 4);
  p.XB = p.O;
  p.WgT = (u16*)take((size_t)NEXP * DEXP * DM * 2);
  p.WuT = (u16*)take((size_t)NEXP * DEXP * DM * 2);
  p.IMGH = (char*)p.X1;
  p.IMGG = (char*)p.Z;
  p.WinT = (u16*)take((size_t)INC * DM * 2);
  p.WoutT = (u16*)take((size_t)DM * DM * 2);
  p.use_cg = 0; p.pad_ = 0;
  p.H = p.P;
  p.Y = p.P + (size_t)32768 * DEXP;

#if SINGLE
  static int grid_blocks = 0;
  if (!grid_blocks) {
    int dev = 0, cus = 0, per_cu = 0;
    hipGetDevice(&dev);
    hipDeviceGetAttribute(&cus, hipDeviceAttributeMultiprocessorCount, dev);
    if (hipFuncSetAttribute((const void*)fwd_megakernel, hipFuncAttributeMaxDynamicSharedMemorySize, SMEM_BYTES) != hipSuccess)
      fprintf(stderr, "hipFuncSetAttribute failed\n");
    hipOccupancyMaxActiveBlocksPerMultiprocessor(&per_cu, fwd_megakernel, 256, SMEM_BYTES);
    if (per_cu > 2) per_cu = 2;
    grid_blocks = cus * per_cu;
  }
  hipMemsetAsync(p.bar, 0, (XCD_BAR_WORDS + 2048) * 4, stream);
  void* args[] = {&p};
  hipError_t e = hipLaunchCooperativeKernel((void*)fwd_megakernel, dim3(grid_blocks), dim3(256), args, SMEM_BYTES, stream);
  if (e != hipSuccess) fprintf(stderr, "cooperative launch failed: %s (grid %d)\n", hipGetErrorString(e), grid_blocks);
#else
  const int G = 512;
  kA<<<G, 256, 0, stream>>>(p);
  kB<<<64, 256, 0, stream>>>(p);
  kC<<<G, 256, 0, stream>>>(p);
  kD<<<G, 256, 0, stream>>>(p);
  kE1<<<G, 256, 0, stream>>>(p);
  kE2<<<G, 256, 0, stream>>>(p);
  kF<<<G, 256, 0, stream>>>(p);
#endif
}
```

```cpp
#include <hip/hip_runtime.h>
#include <hip/hip_cooperative_groups.h>
#include <cstdio>
namespace cg = cooperative_groups;

#ifndef SINGLE
#define SINGLE 1
#endif

typedef unsigned short u16;
typedef __attribute__((ext_vector_type(8))) short bf16x8;
typedef __attribute__((ext_vector_type(4))) short bf16x4;
typedef __attribute__((ext_vector_type(4))) float f32x4;
typedef __bf16 bf16x2_t __attribute__((ext_vector_type(2)));
typedef float f32x2_t __attribute__((ext_vector_type(2)));
typedef unsigned u32x4 __attribute__((ext_vector_type(4)));
typedef unsigned u32x2 __attribute__((ext_vector_type(2)));

constexpr int NTOK = 16384;
constexpr int SEQ = 2048;
constexpr int DM = 1024;
constexpr int INC = 3600;
constexpr int NEXP = 64;
constexpr int DEXP = 512;
constexpr int CAP = 32768;
constexpr float ALPHA = 1.189207115002721f;
constexpr float LN_EPS = 1e-5f;

struct Params {
  const float *x, *w_in, *w_a2, *b_a, *lb, *norm_h, *norm_g, *w_out, *ln1_g, *ln1_b, *w_gr, *w_er,
      *w_gate, *w_up, *w_down, *ln2_g, *ln2_b;
  float* out;
  u16* P;
  float* LF;
  float* GA;
  float* Z;
  u16* O;
  float* X1;
  u16* X1B;
  u16* H;
  u16* Y;
  int* cnt;
  int* tok_e;
  int* tok_pos;
  int* list_tok;
  float* list_gate;
  u16* XB;
  u16* WinT;
  u16* WoutT;
  u16* WgT;
  u16* WuT;
  char* IMGH;
  char* IMGG;
  unsigned* bar;
  int use_cg; int pad_;
};

__device__ __forceinline__ unsigned pack2(float a, float b) {
  f32x2_t f = {a, b};
  bf16x2_t h = __builtin_convertvector(f, bf16x2_t);
  return *(unsigned*)&h;
}
__device__ __forceinline__ u16 f2bf(float a) {
  __bf16 h = (__bf16)a;
  return *(u16*)&h;
}
__device__ __forceinline__ float bf2f(u16 v) { return __uint_as_float(((unsigned)v) << 16); }
__device__ __forceinline__ float bflo(unsigned v) { return __uint_as_float(v << 16); }
__device__ __forceinline__ float bfhi(unsigned v) { return __uint_as_float(v & 0xffff0000u); }
__device__ __forceinline__ float sigmoidf(float x) { return 1.f / (1.f + __expf(-x)); }
__device__ __forceinline__ float siluf(float x) { return x / (1.f + __expf(-x)); }


constexpr int QW_BASE = 3456;
__device__ __forceinline__ unsigned my_xcc_id() { return (unsigned)__builtin_amdgcn_s_getreg((3 << 11) | 20) & 7u; }
template <class F>
__device__ __forceinline__ void xcd_queue_run(unsigned* qwords, int nper, char* smem_aux, F fn) {
  volatile int* slot = (volatile int*)smem_aux;
  const unsigned x = my_xcc_id();
  for (int dj = 0; dj < 8; dj++) {
    const int j = (int)((x + dj) & 7u);
    for (;;) {
      __syncthreads();
      if (threadIdx.x == 0) *slot = (int)__hip_atomic_fetch_add(qwords + 64 * j, 1u, __ATOMIC_RELAXED, __HIP_MEMORY_SCOPE_AGENT);
      __syncthreads();
      const int q = *slot;
      if (q >= nper) break;
      fn(j, q);
    }
  }
}

constexpr int BM = 128, BN = 128, BK = 64, LDT = 64;
constexpr int GEMM_SMEM = (BM + BN) * LDT * 2;

template <bool ABF, bool BBF, class RowF, class ColF, class Epi>
__device__ __forceinline__ void gemm_tile(char* smem, int K, RowF rowptr, ColF colptr, int ldb, Epi epi) {
  u16* As0 = (u16*)smem;
  const int tid = threadIdx.x, lane = tid & 63, w = tid >> 6, wm = w >> 1, wn = w & 1;
  const int l15 = lane & 15, kg = lane >> 4, swz = (l15 >> 1) & 7;
  f32x4 acc[4][4];
#pragma unroll
  for (int i = 0; i < 4; i++)
#pragma unroll
    for (int j = 0; j < 4; j++) acc[i][j] = f32x4{0.f, 0.f, 0.f, 0.f};

  constexpr int NA = ABF ? 4 : 8;
  const int ar0 = ABF ? (tid >> 3) : (tid >> 4);
  const int ac = ABF ? (tid & 7) * 8 : (tid & 15) * 4;
  constexpr int ARS = ABF ? 32 : 16;
  const char* ap[NA];
#pragma unroll
  for (int i = 0; i < NA; i++) ap[i] = (const char*)rowptr(ar0 + ARS * i) + ac * (ABF ? 2 : 4);
  const int bc = tid & 127, kh = tid >> 7;
  const float* bp = BBF ? nullptr : ((const float*)colptr(bc) + (size_t)(kh * 32) * ldb);
  const int br0 = tid >> 3, bcc = (tid & 7) * 8;
  const char* bq[4];
  if (BBF) {
#pragma unroll
    for (int i = 0; i < 4; i++) bq[i] = (const char*)colptr(br0 + 32 * i) + bcc * 2;
  }

  u32x4 ra[NA];
  float rb[BBF ? 1 : 32];
  u32x4 rbb[BBF ? 4 : 1];
  auto gload = [&](int k0) {
#pragma unroll
    for (int i = 0; i < NA; i++) ra[i] = *(const u32x4*)(ap[i] + (size_t)k0 * (ABF ? 2 : 4));
    if (BBF) {
#pragma unroll
      for (int i = 0; i < 4; i++) rbb[BBF ? i : 0] = *(const u32x4*)(bq[i] + (size_t)k0 * 2);
    } else {
      const float* b = bp + (size_t)k0 * ldb;
#pragma unroll
      for (int j = 0; j < 32; j++) rb[BBF ? 0 : j] = b[(size_t)j * ldb];
    }
  };
  auto sstore = [&](int buf) {
    u16* As = As0 + buf * (GEMM_SMEM / 2);
    u16* Bs = As + BM * LDT;
#pragma unroll
    for (int i = 0; i < NA; i++) {
      if (ABF) {
        { const int row = ar0 + ARS * i; *(u32x4*)&As[row * LDT + (((ac >> 3) ^ ((row >> 1) & 7)) << 3)] = ra[i]; }
      } else {
        u32x2 v;
        v[0] = pack2(__uint_as_float(ra[i][0]), __uint_as_float(ra[i][1]));
        v[1] = pack2(__uint_as_float(ra[i][2]), __uint_as_float(ra[i][3]));
        { const int row = ar0 + ARS * i; *(u32x2*)&As[row * LDT + (((ac >> 3) ^ ((row >> 1) & 7)) << 3) + (ac & 4)] = v; }
      }
    }
    if (BBF) {
#pragma unroll
      for (int i = 0; i < 4; i++) { const int row = br0 + 32 * i; *(u32x4*)&Bs[row * LDT + (((bcc >> 3) ^ ((row >> 1) & 7)) << 3)] = rbb[BBF ? i : 0]; }
    } else {
#pragma unroll
      for (int j = 0; j < 4; j++) {
        u32x4 v;
        v[0] = pack2(rb[BBF ? 0 : 8 * j + 0], rb[BBF ? 0 : 8 * j + 1]);
        v[1] = pack2(rb[BBF ? 0 : 8 * j + 2], rb[BBF ? 0 : 8 * j + 3]);
        v[2] = pack2(rb[BBF ? 0 : 8 * j + 4], rb[BBF ? 0 : 8 * j + 5]);
        v[3] = pack2(rb[BBF ? 0 : 8 * j + 6], rb[BBF ? 0 : 8 * j + 7]);
        *(u32x4*)&Bs[bc * LDT + (((kh * 4 + j) ^ ((bc >> 1) & 7)) << 3)] = v;
      }
    }
  };

  gload(0);
  sstore(0);
  __syncthreads();
  int cur = 0;
  for (int k0 = 0; k0 < K; k0 += BK) {
    if (k0 + BK < K) gload(k0 + BK);
    const u16* As = As0 + cur * (GEMM_SMEM / 2);
    const u16* Bs = As + BM * LDT;
    {
      bf16x8 af[2][4], bfr[2][4];
#pragma unroll
      for (int ks = 0; ks < 2; ks++) {
#pragma unroll
        for (int mi = 0; mi < 4; mi++) af[ks][mi] = *(const bf16x8*)&As[(wm * 64 + mi * 16 + l15) * LDT + (((ks * 4 + kg) ^ swz) << 3)];
#pragma unroll
        for (int ni = 0; ni < 4; ni++) bfr[ks][ni] = *(const bf16x8*)&Bs[(wn * 64 + ni * 16 + l15) * LDT + (((ks * 4 + kg) ^ swz) << 3)];
      }
      __builtin_amdgcn_sched_barrier(0);
#pragma unroll
      for (int ks = 0; ks < 2; ks++)
#pragma unroll
        for (int mi = 0; mi < 4; mi++)
#pragma unroll
          for (int ni = 0; ni < 4; ni++)
            acc[mi][ni] = __builtin_amdgcn_mfma_f32_16x16x32_bf16(bfr[ks][ni], af[ks][mi], acc[mi][ni], 0, 0, 0);
      __builtin_amdgcn_sched_barrier(0);
    }
    if (k0 + BK < K) sstore(cur ^ 1);
    __syncthreads();
    cur ^= 1;
  }
  epi(acc, wm * 64 + l15, wn * 64 + kg * 4);
}


__device__ void transpose_tile(const float* W, int ld, int N, int k0, int n0, u16* WT, int K, char* smem) {
  u16* T = (u16*)smem;
  const int tid = threadIdx.x;
  __syncthreads();
  {
    const int r = tid >> 4, c4 = (tid & 15) * 4;
#pragma unroll
    for (int i = 0; i < 4; i++) {
      const int k = r + 16 * i;
      float4 v = make_float4(0.f, 0.f, 0.f, 0.f);
      if (n0 + c4 < N) v = *(const float4*)&W[(size_t)(k0 + k) * ld + n0 + c4];
      T[(c4 + 0) * 72 + k] = f2bf(v.x); T[(c4 + 1) * 72 + k] = f2bf(v.y);
      T[(c4 + 2) * 72 + k] = f2bf(v.z); T[(c4 + 3) * 72 + k] = f2bf(v.w);
    }
  }
  __syncthreads();
  {
    const int n = tid >> 2, seg = (tid & 3) * 16;
    if (n0 + n < N) {
      u32x4 a = *(const u32x4*)&T[n * 72 + seg], b = *(const u32x4*)&T[n * 72 + seg + 8];
      *(u32x4*)&WT[(size_t)(n0 + n) * K + k0 + seg] = a;
      *(u32x4*)&WT[(size_t)(n0 + n) * K + k0 + seg + 8] = b;
    }
  }
}
__device__ void phaseP0(const Params& p, char* smem) {
  if (blockIdx.x == 0 && threadIdx.x < 64) p.cnt[threadIdx.x] = 0;
  constexpr int NTI = 57 * 16, NTO = 16 * 16;
  for (int u = blockIdx.x; u < NTI + NTO; u += gridDim.x) {
    if (u < NTI) transpose_tile(p.w_in, INC, INC, (u % 16) * 64, (u / 16) * 64, p.WinT, DM, smem);
    else { const int v = u - NTI; transpose_tile(p.w_out, DM, DM, (v % 16) * 64, (v / 16) * 64, p.WoutT, DM, smem); }
  }
  const size_t n4 = (size_t)NTOK * DM / 4;
  for (size_t i = blockIdx.x * (size_t)256 + threadIdx.x; i < n4; i += (size_t)gridDim.x * 256) {
    float4 v = ((const float4*)p.x)[i];
    uint2 o; o.x = pack2(v.x, v.y); o.y = pack2(v.z, v.w);
    ((uint2*)p.XB)[i] = o;
  }
}

__device__ void phaseA(const Params& p, char* smem) {
  xcd_queue_run(p.bar + QW_BASE, 464, smem + 2 * GEMM_SMEM + 800, [&](int j, int q) {
    const int pj = j >> 1, odd = j & 1;
    int mt, nt;
    if (q < 384) { mt = q / 3; nt = 7 * pj + odd * 4 + q % 3; }
    else if (q < 448) { mt = odd * 64 + (q - 384); nt = 7 * pj + 3; }
    else { mt = 16 * j + (q - 448); nt = 28; }
    const int m0 = mt * 128, n0 = nt * 128;
    const u16* xa = p.XB + (size_t)m0 * DM;
    auto rowf = [&](int r) { return (const void*)(xa + (size_t)r * DM); };
    auto colf = [&](int c) { int n = n0 + c; if (n > INC - 1) n = INC - 1; return (const void*)(p.WinT + (size_t)n * DM); };
    auto epi = [&](f32x4 (&acc)[4][4], int mb, int nb) {
#pragma unroll
      for (int mi = 0; mi < 4; mi++)
#pragma unroll
        for (int ni = 0; ni < 4; ni++) {
          const int m = m0 + mb + mi * 16, n = n0 + nb + ni * 16;
          f32x4 v = acc[mi][ni];
          if (n >= INC) continue;
          if (n >= 512 && n < 1024) {
            const int c = n - 512;
            float lf[4], kf[4];
#pragma unroll
            for (int r = 0; r < 4; r++) {
              float lbv = sigmoidf(p.lb[c + r] - p.lb[512 + c + r]);
              float sg = sigmoidf(v[r]);
              float f = lbv + (1.f - lbv) * sg;
              lf[r] = __logf(f);
              kf[r] = (1.f - lbv) * (1.f - sg);
            }
            *(float4*)&p.LF[(size_t)m * 512 + c] = make_float4(lf[0], lf[1], lf[2], lf[3]);
            uint2 o; o.x = pack2(kf[0], kf[1]); o.y = pack2(kf[2], kf[3]);
            *(uint2*)&p.P[(size_t)m * INC + n] = o;
          } else if (n >= 3072 && n < 3088) {
            *(float4*)&p.GA[(size_t)m * 16 + (n - 3072)] = make_float4(v[0], v[1], v[2], v[3]);
          } else {
            if (n < 512) { v *= 0.08838834764831845f; }
            else if ((n >= 1536 && n < 2048) || n >= 3088) {
#pragma unroll
              for (int r = 0; r < 4; r++) v[r] = siluf(v[r]);
            } else if (n >= 2048 && n < 2304) { v *= 0.125f; }
            uint2 o; o.x = pack2(v[0], v[1]); o.y = pack2(v[2], v[3]);
            *(uint2*)&p.P[(size_t)m * INC + n] = o;
          }
        }
    };
    gemm_tile<true, true>(smem, DM, rowf, colf, INC, epi);
  });
}

__device__ __forceinline__ float dpp_scan_add(float x) {
  int xi;
  xi = __builtin_amdgcn_update_dpp(0, __float_as_int(x), 0x111, 0xf, 0xf, true); x += __int_as_float(xi);
  xi = __builtin_amdgcn_update_dpp(0, __float_as_int(x), 0x112, 0xf, 0xf, true); x += __int_as_float(xi);
  xi = __builtin_amdgcn_update_dpp(0, __float_as_int(x), 0x114, 0xf, 0xf, true); x += __int_as_float(xi);
  xi = __builtin_amdgcn_update_dpp(0, __float_as_int(x), 0x118, 0xf, 0xf, true); x += __int_as_float(xi);
  return x;
}


__device__ __forceinline__ float dpp_row_bcast15(float x) {
  return __int_as_float(__builtin_amdgcn_update_dpp(0, __float_as_int(x), 0x15F, 0xf, 0xf, false));
}
__device__ __forceinline__ float dpp_row_sum(float x) {
  x += __int_as_float(__builtin_amdgcn_update_dpp(0, __float_as_int(x), 0x128, 0xf, 0xf, false));
  x += __int_as_float(__builtin_amdgcn_update_dpp(0, __float_as_int(x), 0x124, 0xf, 0xf, false));
  x += __int_as_float(__builtin_amdgcn_update_dpp(0, __float_as_int(x), 0x122, 0xf, 0xf, false));
  x += __int_as_float(__builtin_amdgcn_update_dpp(0, __float_as_int(x), 0x121, 0xf, 0xf, false));
  return x;
}

#define STAGE() do { } while (0)
__device__ void mid_barrier(const Params& p, char* smem);
__device__ void phaseC(const Params& p, char* smem, int which);
template <int DK, bool HG, int MODE>
__device__ void recur_unit(const Params& p, char* smem, int b, int h, char* img, int nstart, int nstep, int nend) {
  constexpr int IMG = (2 * 16 * (DK + 8) + DK * 20 + 128 * 20) * 2 + DK * 4;
  constexpr int NIM = (IMG + 4095) / 4096;
  constexpr int KPT = DK / 16;
  constexpr int NKS = DK / 32;
  constexpr int NKT = DK / 16;
  constexpr int LQ = DK + 8;
  u16* Qt = (u16*)smem;
  u16* Kt = Qt + 16 * LQ;
  u16* KhT = Kt + 16 * LQ;
  u16* VT = KhT + DK * 20;
  float* Gch = (float*)(VT + 128 * 20);
  float* SS = Gch + DK;
  float* Wa = SS + 64;
  u16* GT = (u16*)(smem + 20480);
  u16* OT = (u16*)(smem + 24832);

  const int tid = threadIdx.x, lane = tid & 63, w = tid >> 6, l15 = lane & 15, kg = lane >> 4;
  const int t = tid & 15, kgp = tid >> 4, k0 = kgp * KPT;
  const int qcol = HG ? (h * 128) : (2048 + h * 64);
  const int kcol = HG ? (512 + h * 128) : (2304 + h * 64);
  const int vcol = HG ? (1024 + h * 128) : (2560 + h * 128);
  const int gcol = HG ? (1536 + h * 128) : (3088 + h * 128);
  const int ocol = HG ? (h * 128) : (512 + h * 128);
  const float* gain = HG ? p.norm_h : p.norm_g;

  float ba[KPT];
  if (!HG && MODE == 1) {
    __syncthreads();
    for (int i = tid; i < 16 * 64; i += 256) Wa[i] = p.w_a2[(i >> 6) * 256 + h * 64 + (i & 63)];
#pragma unroll
    for (int i = 0; i < KPT; i++) ba[i] = p.b_a[h * 64 + k0 + i];
    __syncthreads();
  }
  const float g0 = gain[h * 128 + w * 32 + l15], g1 = gain[h * 128 + w * 32 + 16 + l15];

  f32x4 S[NKT][2];
#pragma unroll
  for (int i = 0; i < NKT; i++) { S[i][0] = f32x4{0, 0, 0, 0}; S[i][1] = f32x4{0, 0, 0, 0}; }

  float4 pl[4];
  uint4 pq, pk, pv;
  u16 psg[8];
  u32x4 imA[NIM], imB[NIM];
  u16 psgB[8];
  auto prefetch = [&](int n, u32x4 (&im)[NIM], u16 (&psg)[8]) {
    if (MODE == 2) {
      const char* src = img + (size_t)n * IMG;
#pragma unroll
      for (int i = 0; i < NIM; i++) if (tid * 16 + 4096 * i < IMG) im[i] = *(const u32x4*)(src + tid * 16 + 4096 * i);
      {
        const u32x4 g = *(const u32x4*)(p.P + ((size_t)b * SEQ + n * 16 + (tid >> 4)) * INC + gcol + (tid & 15) * 8);
        psg[0] = (u16)(g[0] & 0xffff); psg[1] = (u16)(g[0] >> 16); psg[2] = (u16)(g[1] & 0xffff); psg[3] = (u16)(g[1] >> 16);
        psg[4] = (u16)(g[2] & 0xffff); psg[5] = (u16)(g[2] >> 16); psg[6] = (u16)(g[3] & 0xffff); psg[7] = (u16)(g[3] >> 16);
      }
      return;
    }
    const size_t tok = (size_t)b * SEQ + n * 16 + t;
    const u16* prow = p.P + tok * INC;
    if (HG) {
      pl[0] = *(const float4*)&p.LF[tok * 512 + h * 128 + k0];
      pl[1] = *(const float4*)&p.LF[tok * 512 + h * 128 + k0 + 4];
      pq = *(const uint4*)&prow[qcol + k0];
      pk = *(const uint4*)&prow[kcol + k0];
    } else {
#pragma unroll
      for (int i = 0; i < 4; i++) pl[i] = *(const float4*)&p.GA[tok * 16 + 4 * i];
      uint2 a = *(const uint2*)&prow[qcol + k0];
      uint2 c = *(const uint2*)&prow[kcol + k0];
      pq.x = a.x; pq.y = a.y; pk.x = c.x; pk.y = c.y;
    }
    pv = *(const uint4*)&prow[vcol + kgp * 8];
  };

  constexpr int PFD = (MODE == 2) ? 2 : 1;
  auto step = [&](int n, u32x4 (&im)[NIM], u16 (&psg)[8]) {
    float sgate[8];
    if (MODE == 2) {
#pragma unroll
      for (int i = 0; i < NIM; i++) if (tid * 16 + 4096 * i < IMG) *(u32x4*)(smem + tid * 16 + 4096 * i) = im[i];
      {
        u32x4 g;
        g[0] = (unsigned)psg[0] | ((unsigned)psg[1] << 16); g[1] = (unsigned)psg[2] | ((unsigned)psg[3] << 16);
        g[2] = (unsigned)psg[4] | ((unsigned)psg[5] << 16); g[3] = (unsigned)psg[6] | ((unsigned)psg[7] << 16);
        *(u32x4*)&GT[(tid >> 4) * 136 + (tid & 15) * 8] = g;
      }
      __builtin_amdgcn_sched_barrier(0);
      if (n + PFD * nstep < nend) prefetch(n + PFD * nstep, im, psg);
      __builtin_amdgcn_sched_barrier(0);
    } else {
    float lg[KPT], qv[KPT], kv[KPT];
    if (HG) {
      lg[0] = pl[0].x; lg[1] = pl[0].y; lg[2] = pl[0].z; lg[3] = pl[0].w;
      if (KPT > 4) { lg[4 % KPT] = pl[1].x; lg[5 % KPT] = pl[1].y; lg[6 % KPT] = pl[1].z; lg[7 % KPT] = pl[1].w; }
    } else {
      float ga[16] = {pl[0].x, pl[0].y, pl[0].z, pl[0].w, pl[1].x, pl[1].y, pl[1].z, pl[1].w,
                      pl[2].x, pl[2].y, pl[2].z, pl[2].w, pl[3].x, pl[3].y, pl[3].z, pl[3].w};
      float z[4] = {ba[0], ba[1], ba[2], ba[3]};
#pragma unroll
      for (int r = 0; r < 16; r++) {
        float4 wv = *(const float4*)&Wa[r * 64 + k0];
        z[0] += ga[r] * wv.x; z[1] += ga[r] * wv.y; z[2] += ga[r] * wv.z; z[3] += ga[r] * wv.w;
      }
#pragma unroll
      for (int i = 0; i < 4; i++) {
        float sp = fmaxf(-z[i], 0.f) + __logf(1.f + __expf(-fabsf(z[i])));
        lg[i] = -sp * (1.f / 16.f);
      }
    }
    {
      unsigned qq[4] = {pq.x, pq.y, pq.z, pq.w}, kk[4] = {pk.x, pk.y, pk.z, pk.w};
#pragma unroll
      for (int i = 0; i < KPT / 2; i++) {
        qv[2 * i] = bflo(qq[i]); qv[2 * i + 1] = bfhi(qq[i]);
        kv[2 * i] = bflo(kk[i]); kv[2 * i + 1] = bfhi(kk[i]);
      }
    }
    {
      unsigned vv[4] = {pv.x, pv.y, pv.z, pv.w};
#pragma unroll
      for (int i = 0; i < 4; i++) {
        VT[(kgp * 8 + 2 * i) * 20 + t] = (u16)(vv[i] & 0xffff);
        VT[(kgp * 8 + 2 * i + 1) * 20 + t] = (u16)(vv[i] >> 16);
      }
    }
    __builtin_amdgcn_sched_barrier(0);
    if (n + nstep < nend) prefetch(n + nstep, im, psg);
    __builtin_amdgcn_sched_barrier(0);
    float qt[KPT], kt[KPT], kh[KPT];
#pragma unroll
    for (int i = 0; i < KPT; i++) {
      float bcum = dpp_scan_add(lg[i]);
      float bl = dpp_row_bcast15(bcum);
      qt[i] = qv[i] * __expf(bcum);
      kt[i] = kv[i] * __expf(-bcum);
      kh[i] = kv[i] * __expf(bl - bcum);
      if (t == 15) Gch[k0 + i] = __expf(bl);
      KhT[(k0 + i) * 20 + t] = f2bf(kh[i]);
    }
    if (KPT == 8) {
      uint4 a, c;
      a.x = pack2(qt[0], qt[1]); a.y = pack2(qt[2], qt[3]); a.z = pack2(qt[4 % KPT], qt[5 % KPT]); a.w = pack2(qt[6 % KPT], qt[7 % KPT]);
      c.x = pack2(kt[0], kt[1]); c.y = pack2(kt[2], kt[3]); c.z = pack2(kt[4 % KPT], kt[5 % KPT]); c.w = pack2(kt[6 % KPT], kt[7 % KPT]);
      *(uint4*)&Qt[t * LQ + k0] = a;
      *(uint4*)&Kt[t * LQ + k0] = c;
    } else {
      uint2 a, c;
      a.x = pack2(qt[0], qt[1]); a.y = pack2(qt[2], qt[3]);
      c.x = pack2(kt[0], kt[1]); c.y = pack2(kt[2], kt[3]);
      *(uint2*)&Qt[t * LQ + k0] = a;
      *(uint2*)&Kt[t * LQ + k0] = c;
    }
    }
    __syncthreads();
    if (MODE == 1) {
      char* dst = img + (size_t)n * IMG;
#pragma unroll
      for (int i = 0; i < NIM; i++) if (tid * 16 + 4096 * i < IMG) *(u32x4*)(dst + tid * 16 + 4096 * i) = *(const u32x4*)(smem + tid * 16 + 4096 * i);
      __syncthreads();
      return;
    }

    STAGE();
    f32x4 sc = f32x4{0, 0, 0, 0};
    bf16x8 qf[NKS];
#pragma unroll
    for (int st = 0; st < NKS; st++) {
      bf16x4 q0 = *(const bf16x4*)&Qt[l15 * LQ + 32 * st + kg * 4];
      bf16x4 q1 = *(const bf16x4*)&Qt[l15 * LQ + 32 * st + 16 + kg * 4];
      bf16x4 c0 = *(const bf16x4*)&Kt[l15 * LQ + 32 * st + kg * 4];
      bf16x4 c1 = *(const bf16x4*)&Kt[l15 * LQ + 32 * st + 16 + kg * 4];
      qf[st] = bf16x8{q0[0], q0[1], q0[2], q0[3], q1[0], q1[1], q1[2], q1[3]};
      bf16x8 kf = bf16x8{c0[0], c0[1], c0[2], c0[3], c1[0], c1[1], c1[2], c1[3]};
      sc = __builtin_amdgcn_mfma_f32_16x16x32_bf16(kf, qf[st], sc, 0, 0, 0);
    }
    STAGE();
#pragma unroll
    for (int r = 0; r < 4; r++) if (kg * 4 + r > l15) sc[r] = 0.f;
    bf16x4 pA;
    {
      unsigned a = pack2(sc[0], sc[1]), c = pack2(sc[2], sc[3]);
      pA = bf16x4{(short)(a & 0xffff), (short)(a >> 16), (short)(c & 0xffff), (short)(c >> 16)};
    }
    bf16x4 vf[2];
    f32x4 o[2], oin[2];
    bf16x8 sbv[2][NKS];
#pragma unroll
    for (int vt = 0; vt < 2; vt++) {
      vf[vt] = *(const bf16x4*)&VT[(w * 32 + vt * 16 + l15) * 20 + kg * 4];
#pragma unroll
      for (int st = 0; st < NKS; st++) {
        unsigned s0 = pack2(S[2 * st][vt][0], S[2 * st][vt][1]), s1 = pack2(S[2 * st][vt][2], S[2 * st][vt][3]);
        unsigned s2 = pack2(S[2 * st + 1][vt][0], S[2 * st + 1][vt][1]), s3 = pack2(S[2 * st + 1][vt][2], S[2 * st + 1][vt][3]);
        sbv[vt][st] = bf16x8{(short)(s0 & 0xffff), (short)(s0 >> 16), (short)(s1 & 0xffff), (short)(s1 >> 16),
                           (short)(s2 & 0xffff), (short)(s2 >> 16), (short)(s3 & 0xffff), (short)(s3 >> 16)};
      }
    }
    STAGE();
#pragma unroll
    for (int vt = 0; vt < 2; vt++) {
      o[vt] = __builtin_amdgcn_mfma_f32_16x16x16bf16_1k(pA, vf[vt], f32x4{0, 0, 0, 0}, 0, 0, 0);
      oin[vt] = f32x4{0, 0, 0, 0};
#pragma unroll
      for (int st = 0; st < NKS; st++) oin[vt] = __builtin_amdgcn_mfma_f32_16x16x32_bf16(qf[st], sbv[vt][st], oin[vt], 0, 0, 0);
    }
    STAGE();
    bf16x4 khf[NKT];
#pragma unroll
    for (int kt2 = 0; kt2 < NKT; kt2++) {
      khf[kt2] = *(const bf16x4*)&KhT[(16 * kt2 + l15) * 20 + kg * 4];
      float4 g4 = *(const float4*)&Gch[16 * kt2 + kg * 4];
      f32x4 gv = f32x4{g4.x, g4.y, g4.z, g4.w};
      S[kt2][0] *= gv; S[kt2][1] *= gv;
    }
    STAGE();
#pragma unroll
    for (int kt2 = 0; kt2 < NKT; kt2++) {
#pragma unroll
      for (int vt = 0; vt < 2; vt++)
        S[kt2][vt] = __builtin_amdgcn_mfma_f32_16x16x16bf16_1k(khf[kt2], vf[vt], S[kt2][vt], 0, 0, 0);
    }
    STAGE();
    float ss[4];
#pragma unroll
    for (int r = 0; r < 4; r++) {
      o[0][r] += oin[0][r]; o[1][r] += oin[1][r];
      float s = o[0][r] * o[0][r] + o[1][r] * o[1][r];
      s = dpp_row_sum(s);
      ss[r] = s;
    }
    if (l15 == 0) *(float4*)&SS[w * 16 + kg * 4] = make_float4(ss[0], ss[1], ss[2], ss[3]);
    __syncthreads();
    {
      float4 a0 = *(const float4*)&SS[0 * 16 + kg * 4], a1 = *(const float4*)&SS[1 * 16 + kg * 4];
      float4 a2 = *(const float4*)&SS[2 * 16 + kg * 4], a3 = *(const float4*)&SS[3 * 16 + kg * 4];
      float tot[4] = {a0.x + a1.x + a2.x + a3.x, a0.y + a1.y + a2.y + a3.y, a0.z + a1.z + a2.z + a3.z, a0.w + a1.w + a2.w + a3.w};
#pragma unroll
      for (int r = 0; r < 4; r++) {
        const float rstd = rsqrtf(tot[r] * (1.f / 128.f) + LN_EPS);
        const int li = (kg * 4 + r) * 136 + w * 32 + l15;
        sgate[r] = bf2f(GT[li]); sgate[4 + r] = bf2f(GT[li + 16]);
        OT[li] = f2bf(o[0][r] * rstd * g0 * sgate[r]);
        OT[li + 16] = f2bf(o[1][r] * rstd * g1 * sgate[4 + r]);
      }
    }
    __syncthreads();
    *(u32x4*)(p.O + ((size_t)b * SEQ + n * 16 + (tid >> 4)) * DM + ocol + (tid & 15) * 8) = *(const u32x4*)&OT[(tid >> 4) * 136 + (tid & 15) * 8];
  };
  if (MODE == 2) {
    prefetch(0, imA, psg);
    prefetch(1, imB, psgB);
    for (int n = 0; n < SEQ / 16; n += 2) {
      if (n == 62) mid_barrier(p, smem);
      step(n, imA, psg); step(n + 1, imB, psgB);
    }
  } else {
    prefetch(nstart, imA, psg);
    for (int n = nstart; n < nend; n += nstep) step(n, imA, psg);
  }
}

constexpr size_t IMGH_SZ = (2 * 16 * 136 + 128 * 20 + 128 * 20) * 2 + 128 * 4;
constexpr size_t IMGG_SZ = (2 * 16 * 72 + 64 * 20 + 128 * 20) * 2 + 64 * 4;
__device__ void phaseB0(const Params& p, char* smem) {
  const int nparts = gridDim.x >> 6;
  if ((int)blockIdx.x >= nparts * 64) return;
  const int u = blockIdx.x & 63, part = blockIdx.x >> 6;
  __syncthreads();
  if (u < 32) recur_unit<128, true, 1>(p, smem, u >> 2, u & 3, p.IMGH + (size_t)u * 128 * IMGH_SZ, part, nparts, 64);
  else recur_unit<64, false, 1>(p, smem, (u - 32) >> 2, u & 3, p.IMGG + (size_t)(u - 32) * 128 * IMGG_SZ, part, nparts, 64);
}
__device__ void phaseB(const Params& p, char* smem) {
  if (blockIdx.x >= 64) {
    const bool quiet = (gridDim.x == 512) && (blockIdx.x >= 256) && (blockIdx.x < 320);
    const int nb = (gridDim.x == 512) ? 384 : ((int)gridDim.x - 64);
    const int fidx = (gridDim.x == 512) ? ((blockIdx.x < 256) ? (int)blockIdx.x - 64 : (int)blockIdx.x - 128) : ((int)blockIdx.x - 64);
    if (quiet) { mid_barrier(p, smem); return; }
    constexpr int NCV = NEXP * 2 * 128, NCV1 = 5632;
    u16* T = (u16*)smem;
    const int tr = threadIdx.x >> 4, tc4 = (threadIdx.x & 15) * 4;
    auto cload = [&](int u, float4 (&v)[4]) {
      const int tile = u & 127, mat = (u >> 7) & 1, e = u >> 8;
      const float* W = (mat ? p.w_up : p.w_gate) + (size_t)e * DM * DEXP + (size_t)((tile & 15) * 64) * DEXP + (tile >> 4) * 64;
#pragma unroll
      for (int i = 0; i < 4; i++) v[i] = *(const float4*)&W[(size_t)(tr + 16 * i) * DEXP + tc4];
    };
    auto cproc = [&](int u, float4 (&v)[4]) {
      const int tile = u & 127, mat = (u >> 7) & 1, e = u >> 8;
      u16* WT = (mat ? p.WuT : p.WgT) + (size_t)e * DEXP * DM;
      const int k0 = (tile & 15) * 64, n0 = (tile >> 4) * 64;
      __syncthreads();
#pragma unroll
      for (int i = 0; i < 4; i++) {
        const int k = tr + 16 * i;
        T[(tc4 + 0) * 72 + k] = f2bf(v[i].x); T[(tc4 + 1) * 72 + k] = f2bf(v[i].y);
        T[(tc4 + 2) * 72 + k] = f2bf(v[i].z); T[(tc4 + 3) * 72 + k] = f2bf(v[i].w);
      }
      __syncthreads();
      const int n = threadIdx.x >> 2, seg = (threadIdx.x & 3) * 16;
      const u32x4 a = *(const u32x4*)&T[n * 72 + seg], b = *(const u32x4*)&T[n * 72 + seg + 8];
      *(u32x4*)&WT[(size_t)(n0 + n) * DM + k0 + seg] = a;
      *(u32x4*)&WT[(size_t)(n0 + n) * DM + k0 + seg + 8] = b;
    };
    auto conv_range = [&](int u, int uend) -> int {
      float4 va[4], vb[4];
      if (u < uend) cload(u, va);
      while (u < uend) {
        if (u + nb < uend) cload(u + nb, vb);
        cproc(u, va);
        u += nb;
        if (u >= uend) break;
        if (u + nb < uend) cload(u + nb, va);
        cproc(u, vb);
        u += nb;
      }
      return u;
    };
    for (int i = fidx; i < 64 * 64; i += nb) {
      const int uu = i & 63, n = 64 + (i >> 6);
      __syncthreads();
      if (uu < 32) recur_unit<128, true, 1>(p, smem, uu >> 2, uu & 3, p.IMGH + (size_t)uu * 128 * IMGH_SZ, n, 128, n + 1);
      else recur_unit<64, false, 1>(p, smem, (uu - 32) >> 2, uu & 3, p.IMGG + (size_t)(uu - 32) * 128 * IMGG_SZ, n, 128, n + 1);
    }
    int u = conv_range(fidx, NCV1);
    mid_barrier(p, smem);
    phaseC(p, smem, 0);
    conv_range(u, NCV);
    return;
  }
  for (int u = blockIdx.x; u < 64; u += gridDim.x) {
    __syncthreads();
    if (u < 32) recur_unit<128, true, 2>(p, smem, u >> 2, u & 3, p.IMGH + (size_t)u * 128 * IMGH_SZ, 0, 1, SEQ / 16);
    else recur_unit<64, false, 2>(p, smem, (u - 32) >> 2, u & 3, p.IMGG + (size_t)(u - 32) * 128 * IMGG_SZ, 0, 1, SEQ / 16);
  }
}

__device__ void phaseC(const Params& p, char* smem, int which) {
  for (int half = 0; half <= which; half++)
  xcd_queue_run(p.bar + QW_BASE + 512 + 32 * half, half ? 72 : 56, smem + 2 * GEMM_SMEM + 800, [&](int j, int q) {
    const int mt = half ? ((q / 9) * 16 + 7 + q % 9) : ((q / 7) * 16 + q % 7), nt = j;
    const int m0 = mt * 128, n0 = nt * 128;
    auto rowf = [&](int r) { return (const void*)(p.O + (size_t)(m0 + r) * DM); };
    auto colf = [&](int c) { return (const void*)(p.WoutT + (size_t)(n0 + c) * DM); };
    auto epi = [&](f32x4 (&acc)[4][4], int mb, int nb) {
#pragma unroll
      for (int mi = 0; mi < 4; mi++)
#pragma unroll
        for (int ni = 0; ni < 4; ni++) {
          const int m = m0 + mb + mi * 16;
          const size_t idx = (size_t)m * DM + n0 + nb + ni * 16;
          float4 xv = *(const float4*)&p.x[idx];
          f32x4 v = acc[mi][ni];
          float* zp = (half == 0) ? (p.LF + ((size_t)((m >> 11) * 1024 + (m & 1023))) * DM + n0 + nb + ni * 16) : (p.Z + idx);
          *(float4*)zp = make_float4(ALPHA * xv.x + v[0], ALPHA * xv.y + v[1], ALPHA * xv.z + v[2], ALPHA * xv.w + v[3]);
        }
    };
    gemm_tile<true, true>(smem, DM, rowf, colf, DM, epi);
  });
}

__device__ __forceinline__ float wave_sum(float v) {
  v = dpp_row_sum(v);
  const int vi = __float_as_int(v);
  return (__int_as_float(__builtin_amdgcn_readlane(vi, 0)) + __int_as_float(__builtin_amdgcn_readlane(vi, 16))) +
         (__int_as_float(__builtin_amdgcn_readlane(vi, 32)) + __int_as_float(__builtin_amdgcn_readlane(vi, 48)));
}

__device__ __forceinline__ void ln_row(const float* zin, const float* g, const float* bb, int lane, float4 (&o)[4]) {
  float4 v[4];
  float s = 0.f;
#pragma unroll
  for (int i = 0; i < 4; i++) { v[i] = *(const float4*)&zin[lane * 4 + 256 * i]; s += v[i].x + v[i].y + v[i].z + v[i].w; }
  const float mu = wave_sum(s) * (1.f / 1024.f);
  float q = 0.f;
#pragma unroll
  for (int i = 0; i < 4; i++) {
    v[i].x -= mu; v[i].y -= mu; v[i].z -= mu; v[i].w -= mu;
    q += v[i].x * v[i].x + v[i].y * v[i].y + v[i].z * v[i].z + v[i].w * v[i].w;
  }
  const float rstd = rsqrtf(wave_sum(q) * (1.f / 1024.f) + LN_EPS);
#pragma unroll
  for (int i = 0; i < 4; i++) {
    float4 gg = *(const float4*)&g[lane * 4 + 256 * i], b4 = *(const float4*)&bb[lane * 4 + 256 * i];
    o[i] = make_float4(v[i].x * rstd * gg.x + b4.x, v[i].y * rstd * gg.y + b4.y, v[i].z * rstd * gg.z + b4.z, v[i].w * rstd * gg.w + b4.w);
  }
}

__device__ void phaseD(const Params& p, char* smem) {
  float* part = (float*)smem;
  float* logits = part + 4 * 16 * 80;
  const int tid = threadIdx.x, lane = tid & 63, w = tid >> 6, l15 = lane & 15, kg = lane >> 4;
  for (int g = blockIdx.x; g < NTOK / 16; g += gridDim.x) {
    const int row0 = g * 16;
    {
      float4 v[4][4];
#pragma unroll
      for (int i = 0; i < 4; i++)
#pragma unroll
        for (int j = 0; j < 4; j++) {
          const int row = row0 + w * 4 + i;
          const float* zr = ((row & 2047) >= 896) ? (p.Z + (size_t)row * DM) : (p.LF + ((size_t)((row >> 11) * 1024 + (row & 1023))) * DM);
          v[i][j] = *(const float4*)&zr[lane * 4 + 256 * j];
        }
#pragma unroll
      for (int i = 0; i < 4; i++) {
        const int row = row0 + w * 4 + i;
        float s = 0.f;
#pragma unroll
        for (int j = 0; j < 4; j++) s += v[i][j].x + v[i][j].y + v[i][j].z + v[i][j].w;
        const float mu = wave_sum(s) * (1.f / 1024.f);
        float q = 0.f;
#pragma unroll
        for (int j = 0; j < 4; j++) {
          v[i][j].x -= mu; v[i][j].y -= mu; v[i][j].z -= mu; v[i][j].w -= mu;
          q += v[i][j].x * v[i][j].x + v[i][j].y * v[i][j].y + v[i][j].z * v[i][j].z + v[i][j].w * v[i][j].w;
        }
        const float rstd = rsqrtf(wave_sum(q) * (1.f / 1024.f) + LN_EPS);
#pragma unroll
        for (int j = 0; j < 4; j++) {
          const float4 gg = *(const float4*)&p.ln1_g[lane * 4 + 256 * j], b4 = *(const float4*)&p.ln1_b[lane * 4 + 256 * j];
          const float4 o = make_float4(v[i][j].x * rstd * gg.x + b4.x, v[i][j].y * rstd * gg.y + b4.y, v[i][j].z * rstd * gg.z + b4.z, v[i][j].w * rstd * gg.w + b4.w);
          *(float4*)&p.X1[(size_t)row * DM + lane * 4 + 256 * j] = o;
          uint2 h; h.x = pack2(o.x, o.y); h.y = pack2(o.z, o.w);
          *(uint2*)&p.X1B[(size_t)row * DM + lane * 4 + 256 * j] = h;
        }
      }
    }
    asm volatile("s_waitcnt vmcnt(0)" ::: "memory");
    __syncthreads();
    f32x4 acc[5];
#pragma unroll
    for (int i = 0; i < 5; i++) acc[i] = f32x4{0, 0, 0, 0};
    const float* xrow = p.X1 + (size_t)(row0 + l15) * DM + 256 * w + 4 * kg;
    struct RB { float4 a; float we[4][4]; float wg[4]; };
    auto rload = [&](int it, RB& r) {
      r.a = *(const float4*)&xrow[16 * it];
      const int kb = 256 * w + 16 * it + 4 * kg;
#pragma unroll
      for (int i = 0; i < 4; i++) {
        const float* we = p.w_er + (size_t)(kb + i) * 64 + l15;
#pragma unroll
        for (int nt = 0; nt < 4; nt++) r.we[i][nt] = we[16 * nt];
        r.wg[i] = (l15 < 8) ? p.w_gr[(size_t)(kb + i) * 8 + l15] : 0.f;
      }
    };
    auto rcomp = [&](const RB& r) {
      const float av[4] = {r.a.x, r.a.y, r.a.z, r.a.w};
#pragma unroll
      for (int i = 0; i < 4; i++) {
#pragma unroll
        for (int nt = 0; nt < 4; nt++) acc[nt] = __builtin_amdgcn_mfma_f32_16x16x4f32(av[i], r.we[i][nt], acc[nt], 0, 0, 0);
        acc[4] = __builtin_amdgcn_mfma_f32_16x16x4f32(av[i], r.wg[i], acc[4], 0, 0, 0);
      }
    };
    {
      RB r0, r1;
      rload(0, r0);
      for (int it = 0; it < 16; it += 2) {
        rload(it + 1, r1);
        rcomp(r0);
        if (it + 2 < 16) rload(it + 2, r0);
        rcomp(r1);
      }
    }
#pragma unroll
    for (int nt = 0; nt < 5; nt++)
#pragma unroll
      for (int r = 0; r < 4; r++) part[(w * 16 + kg * 4 + r) * 80 + nt * 16 + l15] = acc[nt][r];
    __syncthreads();
    for (int idx = tid; idx < 16 * 72; idx += 256) {
      const int r = idx / 72, c = idx % 72;
      logits[r * 72 + c] = part[(0 * 16 + r) * 80 + c] + part[(1 * 16 + r) * 80 + c] + part[(2 * 16 + r) * 80 + c] + part[(3 * 16 + r) * 80 + c];
    }
    __syncthreads();
    if (tid < 16) {
      const float* L = logits + tid * 72;
      const int tok = row0 + tid;
      float gm = L[64]; int gi = 0;
      for (int i = 1; i < 8; i++) if (L[64 + i] > gm) { gm = L[64 + i]; gi = i; }
      float gs = 0.f;
      for (int i = 0; i < 8; i++) gs += expf(L[64 + i] - gm);
      const float pg = 1.f / gs;
      const float* E = L + gi * 8;
      float em = E[0]; int i1 = 0;
      for (int i = 1; i < 8; i++) if (E[i] > em) { em = E[i]; i1 = i; }
      float e2 = -3.0e38f; int i2 = 0;
      for (int i = 0; i < 8; i++) if (i != i1 && E[i] > e2) { e2 = E[i]; i2 = i; }
      const float p1 = 1.f, p2 = expf(e2 - em);
      const float gt1 = pg * p1 / (p1 + p2), gt2 = pg * p2 / (p1 + p2);
      const int ex1 = gi * 8 + i1, ex2 = gi * 8 + i2;
      const int pos1 = atomicAdd(&p.cnt[ex1], 1);
      const int pos2 = atomicAdd(&p.cnt[ex2], 1);
      p.list_tok[ex1 * CAP + pos1] = tok; p.list_gate[ex1 * CAP + pos1] = gt1;
      p.list_tok[ex2 * CAP + pos2] = tok; p.list_gate[ex2 * CAP + pos2] = gt2;
      p.tok_e[tok * 2] = ex1; p.tok_e[tok * 2 + 1] = ex2;
      p.tok_pos[tok * 2] = pos1; p.tok_pos[tok * 2 + 1] = pos2;
    }
    __syncthreads();
  }
}

__device__ __forceinline__ void moe_prefix(const Params& p, int* s_off, int* s_rb) {
  __syncthreads();
  if (threadIdx.x == 0) {
    int o = 0, r = 0;
    for (int e = 0; e < NEXP; e++) {
      s_off[e] = o; s_rb[e] = r;
      int c = p.cnt[e];
      o += c; r += (c + 127) >> 7;
    }
    s_off[NEXP] = o; s_rb[NEXP] = r;
  }
  __syncthreads();
}

__device__ void phaseE1(const Params& p, char* smem) {
  int* s_off = (int*)(smem + 2 * GEMM_SMEM);
  int* s_rb = s_off + 72;
  moe_prefix(p, s_off, s_rb);
  xcd_queue_run(p.bar + QW_BASE + 1024, s_rb[NEXP], smem + 2 * GEMM_SMEM + 800, [&](int j, int q) {
    const int rbg = q, jt = j;
    int e = 0;
    while (s_rb[e + 1] <= rbg) e++;
    const int rb = rbg - s_rb[e];
    const int cnt = p.cnt[e];
    const int rows = min(128, cnt - rb * 128);
    const int* lt = p.list_tok + e * CAP + rb * 128;
    const int slot0 = s_off[e] + rb * 128;
    const int j0 = jt * 64;
    const u16* wg = p.WgT + (size_t)e * DEXP * DM;
    const u16* wu = p.WuT + (size_t)e * DEXP * DM;
    auto rowf = [&](int r) { int rr = r < rows ? r : 0; return (const void*)(p.X1B + (size_t)lt[rr] * DM); };
    auto colf = [&](int c) { return (const void*)(((c & 32) ? wu : wg) + (size_t)(j0 + (c >> 6) * 32 + (c & 31)) * DM); };
    auto epi = [&](f32x4 (&acc)[4][4], int mb, int nb) {
      const int wn = nb >> 6, kg4 = nb & 63;
#pragma unroll
      for (int mi = 0; mi < 4; mi++) {
        const int r = mb + mi * 16;
        if (r < rows) {
#pragma unroll
          for (int ni = 0; ni < 2; ni++) {
            f32x4 gv = acc[mi][ni], uv = acc[mi][ni + 2];
            uint2 o;
            o.x = pack2(siluf(gv[0]) * uv[0], siluf(gv[1]) * uv[1]);
            o.y = pack2(siluf(gv[2]) * uv[2], siluf(gv[3]) * uv[3]);
            *(uint2*)&p.H[(size_t)(slot0 + r) * DEXP + j0 + wn * 32 + ni * 16 + kg4] = o;
          }
        }
      }
    };
    gemm_tile<true, true>(smem, DM, rowf, colf, DEXP, epi);
  });
}

__device__ void phaseE2(const Params& p, char* smem) {
  int* s_off = (int*)(smem + 2 * GEMM_SMEM);
  int* s_rb = s_off + 72;
  moe_prefix(p, s_off, s_rb);
  xcd_queue_run(p.bar + QW_BASE + 1536, s_rb[NEXP], smem + 2 * GEMM_SMEM + 800, [&](int j, int q) {
    const int rbg = q, nt = j;
    int e = 0;
    while (s_rb[e + 1] <= rbg) e++;
    const int rb = rbg - s_rb[e];
    const int cnt = p.cnt[e];
    const int rows = min(128, cnt - rb * 128);
    const int slot0 = s_off[e] + rb * 128;
    const int n0 = nt * 128;
    const float* wd = p.w_down + (size_t)e * DEXP * DM;
    const float* lg = p.list_gate + e * CAP + rb * 128;
    auto rowf = [&](int r) { int rr = r < rows ? r : 0; return (const void*)(p.H + (size_t)(slot0 + rr) * DEXP); };
    auto colf = [&](int c) { return (const void*)(wd + n0 + c); };
    auto epi = [&](f32x4 (&acc)[4][4], int mb, int nb) {
#pragma unroll
      for (int mi = 0; mi < 4; mi++) {
        const int r = mb + mi * 16;
        if (r < rows) {
          const float gt = lg[r];
#pragma unroll
          for (int ni = 0; ni < 4; ni++) {
            f32x4 v = acc[mi][ni];
            uint2 o; o.x = pack2(gt * v[0], gt * v[1]); o.y = pack2(gt * v[2], gt * v[3]);
            *(uint2*)&p.Y[(size_t)(slot0 + r) * DM + n0 + nb + ni * 16] = o;
          }
        }
      }
    };
    gemm_tile<true, false>(smem, DEXP, rowf, colf, DM, epi);
  });
}

__device__ void phaseF(const Params& p, char* smem) {
  int* s_off = (int*)(smem + 2 * GEMM_SMEM);
  int* s_rb = s_off + 72;
  moe_prefix(p, s_off, s_rb);
  const int tid = threadIdx.x, lane = tid & 63, w = tid >> 6;
  for (int rp = blockIdx.x * 4 + w; rp < NTOK / 2; rp += gridDim.x * 4) {
    int sl[2][2];
#pragma unroll
    for (int h = 0; h < 2; h++) {
      const int row = rp * 2 + h;
      const int2 te = *(const int2*)&p.tok_e[row * 2], tp = *(const int2*)&p.tok_pos[row * 2];
      sl[h][0] = s_off[te.x] + tp.x;
      sl[h][1] = s_off[te.y] + tp.y;
    }
    float4 v[2][4];
#pragma unroll
    for (int h = 0; h < 2; h++) {
      const int row = rp * 2 + h;
#pragma unroll
      for (int i = 0; i < 4; i++) {
        const int c = lane * 4 + 256 * i;
        const float4 xv = *(const float4*)&p.X1[(size_t)row * DM + c];
        const uint2 ya = *(const uint2*)&p.Y[(size_t)sl[h][0] * DM + c];
        const uint2 yb = *(const uint2*)&p.Y[(size_t)sl[h][1] * DM + c];
        v[h][i].x = ALPHA * xv.x + (bflo(ya.x) + bflo(yb.x));
        v[h][i].y = ALPHA * xv.y + (bfhi(ya.x) + bfhi(yb.x));
        v[h][i].z = ALPHA * xv.z + (bflo(ya.y) + bflo(yb.y));
        v[h][i].w = ALPHA * xv.w + (bfhi(ya.y) + bfhi(yb.y));
      }
    }
#pragma unroll
    for (int h = 0; h < 2; h++) {
      const int row = rp * 2 + h;
      float s = 0.f;
#pragma unroll
      for (int i = 0; i < 4; i++) s += v[h][i].x + v[h][i].y + v[h][i].z + v[h][i].w;
      const float mu = wave_sum(s) * (1.f / 1024.f);
      float q = 0.f;
#pragma unroll
      for (int i = 0; i < 4; i++) {
        v[h][i].x -= mu; v[h][i].y -= mu; v[h][i].z -= mu; v[h][i].w -= mu;
        q += v[h][i].x * v[h][i].x + v[h][i].y * v[h][i].y + v[h][i].z * v[h][i].z + v[h][i].w * v[h][i].w;
      }
      const float rstd = rsqrtf(wave_sum(q) * (1.f / 1024.f) + LN_EPS);
#pragma unroll
      for (int i = 0; i < 4; i++) {
        const int c = lane * 4 + 256 * i;
        const float4 gg = *(const float4*)&p.ln2_g[c], b4 = *(const float4*)&p.ln2_b[c];
        *(float4*)&p.out[(size_t)row * DM + c] =
            make_float4(v[h][i].x * rstd * gg.x + b4.x, v[h][i].y * rstd * gg.y + b4.y, v[h][i].z * rstd * gg.z + b4.z, v[h][i].w * rstd * gg.w + b4.w);
      }
    }
  }
}


#define XB_TMO      128
#define XB_XCNT(j)  (256  + 64 * (j))
#define XB_XSUB(j)  (1280 + 64 * (j))
#define XB_XGEN(j)  (2304 + 64 * (j))
#define XB_TOP      3328
#define XB_TOPGEN   3392
#define XCD_BAR_WORDS 3456
#define XB_SPIN_CAP (1u << 18)
#define LAS __attribute__((address_space(3)))
__device__ __forceinline__ unsigned xb_ld(unsigned* p)              { return __hip_atomic_load(p, __ATOMIC_RELAXED, __HIP_MEMORY_SCOPE_AGENT); }
__device__ __forceinline__ unsigned xb_add(unsigned* p, unsigned v) { return __hip_atomic_fetch_add(p, v, __ATOMIC_RELAXED, __HIP_MEMORY_SCOPE_AGENT); }
__device__ __forceinline__ unsigned xb_xcc_id() { return (unsigned)__builtin_amdgcn_s_getreg((3 << 11) | 20) & 0xFu; }
#define XB_SPIN(cond, bar) do { unsigned _sp = 0; while (cond) { __builtin_amdgcn_s_sleep(1); \
    if ((++_sp & 255u) == 0u) { if (xb_ld(&(bar)[XB_TMO])) break; if (_sp > XB_SPIN_CAP) { atomicAdd(&(bar)[XB_TMO], 1u); break; } } } } while (0)
struct XcdBarrier { unsigned* bar; unsigned x; volatile LAS unsigned* st; };
__device__ __forceinline__ XcdBarrier xcd_barrier_post(unsigned* bar, volatile LAS unsigned* st) {
  XcdBarrier b; b.bar = bar; b.x = xb_xcc_id(); b.st = st;
  if (threadIdx.x == 0) (void)xb_add(&bar[XB_XCNT(b.x)], 1u);
  return b;
}
__device__ __forceinline__ void xcd_barrier_complete(unsigned* bar, unsigned x, unsigned& nloc, unsigned& nx) {
  const unsigned G = gridDim.x * gridDim.y * gridDim.z;
  unsigned sum, cnt, mine, sp = 0u;
  for (;;) {
    sum = 0u; cnt = 0u; mine = 0u;
#pragma unroll
    for (unsigned j = 0; j < 16; ++j) { const unsigned c = xb_ld(&bar[XB_XCNT(j)]); sum += c; cnt += (c > 0u) ? 1u : 0u; mine = (j == x) ? c : mine; }
    if (sum == G) break;
    __builtin_amdgcn_s_sleep(1);
    if ((++sp & 255u) == 0u) { if (xb_ld(&bar[XB_TMO])) break; if (sp > XB_SPIN_CAP) { atomicAdd(&bar[XB_TMO], 1u); break; } }
  }
  nloc = mine > 0u ? mine : 1u; nx = cnt > 0u ? cnt : 1u;
}
__device__ __forceinline__ void xcd_barrier(const XcdBarrier& b) {
  asm volatile("s_waitcnt vmcnt(0)" ::: "memory");
  __syncthreads();
  if (threadIdx.x == 0) {
    unsigned* bar = b.bar;
    __builtin_amdgcn_s_waitcnt(0);
    unsigned nloc = b.st[0], nx = b.st[1];
    if (nloc == 0u) { xcd_barrier_complete(bar, b.x, nloc, nx); b.st[0] = nloc; b.st[1] = nx; }
    const unsigned old = xb_add(&bar[XB_XSUB(b.x)], 1u);
    const unsigned gen = old / nloc;
    if (old + 1u == (gen + 1u) * nloc) {
      __builtin_amdgcn_fence(__ATOMIC_RELEASE, "agent");
      asm volatile("s_waitcnt vmcnt(0)" ::: "memory");
      const unsigned og = xb_add(&bar[XB_TOP], 1u);
      const unsigned tg = og / nx;
      if (og + 1u == (tg + 1u) * nx) xb_add(&bar[XB_TOPGEN], 1u);
      else XB_SPIN(xb_ld(&bar[XB_TOPGEN]) == tg, bar);
      __builtin_amdgcn_fence(__ATOMIC_ACQUIRE, "agent");
      xb_add(&bar[XB_XGEN(b.x)], 1u);
      asm volatile("s_waitcnt vmcnt(0)" ::: "memory");
    } else {
      XB_SPIN(xb_ld(&bar[XB_XGEN(b.x)]) == gen, bar);
      __builtin_amdgcn_fence(__ATOMIC_ACQUIRE, "agent");
      asm volatile("s_waitcnt vmcnt(0)" ::: "memory");
    }
  }
  __syncthreads();
}

__device__ void mid_barrier(const Params& p, char* smem) {
  XcdBarrier b; b.bar = p.bar; b.x = xb_xcc_id(); b.st = (volatile LAS unsigned*)(smem + 2 * GEMM_SMEM + 768);
  xcd_barrier(b);
}
constexpr int AUX_OFF = 2 * GEMM_SMEM;
constexpr int SMEM_BYTES = AUX_OFF + 1024;

#if SINGLE
__global__ void __launch_bounds__(256, 2) fwd_megakernel(Params p) {
  extern __shared__ __attribute__((aligned(16))) char smem[];
  cg::grid_group grid = cg::this_grid();
  volatile LAS unsigned* st = (volatile LAS unsigned*)(smem + AUX_OFF + 768);
  if (threadIdx.x < 2) st[threadIdx.x] = 0u;
  __syncthreads();
  XcdBarrier xb = xcd_barrier_post(p.bar, st);
  if (p.use_cg) grid.sync();
  phaseP0(p, smem);
  xcd_barrier(xb);
  phaseA(p, smem);
  xcd_barrier(xb);
  phaseB0(p, smem);
  xcd_barrier(xb);
  phaseB(p, smem);
  xcd_barrier(xb);
  phaseC(p, smem, 1);
  xcd_barrier(xb);
  phaseD(p, smem);
  xcd_barrier(xb);
  phaseE1(p, smem);
  xcd_barrier(xb);
  phaseE2(p, smem);
  xcd_barrier(xb);
  phaseF(p, smem);
}
#else
#define PHASE_KERNEL(NAME, FN)                                             \
  __global__ void __launch_bounds__(256, 2) NAME(Params p) {                  \
    __shared__ __attribute__((aligned(16))) char smem[SMEM_BYTES];         \
    FN(p, smem);                                                           \
  }
PHASE_KERNEL(kA, phaseA)
PHASE_KERNEL(kB, phaseB)
PHASE_KERNEL(kC, phaseC)
PHASE_KERNEL(kD, phaseD)
PHASE_KERNEL(kE1, phaseE1)
PHASE_KERNEL(kE2, phaseE2)
PHASE_KERNEL(kF, phaseF)
#endif

extern "C" void kernel_launch(void* const* d_in, const int* in_sizes, int n_in, void* d_out, int out_size,
                              void* d_ws, size_t ws_size, hipStream_t stream) {
  Params p{};
  p.x = (const float*)d_in[0];
  p.w_in = (const float*)d_in[1];
  p.w_a2 = (const float*)d_in[2];
  p.b_a = (const float*)d_in[3];
  p.lb = (const float*)d_in[4];
  p.norm_h = (const float*)d_in[5];
  p.norm_g = (const float*)d_in[6];
  p.w_out = (const float*)d_in[7];
  p.ln1_g = (const float*)d_in[8];
  p.ln1_b = (const float*)d_in[9];
  p.w_gr = (const float*)d_in[10];
  p.w_er = (const float*)d_in[11];
  p.w_gate = (const float*)d_in[12];
  p.w_up = (const float*)d_in[13];
  p.w_down = (const float*)d_in[14];
  p.ln2_g = (const float*)d_in[15];
  p.ln2_b = (const float*)d_in[16];
  p.out = (float*)d_out;
  char* ws = (char*)d_ws;
  size_t off = 0;
  auto take = [&](size_t bytes) { char* r = ws + off; off += (bytes + 255) & ~(size_t)255; return r; };
  p.P = (u16*)take((size_t)NTOK * INC * 2);
  p.LF = (float*)take((size_t)NTOK * 512 * 4);
  p.GA = (float*)take((size_t)NTOK * 16 * 4);
  p.Z = (float*)take((size_t)NTOK * DM * 4);
  p.O = (u16*)take((size_t)NTOK * DM * 2);
  p.X1 = (float*)take((size_t)NTOK * DM * 4);
  p.X1B = (u16*)take((size_t)NTOK * DM * 2);
  p.cnt = (int*)take(256);
  p.tok_e = (int*)take((size_t)NTOK * 2 * 4);
  p.tok_pos = (int*)take((size_t)NTOK * 2 * 4);
  p.list_tok = (int*)take((size_t)NEXP * CAP * 4);
  p.list_gate = (float*)take((size_t)NEXP * CAP * 4);
  p.bar = (unsigned*)take((XCD_BAR_WORDS + 2048) * 4);
  p.XB = p.O;
  p.WgT = (u16*)take((size_t)NEXP * DEXP * DM * 2);
  p.WuT = (u16*)take((size_t)NEXP * DEXP * DM * 2);
  p.IMGH = (char*)p.X1;
  p.IMGG = (char*)p.Z;
  p.WinT = (u16*)take((size_t)INC * DM * 2);
  p.WoutT = (u16*)take((size_t)DM * DM * 2);
  p.use_cg = 0; p.pad_ = 0;
  p.H = p.P;
  p.Y = p.P + (size_t)32768 * DEXP;

#if SINGLE
  static int grid_blocks = 0;
  if (!grid_blocks) {
    int dev = 0, cus = 0, per_cu = 0;
    hipGetDevice(&dev);
    hipDeviceGetAttribute(&cus, hipDeviceAttributeMultiprocessorCount, dev);
    if (hipFuncSetAttribute((const void*)fwd_megakernel, hipFuncAttributeMaxDynamicSharedMemorySize, SMEM_BYTES) != hipSuccess)
      fprintf(stderr, "hipFuncSetAttribute failed\n");
    hipOccupancyMaxActiveBlocksPerMultiprocessor(&per_cu, fwd_megakernel, 256, SMEM_BYTES);
    if (per_cu > 2) per_cu = 2;
    grid_blocks = cus * per_cu;
  }
  hipMemsetAsync(p.bar, 0, (XCD_BAR_WORDS + 2048) * 4, stream);
  void* args[] = {&p};
  hipError_t e = hipLaunchCooperativeKernel((void*)fwd_megakernel, dim3(grid_blocks), dim3(256), args, SMEM_BYTES, stream);
  if (e != hipSuccess) fprintf(stderr, "cooperative launch failed: %s (grid %d)\n", hipGetErrorString(e), grid_blocks);
#else
  const int G = 512;
  kA<<<G, 256, 0, stream>>>(p);
  kB<<<64, 256, 0, stream>>>(p);
  kC<<<G, 256, 0, stream>>>(p);
  kD<<<G, 256, 0, stream>>>(p);
  kE1<<<G, 256, 0, stream>>>(p);
  kE2<<<G, 256, 0, stream>>>(p);
  kF<<<G, 256, 0, stream>>>(p);
#endif
}
```

```cpp
#include <hip/hip_runtime.h>
#include <hip/hip_cooperative_groups.h>
#include <cstdio>
namespace cg = cooperative_groups;

#ifndef SINGLE
#define SINGLE 1
#endif

typedef unsigned short u16;
typedef __attribute__((ext_vector_type(8))) short bf16x8;
typedef __attribute__((ext_vector_type(4))) short bf16x4;
typedef __attribute__((ext_vector_type(4))) float f32x4;
typedef __bf16 bf16x2_t __attribute__((ext_vector_type(2)));
typedef float f32x2_t __attribute__((ext_vector_type(2)));
typedef unsigned u32x4 __attribute__((ext_vector_type(4)));
typedef unsigned u32x2 __attribute__((ext_vector_type(2)));

constexpr int NTOK = 16384;
constexpr int SEQ = 2048;
constexpr int DM = 1024;
constexpr int INC = 3600;
constexpr int NEXP = 64;
constexpr int DEXP = 512;
constexpr int CAP = 32768;
constexpr float ALPHA = 1.189207115002721f;
constexpr float LN_EPS = 1e-5f;

struct Params {
  const float *x, *w_in, *w_a2, *b_a, *lb, *norm_h, *norm_g, *w_out, *ln1_g, *ln1_b, *w_gr, *w_er,
      *w_gate, *w_up, *w_down, *ln2_g, *ln2_b;
  float* out;
  u16* P;
  float* LF;
  float* GA;
  float* Z;
  u16* O;
  float* X1;
  u16* X1B;
  u16* H;
  u16* Y;
  int* cnt;
  int* tok_e;
  int* tok_pos;
  int* list_tok;
  float* list_gate;
  u16* XB;
  u16* WinT;
  u16* WoutT;
  u16* WgT;
  u16* WuT;
  char* IMGH;
  char* IMGG;
  unsigned* bar;
  int use_cg; int pad_;
};

__device__ __forceinline__ unsigned pack2(float a, float b) {
  f32x2_t f = {a, b};
  bf16x2_t h = __builtin_convertvector(f, bf16x2_t);
  return *(unsigned*)&h;
}
__device__ __forceinline__ u16 f2bf(float a) {
  __bf16 h = (__bf16)a;
  return *(u16*)&h;
}
__device__ __forceinline__ float bf2f(u16 v) { return __uint_as_float(((unsigned)v) << 16); }
__device__ __forceinline__ float bflo(unsigned v) { return __uint_as_float(v << 16); }
__device__ __forceinline__ float bfhi(unsigned v) { return __uint_as_float(v & 0xffff0000u); }
__device__ __forceinline__ float sigmoidf(float x) { return 1.f / (1.f + __expf(-x)); }
__device__ __forceinline__ float siluf(float x) { return x / (1.f + __expf(-x)); }


constexpr int QW_BASE = 3456;
__device__ __forceinline__ unsigned my_xcc_id() { return (unsigned)__builtin_amdgcn_s_getreg((3 << 11) | 20) & 7u; }
template <class F>
__device__ __forceinline__ void xcd_queue_run(unsigned* qwords, int nper, char* smem_aux, F fn) {
  volatile int* slot = (volatile int*)smem_aux;
  const unsigned x = my_xcc_id();
  for (int dj = 0; dj < 8; dj++) {
    const int j = (int)((x + dj) & 7u);
    for (;;) {
      __syncthreads();
      if (threadIdx.x == 0) *slot = (int)__hip_atomic_fetch_add(qwords + 64 * j, 1u, __ATOMIC_RELAXED, __HIP_MEMORY_SCOPE_AGENT);
      __syncthreads();
      const int q = *slot;
      if (q >= nper) break;
      fn(j, q);
    }
  }
}

constexpr int BM = 128, BN = 128, BK = 64, LDT = 64;
constexpr int GEMM_SMEM = (BM + BN) * LDT * 2;

template <bool ABF, bool BBF, class RowF, class ColF, class Epi>
__device__ __forceinline__ void gemm_tile(char* smem, int K, RowF rowptr, ColF colptr, int ldb, Epi epi) {
  u16* As0 = (u16*)smem;
  const int tid = threadIdx.x, lane = tid & 63, w = tid >> 6, wm = w >> 1, wn = w & 1;
  const int l15 = lane & 15, kg = lane >> 4, swz = (l15 >> 1) & 7;
  f32x4 acc[4][4];
#pragma unroll
  for (int i = 0; i < 4; i++)
#pragma unroll
    for (int j = 0; j < 4; j++) acc[i][j] = f32x4{0.f, 0.f, 0.f, 0.f};

  constexpr int NA = ABF ? 4 : 8;
  const int ar0 = ABF ? (tid >> 3) : (tid >> 4);
  const int ac = ABF ? (tid & 7) * 8 : (tid & 15) * 4;
  constexpr int ARS = ABF ? 32 : 16;
  const char* ap[NA];
#pragma unroll
  for (int i = 0; i < NA; i++) ap[i] = (const char*)rowptr(ar0 + ARS * i) + ac * (ABF ? 2 : 4);
  const int bc = tid & 127, kh = tid >> 7;
  const float* bp = BBF ? nullptr : ((const float*)colptr(bc) + (size_t)(kh * 32) * ldb);
  const int br0 = tid >> 3, bcc = (tid & 7) * 8;
  const char* bq[4];
  if (BBF) {
#pragma unroll
    for (int i = 0; i < 4; i++) bq[i] = (const char*)colptr(br0 + 32 * i) + bcc * 2;
  }

  u32x4 ra[NA];
  float rb[BBF ? 1 : 32];
  u32x4 rbb[BBF ? 4 : 1];
  auto gload = [&](int k0) {
#pragma unroll
    for (int i = 0; i < NA; i++) ra[i] = *(const u32x4*)(ap[i] + (size_t)k0 * (ABF ? 2 : 4));
    if (BBF) {
#pragma unroll
      for (int i = 0; i < 4; i++) rbb[BBF ? i : 0] = *(const u32x4*)(bq[i] + (size_t)k0 * 2);
    } else {
      const float* b = bp + (size_t)k0 * ldb;
#pragma unroll
      for (int j = 0; j < 32; j++) rb[BBF ? 0 : j] = b[(size_t)j * ldb];
    }
  };
  auto sstore = [&](int buf) {
    u16* As = As0 + buf * (GEMM_SMEM / 2);
    u16* Bs = As + BM * LDT;
#pragma unroll
    for (int i = 0; i < NA; i++) {
      if (ABF) {
        { const int row = ar0 + ARS * i; *(u32x4*)&As[row * LDT + (((ac >> 3) ^ ((row >> 1) & 7)) << 3)] = ra[i]; }
      } else {
        u32x2 v;
        v[0] = pack2(__uint_as_float(ra[i][0]), __uint_as_float(ra[i][1]));
        v[1] = pack2(__uint_as_float(ra[i][2]), __uint_as_float(ra[i][3]));
        { const int row = ar0 + ARS * i; *(u32x2*)&As[row * LDT + (((ac >> 3) ^ ((row >> 1) & 7)) << 3) + (ac & 4)] = v; }
      }
    }
    if (BBF) {
#pragma unroll
      for (int i = 0; i < 4; i++) { const int row = br0 + 32 * i; *(u32x4*)&Bs[row * LDT + (((bcc >> 3) ^ ((row >> 1) & 7)) << 3)] = rbb[BBF ? i : 0]; }
    } else {
#pragma unroll
      for (int j = 0; j < 4; j++) {
        u32x4 v;
        v[0] = pack2(rb[BBF ? 0 : 8 * j + 0], rb[BBF ? 0 : 8 * j + 1]);
        v[1] = pack2(rb[BBF ? 0 : 8 * j + 2], rb[BBF ? 0 : 8 * j + 3]);
        v[2] = pack2(rb[BBF ? 0 : 8 * j + 4], rb[BBF ? 0 : 8 * j + 5]);
        v[3] = pack2(rb[BBF ? 0 : 8 * j + 6], rb[BBF ? 0 : 8 * j + 7]);
        *(u32x4*)&Bs[bc * LDT + (((kh * 4 + j) ^ ((bc >> 1) & 7)) << 3)] = v;
      }
    }
  };

  gload(0);
  sstore(0);
  __syncthreads();
  int cur = 0;
  for (int k0 = 0; k0 < K; k0 += BK) {
    if (k0 + BK < K) gload(k0 + BK);
    const u16* As = As0 + cur * (GEMM_SMEM / 2);
    const u16* Bs = As + BM * LDT;
    {
      bf16x8 af[2][4], bfr[2][4];
#pragma unroll
      for (int ks = 0; ks < 2; ks++) {
#pragma unroll
        for (int mi = 0; mi < 4; mi++) af[ks][mi] = *(const bf16x8*)&As[(wm * 64 + mi * 16 + l15) * LDT + (((ks * 4 + kg) ^ swz) << 3)];
#pragma unroll
        for (int ni = 0; ni < 4; ni++) bfr[ks][ni] = *(const bf16x8*)&Bs[(wn * 64 + ni * 16 + l15) * LDT + (((ks * 4 + kg) ^ swz) << 3)];
      }
      __builtin_amdgcn_sched_barrier(0);
#pragma unroll
      for (int ks = 0; ks < 2; ks++)
#pragma unroll
        for (int mi = 0; mi < 4; mi++)
#pragma unroll
          for (int ni = 0; ni < 4; ni++)
            acc[mi][ni] = __builtin_amdgcn_mfma_f32_16x16x32_bf16(bfr[ks][ni], af[ks][mi], acc[mi][ni], 0, 0, 0);
      __builtin_amdgcn_sched_barrier(0);
    }
    if (k0 + BK < K) sstore(cur ^ 1);
    __syncthreads();
    cur ^= 1;
  }
  epi(acc, wm * 64 + l15, wn * 64 + kg * 4);
}


__device__ void transpose_tile(const float* W, int ld, int N, int k0, int n0, u16* WT, int K, char* smem) {
  u16* T = (u16*)smem;
  const int tid = threadIdx.x;
  __syncthreads();
  {
    const int r = tid >> 4, c4 = (tid & 15) * 4;
#pragma unroll
    for (int i = 0; i < 4; i++) {
      const int k = r + 16 * i;
      float4 v = make_float4(0.f, 0.f, 0.f, 0.f);
      if (n0 + c4 < N) v = *(const float4*)&W[(size_t)(k0 + k) * ld + n0 + c4];
      T[(c4 + 0) * 72 + k] = f2bf(v.x); T[(c4 + 1) * 72 + k] = f2bf(v.y);
      T[(c4 + 2) * 72 + k] = f2bf(v.z); T[(c4 + 3) * 72 + k] = f2bf(v.w);
    }
  }
  __syncthreads();
  {
    const int n = tid >> 2, seg = (tid & 3) * 16;
    if (n0 + n < N) {
      u32x4 a = *(const u32x4*)&T[n * 72 + seg], b = *(const u32x4*)&T[n * 72 + seg + 8];
      *(u32x4*)&WT[(size_t)(n0 + n) * K + k0 + seg] = a;
      *(u32x4*)&WT[(size_t)(n0 + n) * K + k0 + seg + 8] = b;
    }
  }
}
__device__ void phaseP0(const Params& p, char* smem) {
  if (blockIdx.x == 0 && threadIdx.x < 64) p.cnt[threadIdx.x] = 0;
  constexpr int NTI = 57 * 16, NTO = 16 * 16;
  for (int u = blockIdx.x; u < NTI + NTO; u += gridDim.x) {
    if (u < NTI) transpose_tile(p.w_in, INC, INC, (u % 16) * 64, (u / 16) * 64, p.WinT, DM, smem);
    else { const int v = u - NTI; transpose_tile(p.w_out, DM, DM, (v % 16) * 64, (v / 16) * 64, p.WoutT, DM, smem); }
  }
  const size_t n4 = (size_t)NTOK * DM / 4;
  for (size_t i = blockIdx.x * (size_t)256 + threadIdx.x; i < n4; i += (size_t)gridDim.x * 256) {
    float4 v = ((const float4*)p.x)[i];
    uint2 o; o.x = pack2(v.x, v.y); o.y = pack2(v.z, v.w);
    ((uint2*)p.XB)[i] = o;
  }
}

__device__ void phaseA(const Params& p, char* smem) {
  xcd_queue_run(p.bar + QW_BASE, 464, smem + 2 * GEMM_SMEM + 800, [&](int j, int q) {
    const int pj = j >> 1, odd = j & 1;
    int mt, nt;
    if (q < 384) { mt = q / 3; nt = 7 * pj + odd * 4 + q % 3; }
    else if (q < 448) { mt = odd * 64 + (q - 384); nt = 7 * pj + 3; }
    else { mt = 16 * j + (q - 448); nt = 28; }
    const int m0 = mt * 128, n0 = nt * 128;
    const u16* xa = p.XB + (size_t)m0 * DM;
    auto rowf = [&](int r) { return (const void*)(xa + (size_t)r * DM); };
    auto colf = [&](int c) { int n = n0 + c; if (n > INC - 1) n = INC - 1; return (const void*)(p.WinT + (size_t)n * DM); };
    auto epi = [&](f32x4 (&acc)[4][4], int mb, int nb) {
#pragma unroll
      for (int mi = 0; mi < 4; mi++)
#pragma unroll
        for (int ni = 0; ni < 4; ni++) {
          const int m = m0 + mb + mi * 16, n = n0 + nb + ni * 16;
          f32x4 v = acc[mi][ni];
          if (n >= INC) continue;
          if (n >= 512 && n < 1024) {
            const int c = n - 512;
            float lf[4], kf[4];
#pragma unroll
            for (int r = 0; r < 4; r++) {
              float lbv = sigmoidf(p.lb[c + r] - p.lb[512 + c + r]);
              float sg = sigmoidf(v[r]);
              float f = lbv + (1.f - lbv) * sg;
              lf[r] = __logf(f);
              kf[r] = (1.f - lbv) * (1.f - sg);
            }
            *(float4*)&p.LF[(size_t)m * 512 + c] = make_float4(lf[0], lf[1], lf[2], lf[3]);
            uint2 o; o.x = pack2(kf[0], kf[1]); o.y = pack2(kf[2], kf[3]);
            *(uint2*)&p.P[(size_t)m * INC + n] = o;
          } else if (n >= 3072 && n < 3088) {
            *(float4*)&p.GA[(size_t)m * 16 + (n - 3072)] = make_float4(v[0], v[1], v[2], v[3]);
          } else {
            if (n < 512) { v *= 0.08838834764831845f; }
            else if ((n >= 1536 && n < 2048) || n >= 3088) {
#pragma unroll
              for (int r = 0; r < 4; r++) v[r] = siluf(v[r]);
            } else if (n >= 2048 && n < 2304) { v *= 0.125f; }
            uint2 o; o.x = pack2(v[0], v[1]); o.y = pack2(v[2], v[3]);
            *(uint2*)&p.P[(size_t)m * INC + n] = o;
          }
        }
    };
    gemm_tile<true, true>(smem, DM, rowf, colf, INC, epi);
  });
}

__device__ __forceinline__ float dpp_scan_add(float x) {
  int xi;
  xi = __builtin_amdgcn_update_dpp(0, __float_as_int(x), 0x111, 0xf, 0xf, true); x += __int_as_float(xi);
  xi = __builtin_amdgcn_update_dpp(0, __float_as_int(x), 0x112, 0xf, 0xf, true); x += __int_as_float(xi);
  xi = __builtin_amdgcn_update_dpp(0, __float_as_int(x), 0x114, 0xf, 0xf, true); x += __int_as_float(xi);
  xi = __builtin_amdgcn_update_dpp(0, __float_as_int(x), 0x118, 0xf, 0xf, true); x += __int_as_float(xi);
  return x;
}


__device__ __forceinline__ float dpp_row_bcast15(float x) {
  return __int_as_float(__builtin_amdgcn_update_dpp(0, __float_as_int(x), 0x15F, 0xf, 0xf, false));
}
__device__ __forceinline__ float dpp_row_sum(float x) {
  x += __int_as_float(__builtin_amdgcn_update_dpp(0, __float_as_int(x), 0x128, 0xf, 0xf, false));
  x += __int_as_float(__builtin_amdgcn_update_dpp(0, __float_as_int(x), 0x124, 0xf, 0xf, false));
  x += __int_as_float(__builtin_amdgcn_update_dpp(0, __float_as_int(x), 0x122, 0xf, 0xf, false));
  x += __int_as_float(__builtin_amdgcn_update_dpp(0, __float_as_int(x), 0x121, 0xf, 0xf, false));
  return x;
}

#define STAGE() do { } while (0)
__device__ void mid_barrier(const Params& p, char* smem);
__device__ void phaseC(const Params& p, char* smem, int which);
template <int DK, bool HG, int MODE>
__device__ void recur_unit(const Params& p, char* smem, int b, int h, char* img, int nstart, int nstep, int nend) {
  constexpr int IMG = (2 * 16 * (DK + 8) + DK * 20 + 128 * 20) * 2 + DK * 4;
  constexpr int NIM = (IMG + 4095) / 4096;
  constexpr int KPT = DK / 16;
  constexpr int NKS = DK / 32;
  constexpr int NKT = DK / 16;
  constexpr int LQ = DK + 8;
  u16* Qt = (u16*)smem;
  u16* Kt = Qt + 16 * LQ;
  u16* KhT = Kt + 16 * LQ;
  u16* VT = KhT + DK * 20;
  float* Gch = (float*)(VT + 128 * 20);
  float* SS = Gch + DK;
  float* Wa = SS + 64;
  u16* GT = (u16*)(smem + 20480);
  u16* OT = (u16*)(smem + 24832);

  const int tid = threadIdx.x, lane = tid & 63, w = tid >> 6, l15 = lane & 15, kg = lane >> 4;
  const int t = tid & 15, kgp = tid >> 4, k0 = kgp * KPT;
  const int qcol = HG ? (h * 128) : (2048 + h * 64);
  const int kcol = HG ? (512 + h * 128) : (2304 + h * 64);
  const int vcol = HG ? (1024 + h * 128) : (2560 + h * 128);
  const int gcol = HG ? (1536 + h * 128) : (3088 + h * 128);
  const int ocol = HG ? (h * 128) : (512 + h * 128);
  const float* gain = HG ? p.norm_h : p.norm_g;

  float ba[KPT];
  if (!HG && MODE == 1) {
    __syncthreads();
    for (int i = tid; i < 16 * 64; i += 256) Wa[i] = p.w_a2[(i >> 6) * 256 + h * 64 + (i & 63)];
#pragma unroll
    for (int i = 0; i < KPT; i++) ba[i] = p.b_a[h * 64 + k0 + i];
    __syncthreads();
  }
  const float g0 = gain[h * 128 + w * 32 + l15], g1 = gain[h * 128 + w * 32 + 16 + l15];

  f32x4 S[NKT][2];
#pragma unroll
  for (int i = 0; i < NKT; i++) { S[i][0] = f32x4{0, 0, 0, 0}; S[i][1] = f32x4{0, 0, 0, 0}; }

  float4 pl[4];
  uint4 pq, pk, pv;
  u16 psg[8];
  u32x4 imA[NIM], imB[NIM];
  u16 psgB[8];
  auto prefetch = [&](int n, u32x4 (&im)[NIM], u16 (&psg)[8]) {
    if (MODE == 2) {
      const char* src = img + (size_t)n * IMG;
#pragma unroll
      for (int i = 0; i < NIM; i++) if (tid * 16 + 4096 * i < IMG) im[i] = *(const u32x4*)(src + tid * 16 + 4096 * i);
      {
        const u32x4 g = *(const u32x4*)(p.P + ((size_t)b * SEQ + n * 16 + (tid >> 4)) * INC + gcol + (tid & 15) * 8);
        psg[0] = (u16)(g[0] & 0xffff); psg[1] = (u16)(g[0] >> 16); psg[2] = (u16)(g[1] & 0xffff); psg[3] = (u16)(g[1] >> 16);
        psg[4] = (u16)(g[2] & 0xffff); psg[5] = (u16)(g[2] >> 16); psg[6] = (u16)(g[3] & 0xffff); psg[7] = (u16)(g[3] >> 16);
      }
      return;
    }
    const size_t tok = (size_t)b * SEQ + n * 16 + t;
    const u16* prow = p.P + tok * INC;
    if (HG) {
      pl[0] = *(const float4*)&p.LF[tok * 512 + h * 128 + k0];
      pl[1] = *(const float4*)&p.LF[tok * 512 + h * 128 + k0 + 4];
      pq = *(const uint4*)&prow[qcol + k0];
      pk = *(const uint4*)&prow[kcol + k0];
    } else {
#pragma unroll
      for (int i = 0; i < 4; i++) pl[i] = *(const float4*)&p.GA[tok * 16 + 4 * i];
      uint2 a = *(const uint2*)&prow[qcol + k0];
      uint2 c = *(const uint2*)&prow[kcol + k0];
      pq.x = a.x; pq.y = a.y; pk.x = c.x; pk.y = c.y;
    }
    pv = *(const uint4*)&prow[vcol + kgp * 8];
  };

  constexpr int PFD = (MODE == 2) ? 2 : 1;
  auto step = [&](int n, u32x4 (&im)[NIM], u16 (&psg)[8]) {
    float sgate[8];
    if (MODE == 2) {
#pragma unroll
      for (int i = 0; i < NIM; i++) if (tid * 16 + 4096 * i < IMG) *(u32x4*)(smem + tid * 16 + 4096 * i) = im[i];
      {
        u32x4 g;
        g[0] = (unsigned)psg[0] | ((unsigned)psg[1] << 16); g[1] = (unsigned)psg[2] | ((unsigned)psg[3] << 16);
        g[2] = (unsigned)psg[4] | ((unsigned)psg[5] << 16); g[3] = (unsigned)psg[6] | ((unsigned)psg[7] << 16);
        *(u32x4*)&GT[(tid >> 4) * 136 + (tid & 15) * 8] = g;
      }
      __builtin_amdgcn_sched_barrier(0);
      if (n + PFD * nstep < nend) prefetch(n + PFD * nstep, im, psg);
      __builtin_amdgcn_sched_barrier(0);
    } else {
    float lg[KPT], qv[KPT], kv[KPT];
    if (HG) {
      lg[0] = pl[0].x; lg[1] = pl[0].y; lg[2] = pl[0].z; lg[3] = pl[0].w;
      if (KPT > 4) { lg[4 % KPT] = pl[1].x; lg[5 % KPT] = pl[1].y; lg[6 % KPT] = pl[1].z; lg[7 % KPT] = pl[1].w; }
    } else {
      float ga[16] = {pl[0].x, pl[0].y, pl[0].z, pl[0].w, pl[1].x, pl[1].y, pl[1].z, pl[1].w,
                      pl[2].x, pl[2].y, pl[2].z, pl[2].w, pl[3].x, pl[3].y, pl[3].z, pl[3].w};
      float z[4] = {ba[0], ba[1], ba[2], ba[3]};
#pragma unroll
      for (int r = 0; r < 16; r++) {
        float4 wv = *(const float4*)&Wa[r * 64 + k0];
        z[0] += ga[r] * wv.x; z[1] += ga[r] * wv.y; z[2] += ga[r] * wv.z; z[3] += ga[r] * wv.w;
      }
#pragma unroll
      for (int i = 0; i < 4; i++) {
        float sp = fmaxf(-z[i], 0.f) + __logf(1.f + __expf(-fabsf(z[i])));
        lg[i] = -sp * (1.f / 16.f);
      }
    }
    {
      unsigned qq[4] = {pq.x, pq.y, pq.z, pq.w}, kk[4] = {pk.x, pk.y, pk.z, pk.w};
#pragma unroll
      for (int i = 0; i < KPT / 2; i++) {
        qv[2 * i] = bflo(qq[i]); qv[2 * i + 1] = bfhi(qq[i]);
        kv[2 * i] = bflo(kk[i]); kv[2 * i + 1] = bfhi(kk[i]);
      }
    }
    {
      unsigned vv[4] = {pv.x, pv.y, pv.z, pv.w};
#pragma unroll
      for (int i = 0; i < 4; i++) {
        VT[(kgp * 8 + 2 * i) * 20 + t] = (u16)(vv[i] & 0xffff);
        VT[(kgp * 8 + 2 * i + 1) * 20 + t] = (u16)(vv[i] >> 16);
      }
    }
    __builtin_amdgcn_sched_barrier(0);
    if (n + nstep < nend) prefetch(n + nstep, im, psg);
    __builtin_amdgcn_sched_barrier(0);
    float qt[KPT], kt[KPT], kh[KPT];
#pragma unroll
    for (int i = 0; i < KPT; i++) {
      float bcum = dpp_scan_add(lg[i]);
      float bl = dpp_row_bcast15(bcum);
      qt[i] = qv[i] * __expf(bcum);
      kt[i] = kv[i] * __expf(-bcum);
      kh[i] = kv[i] * __expf(bl - bcum);
      if (t == 15) Gch[k0 + i] = __expf(bl);
      KhT[(k0 + i) * 20 + t] = f2bf(kh[i]);
    }
    if (KPT == 8) {
      uint4 a, c;
      a.x = pack2(qt[0], qt[1]); a.y = pack2(qt[2], qt[3]); a.z = pack2(qt[4 % KPT], qt[5 % KPT]); a.w = pack2(qt[6 % KPT], qt[7 % KPT]);
      c.x = pack2(kt[0], kt[1]); c.y = pack2(kt[2], kt[3]); c.z = pack2(kt[4 % KPT], kt[5 % KPT]); c.w = pack2(kt[6 % KPT], kt[7 % KPT]);
      *(uint4*)&Qt[t * LQ + k0] = a;
      *(uint4*)&Kt[t * LQ + k0] = c;
    } else {
      uint2 a, c;
      a.x = pack2(qt[0], qt[1]); a.y = pack2(qt[2], qt[3]);
      c.x = pack2(kt[0], kt[1]); c.y = pack2(kt[2], kt[3]);
      *(uint2*)&Qt[t * LQ + k0] = a;
      *(uint2*)&Kt[t * LQ + k0] = c;
    }
    }
    __syncthreads();
    if (MODE == 1) {
      char* dst = img + (size_t)n * IMG;
#pragma unroll
      for (int i = 0; i < NIM; i++) if (tid * 16 + 4096 * i < IMG) *(u32x4*)(dst + tid * 16 + 4096 * i) = *(const u32x4*)(smem + tid * 16 + 4096 * i);
      __syncthreads();
      return;
    }

    STAGE();
    f32x4 sc = f32x4{0, 0, 0, 0};
    bf16x8 qf[NKS];
#pragma unroll
    for (int st = 0; st < NKS; st++) {
      bf16x4 q0 = *(const bf16x4*)&Qt[l15 * LQ + 32 * st + kg * 4];
      bf16x4 q1 = *(const bf16x4*)&Qt[l15 * LQ + 32 * st + 16 + kg * 4];
      bf16x4 c0 = *(const bf16x4*)&Kt[l15 * LQ + 32 * st + kg * 4];
      bf16x4 c1 = *(const bf16x4*)&Kt[l15 * LQ + 32 * st + 16 + kg * 4];
      qf[st] = bf16x8{q0[0], q0[1], q0[2], q0[3], q1[0], q1[1], q1[2], q1[3]};
      bf16x8 kf = bf16x8{c0[0], c0[1], c0[2], c0[3], c1[0], c1[1], c1[2], c1[3]};
      sc = __builtin_amdgcn_mfma_f32_16x16x32_bf16(kf, qf[st], sc, 0, 0, 0);
    }
    STAGE();
#pragma unroll
    for (int r = 0; r < 4; r++) if (kg * 4 + r > l15) sc[r] = 0.f;
    bf16x4 pA;
    {
      unsigned a = pack2(sc[0], sc[1]), c = pack2(sc[2], sc[3]);
      pA = bf16x4{(short)(a & 0xffff), (short)(a >> 16), (short)(c & 0xffff), (short)(c >> 16)};
    }
    bf16x4 vf[2];
    f32x4 o[2], oin[2];
    bf16x8 sbv[2][NKS];
#pragma unroll
    for (int vt = 0; vt < 2; vt++) {
      vf[vt] = *(const bf16x4*)&VT[(w * 32 + vt * 16 + l15) * 20 + kg * 4];
#pragma unroll
      for (int st = 0; st < NKS; st++) {
        unsigned s0 = pack2(S[2 * st][vt][0], S[2 * st][vt][1]), s1 = pack2(S[2 * st][vt][2], S[2 * st][vt][3]);
        unsigned s2 = pack2(S[2 * st + 1][vt][0], S[2 * st + 1][vt][1]), s3 = pack2(S[2 * st + 1][vt][2], S[2 * st + 1][vt][3]);
        sbv[vt][st] = bf16x8{(short)(s0 & 0xffff), (short)(s0 >> 16), (short)(s1 & 0xffff), (short)(s1 >> 16),
                           (short)(s2 & 0xffff), (short)(s2 >> 16), (short)(s3 & 0xffff), (short)(s3 >> 16)};
      }
    }
    STAGE();
#pragma unroll
    for (int vt = 0; vt < 2; vt++) {
      o[vt] = __builtin_amdgcn_mfma_f32_16x16x16bf16_1k(pA, vf[vt], f32x4{0, 0, 0, 0}, 0, 0, 0);
      oin[vt] = f32x4{0, 0, 0, 0};
#pragma unroll
      for (int st = 0; st < NKS; st++) oin[vt] = __builtin_amdgcn_mfma_f32_16x16x32_bf16(qf[st], sbv[vt][st], oin[vt], 0, 0, 0);
    }
    STAGE();
    bf16x4 khf[NKT];
#pragma unroll
    for (int kt2 = 0; kt2 < NKT; kt2++) {
      khf[kt2] = *(const bf16x4*)&KhT[(16 * kt2 + l15) * 20 + kg * 4];
      float4 g4 = *(const float4*)&Gch[16 * kt2 + kg * 4];
      f32x4 gv = f32x4{g4.x, g4.y, g4.z, g4.w};
      S[kt2][0] *= gv; S[kt2][1] *= gv;
    }
    STAGE();
#pragma unroll
    for (int kt2 = 0; kt2 < NKT; kt2++) {
#pragma unroll
      for (int vt = 0; vt < 2; vt++)
        S[kt2][vt] = __builtin_amdgcn_mfma_f32_16x16x16bf16_1k(khf[kt2], vf[vt], S[kt2][vt], 0, 0, 0);
    }
    STAGE();
    float ss[4];
#pragma unroll
    for (int r = 0; r < 4; r++) {
      o[0][r] += oin[0][r]; o[1][r] += oin[1][r];
      float s = o[0][r] * o[0][r] + o[1][r] * o[1][r];
      s = dpp_row_sum(s);
      ss[r] = s;
    }
    if (l15 == 0) *(float4*)&SS[w * 16 + kg * 4] = make_float4(ss[0], ss[1], ss[2], ss[3]);
    __syncthreads();
    {
      float4 a0 = *(const float4*)&SS[0 * 16 + kg * 4], a1 = *(const float4*)&SS[1 * 16 + kg * 4];
      float4 a2 = *(const float4*)&SS[2 * 16 + kg * 4], a3 = *(const float4*)&SS[3 * 16 + kg * 4];
      float tot[4] = {a0.x + a1.x + a2.x + a3.x, a0.y + a1.y + a2.y + a3.y, a0.z + a1.z + a2.z + a3.z, a0.w + a1.w + a2.w + a3.w};
#pragma unroll
      for (int r = 0; r < 4; r++) {
        const float rstd = rsqrtf(tot[r] * (1.f / 128.f) + LN_EPS);
        const int li = (kg * 4 + r) * 136 + w * 32 + l15;
        sgate[r] = bf2f(GT[li]); sgate[4 + r] = bf2f(GT[li + 16]);
        OT[li] = f2bf(o[0][r] * rstd * g0 * sgate[r]);
        OT[li + 16] = f2bf(o[1][r] * rstd * g1 * sgate[4 + r]);
      }
    }
    __syncthreads();
    *(u32x4*)(p.O + ((size_t)b * SEQ + n * 16 + (tid >> 4)) * DM + ocol + (tid & 15) * 8) = *(const u32x4*)&OT[(tid >> 4) * 136 + (tid & 15) * 8];
  };
  if (MODE == 2) {
    prefetch(0, imA, psg);
    prefetch(1, imB, psgB);
    for (int n = 0; n < SEQ / 16; n += 2) {
      if (n == 62) mid_barrier(p, smem);
      step(n, imA, psg); step(n + 1, imB, psgB);
    }
  } else {
    prefetch(nstart, imA, psg);
    for (int n = nstart; n < nend; n += nstep) step(n, imA, psg);
  }
}

constexpr size_t IMGH_SZ = (2 * 16 * 136 + 128 * 20 + 128 * 20) * 2 + 128 * 4;
constexpr size_t IMGG_SZ = (2 * 16 * 72 + 64 * 20 + 128 * 20) * 2 + 64 * 4;
__device__ void phaseB0(const Params& p, char* smem) {
  const int nparts = gridDim.x >> 6;
  if ((int)blockIdx.x >= nparts * 64) return;
  const int u = blockIdx.x & 63, part = blockIdx.x >> 6;
  __syncthreads();
  if (u < 32) recur_unit<128, true, 1>(p, smem, u >> 2, u & 3, p.IMGH + (size_t)u * 128 * IMGH_SZ, part, nparts, 64);
  else recur_unit<64, false, 1>(p, smem, (u - 32) >> 2, u & 3, p.IMGG + (size_t)(u - 32) * 128 * IMGG_SZ, part, nparts, 64);
}
__device__ void phaseB(const Params& p, char* smem) {
  if (blockIdx.x >= 64) {
    const bool quiet = (gridDim.x == 512) && (blockIdx.x >= 256) && (blockIdx.x < 320);
    const int nb = (gridDim.x == 512) ? 384 : ((int)gridDim.x - 64);
    const int fidx = (gridDim.x == 512) ? ((blockIdx.x < 256) ? (int)blockIdx.x - 64 : (int)blockIdx.x - 128) : ((int)blockIdx.x - 64);
    if (quiet) { mid_barrier(p, smem); return; }
    constexpr int NCV = NEXP * 2 * 128, NCV1 = 5632;
    u16* T = (u16*)smem;
    const int tr = threadIdx.x >> 4, tc4 = (threadIdx.x & 15) * 4;
    auto cload = [&](int u, float4 (&v)[4]) {
      const int tile = u & 127, mat = (u >> 7) & 1, e = u >> 8;
      const float* W = (mat ? p.w_up : p.w_gate) + (size_t)e * DM * DEXP + (size_t)((tile & 15) * 64) * DEXP + (tile >> 4) * 64;
#pragma unroll
      for (int i = 0; i < 4; i++) v[i] = *(const float4*)&W[(size_t)(tr + 16 * i) * DEXP + tc4];
    };
    auto cproc = [&](int u, float4 (&v)[4]) {
      const int tile = u & 127, mat = (u >> 7) & 1, e = u >> 8;
      u16* WT = (mat ? p.WuT : p.WgT) + (size_t)e * DEXP * DM;
      const int k0 = (tile & 15) * 64, n0 = (tile >> 4) * 64;
      __syncthreads();
#pragma unroll
      for (int i = 0; i < 4; i++) {
        const int k = tr + 16 * i;
        T[(tc4 + 0) * 72 + k] = f2bf(v[i].x); T[(tc4 + 1) * 72 + k] = f2bf(v[i].y);
        T[(tc4 + 2) * 72 + k] = f2bf(v[i].z); T[(tc4 + 3) * 72 + k] = f2bf(v[i].w);
      }
      __syncthreads();
      const int n = threadIdx.x >> 2, seg = (threadIdx.x & 3) * 16;
      const u32x4 a = *(const u32x4*)&T[n * 72 + seg], b = *(const u32x4*)&T[n * 72 + seg + 8];
      *(u32x4*)&WT[(size_t)(n0 + n) * DM + k0 + seg] = a;
      *(u32x4*)&WT[(size_t)(n0 + n) * DM + k0 + seg + 8] = b;
    };
    auto conv_range = [&](int u, int uend) -> int {
      float4 va[4], vb[4];
      if (u < uend) cload(u, va);
      while (u < uend) {
        if (u + nb < uend) cload(u + nb, vb);
        cproc(u, va);
        u += nb;
        if (u >= uend) break;
        if (u + nb < uend) cload(u + nb, va);
        cproc(u, vb);
        u += nb;
      }
      return u;
    };
    for (int i = fidx; i < 64 * 64; i += nb) {
      const int uu = i & 63, n = 64 + (i >> 6);
      __syncthreads();
      if (uu < 32) recur_unit<128, true, 1>(p, smem, uu >> 2, uu & 3, p.IMGH + (size_t)uu * 128 * IMGH_SZ, n, 128, n + 1);
      else recur_unit<64, false, 1>(p, smem, (uu - 32) >> 2, uu & 3, p.IMGG + (size_t)(uu - 32) * 128 * IMGG_SZ, n, 128, n + 1);
    }
    int u = conv_range(fidx, NCV1);
    mid_barrier(p, smem);
    phaseC(p, smem, 0);
    conv_range(u, NCV);
    return;
  }
  for (int u = blockIdx.x; u < 64; u += gridDim.x) {
    __syncthreads();
    if (u < 32) recur_unit<128, true, 2>(p, smem, u >> 2, u & 3, p.IMGH + (size_t)u * 128 * IMGH_SZ, 0, 1, SEQ / 16);
    else recur_unit<64, false, 2>(p, smem, (u - 32) >> 2, u & 3, p.IMGG + (size_t)(u - 32) * 128 * IMGG_SZ, 0, 1, SEQ / 16);
  }
}

__device__ void phaseC(const Params& p, char* smem, int which) {
  for (int half = 0; half <= which; half++)
  xcd_queue_run(p.bar + QW_BASE + 512 + 32 * half, half ? 72 : 56, smem + 2 * GEMM_SMEM + 800, [&](int j, int q) {
    const int mt = half ? ((q / 9) * 16 + 7 + q % 9) : ((q / 7) * 16 + q % 7), nt = j;
    const int m0 = mt * 128, n0 = nt * 128;
    auto rowf = [&](int r) { return (const void*)(p.O + (size_t)(m0 + r) * DM); };
    auto colf = [&](int c) { return (const void*)(p.WoutT + (size_t)(n0 + c) * DM); };
    auto epi = [&](f32x4 (&acc)[4][4], int mb, int nb) {
#pragma unroll
      for (int mi = 0; mi < 4; mi++)
#pragma unroll
        for (int ni = 0; ni < 4; ni++) {
          const int m = m0 + mb + mi * 16;
          const size_t idx = (size_t)m * DM + n0 + nb + ni * 16;
          float4 xv = *(const float4*)&p.x[idx];
          f32x4 v = acc[mi][ni];
          float* zp = (half == 0) ? (p.LF + ((size_t)((m >> 11) * 1024 + (m & 1023))) * DM + n0 + nb + ni * 16) : (p.Z + idx);
          *(float4*)zp = make_float4(ALPHA * xv.x + v[0], ALPHA * xv.y + v[1], ALPHA * xv.z + v[2], ALPHA * xv.w + v[3]);
        }
    };
    gemm_tile<true, true>(smem, DM, rowf, colf, DM, epi);
  });
}

__device__ __forceinline__ float wave_sum(float v) {
  v = dpp_row_sum(v);
  const int vi = __float_as_int(v);
  return (__int_as_float(__builtin_amdgcn_readlane(vi, 0)) + __int_as_float(__builtin_amdgcn_readlane(vi, 16))) +
         (__int_as_float(__builtin_amdgcn_readlane(vi, 32)) + __int_as_float(__builtin_amdgcn_readlane(vi, 48)));
}

__device__ __forceinline__ void ln_row(const float* zin, const float* g, const float* bb, int lane, float4 (&o)[4]) {
  float4 v[4];
  float s = 0.f;
#pragma unroll
  for (int i = 0; i < 4; i++) { v[i] = *(const float4*)&zin[lane * 4 + 256 * i]; s += v[i].x + v[i].y + v[i].z + v[i].w; }
  const float mu = wave_sum(s) * (1.f / 1024.f);
  float q = 0.f;
#pragma unroll
  for (int i = 0; i < 4; i++) {
    v[i].x -= mu; v[i].y -= mu; v[i].z -= mu; v[i].w -= mu;
    q += v[i].x * v[i].x + v[i].y * v[i].y + v[i].z * v[i].z + v[i].w * v[i].w;
  }
  const float rstd = rsqrtf(wave_sum(q) * (1.f / 1024.f) + LN_EPS);
#pragma unroll
  for (int i = 0; i < 4; i++) {
    float4 gg = *(const float4*)&g[lane * 4 + 256 * i], b4 = *(const float4*)&bb[lane * 4 + 256 * i];
    o[i] = make_float4(v[i].x * rstd * gg.x + b4.x, v[i].y * rstd * gg.y + b4.y, v[i].z * rstd * gg.z + b4.z, v[i].w * rstd * gg.w + b4.w);
  }
}

__device__ void phaseD(const Params& p, char* smem) {
  float* part = (float*)smem;
  float* logits = part + 4 * 16 * 80;
  float* stats = logits + 16 * 72;
  const int tid = threadIdx.x, lane = tid & 63, w = tid >> 6, l15 = lane & 15, kg = lane >> 4;
  for (int g = blockIdx.x; g < NTOK / 16; g += gridDim.x) {
    const int row0 = g * 16;
    {
      float4 v[4][4];
#pragma unroll
      for (int i = 0; i < 4; i++)
#pragma unroll
        for (int j = 0; j < 4; j++) {
          const int row = row0 + w * 4 + i;
          const float* zr = ((row & 2047) >= 896) ? (p.Z + (size_t)row * DM) : (p.LF + ((size_t)((row >> 11) * 1024 + (row & 1023))) * DM);
          v[i][j] = *(const float4*)&zr[lane * 4 + 256 * j];
        }
#pragma unroll
      for (int i = 0; i < 4; i++) {
        const int row = row0 + w * 4 + i;
        float s = 0.f;
#pragma unroll
        for (int j = 0; j < 4; j++) s += v[i][j].x + v[i][j].y + v[i][j].z + v[i][j].w;
        const float mu = wave_sum(s) * (1.f / 1024.f);
        float q = 0.f;
#pragma unroll
        for (int j = 0; j < 4; j++) {
          v[i][j].x -= mu; v[i][j].y -= mu; v[i][j].z -= mu; v[i][j].w -= mu;
          q += v[i][j].x * v[i][j].x + v[i][j].y * v[i][j].y + v[i][j].z * v[i][j].z + v[i][j].w * v[i][j].w;
        }
        const float rstd = rsqrtf(wave_sum(q) * (1.f / 1024.f) + LN_EPS);
        if (lane == 0) { stats[(w * 4 + i) * 2] = mu; stats[(w * 4 + i) * 2 + 1] = rstd; }
#pragma unroll
        for (int j = 0; j < 4; j++) {
          const float4 gg = *(const float4*)&p.ln1_g[lane * 4 + 256 * j], b4 = *(const float4*)&p.ln1_b[lane * 4 + 256 * j];
          const float4 o = make_float4(v[i][j].x * rstd * gg.x + b4.x, v[i][j].y * rstd * gg.y + b4.y, v[i][j].z * rstd * gg.z + b4.z, v[i][j].w * rstd * gg.w + b4.w);
          uint2 h; h.x = pack2(o.x, o.y); h.y = pack2(o.z, o.w);
          *(uint2*)&p.X1B[(size_t)row * DM + lane * 4 + 256 * j] = h;
        }
      }
    }
    __syncthreads();
    f32x4 acc[5];
#pragma unroll
    for (int i = 0; i < 5; i++) acc[i] = f32x4{0, 0, 0, 0};
    const int rrow = row0 + l15;
    const float* xrow = (((rrow & 2047) >= 896) ? (p.Z + (size_t)rrow * DM) : (p.LF + ((size_t)((rrow >> 11) * 1024 + (rrow & 1023))) * DM)) + 256 * w + 4 * kg;
    const float rmu = stats[l15 * 2], rrs = stats[l15 * 2 + 1];
    struct RB { float4 a, g, b; float we[4][4]; float wg[4]; };
    auto rload = [&](int it, RB& r) {
      r.a = *(const float4*)&xrow[16 * it];
      r.g = *(const float4*)&p.ln1_g[256 * w + 16 * it + 4 * kg];
      r.b = *(const float4*)&p.ln1_b[256 * w + 16 * it + 4 * kg];
      const int kb = 256 * w + 16 * it + 4 * kg;
#pragma unroll
      for (int i = 0; i < 4; i++) {
        const float* we = p.w_er + (size_t)(kb + i) * 64 + l15;
#pragma unroll
        for (int nt = 0; nt < 4; nt++) r.we[i][nt] = we[16 * nt];
        r.wg[i] = (l15 < 8) ? p.w_gr[(size_t)(kb + i) * 8 + l15] : 0.f;
      }
    };
    auto rcomp = [&](const RB& r) {
      const float av[4] = {(r.a.x - rmu) * rrs * r.g.x + r.b.x, (r.a.y - rmu) * rrs * r.g.y + r.b.y,
                           (r.a.z - rmu) * rrs * r.g.z + r.b.z, (r.a.w - rmu) * rrs * r.g.w + r.b.w};
#pragma unroll
      for (int i = 0; i < 4; i++) {
#pragma unroll
        for (int nt = 0; nt < 4; nt++) acc[nt] = __builtin_amdgcn_mfma_f32_16x16x4f32(av[i], r.we[i][nt], acc[nt], 0, 0, 0);
        acc[4] = __builtin_amdgcn_mfma_f32_16x16x4f32(av[i], r.wg[i], acc[4], 0, 0, 0);
      }
    };
    {
      RB r0, r1;
      rload(0, r0);
      for (int it = 0; it < 16; it += 2) {
        rload(it + 1, r1);
        rcomp(r0);
        if (it + 2 < 16) rload(it + 2, r0);
        rcomp(r1);
      }
    }
#pragma unroll
    for (int nt = 0; nt < 5; nt++)
#pragma unroll
      for (int r = 0; r < 4; r++) part[(w * 16 + kg * 4 + r) * 80 + nt * 16 + l15] = acc[nt][r];
    __syncthreads();
    for (int idx = tid; idx < 16 * 72; idx += 256) {
      const int r = idx / 72, c = idx % 72;
      logits[r * 72 + c] = part[(0 * 16 + r) * 80 + c] + part[(1 * 16 + r) * 80 + c] + part[(2 * 16 + r) * 80 + c] + part[(3 * 16 + r) * 80 + c];
    }
    __syncthreads();
    if (tid < 16) {
      const float* L = logits + tid * 72;
      const int tok = row0 + tid;
      float gm = L[64]; int gi = 0;
      for (int i = 1; i < 8; i++) if (L[64 + i] > gm) { gm = L[64 + i]; gi = i; }
      float gs = 0.f;
      for (int i = 0; i < 8; i++) gs += expf(L[64 + i] - gm);
      const float pg = 1.f / gs;
      const float* E = L + gi * 8;
      float em = E[0]; int i1 = 0;
      for (int i = 1; i < 8; i++) if (E[i] > em) { em = E[i]; i1 = i; }
      float e2 = -3.0e38f; int i2 = 0;
      for (int i = 0; i < 8; i++) if (i != i1 && E[i] > e2) { e2 = E[i]; i2 = i; }
      const float p1 = 1.f, p2 = expf(e2 - em);
      const float gt1 = pg * p1 / (p1 + p2), gt2 = pg * p2 / (p1 + p2);
      const int ex1 = gi * 8 + i1, ex2 = gi * 8 + i2;
      const int pos1 = atomicAdd(&p.cnt[ex1], 1);
      const int pos2 = atomicAdd(&p.cnt[ex2], 1);
      p.list_tok[ex1 * CAP + pos1] = tok; p.list_gate[ex1 * CAP + pos1] = gt1;
      p.list_tok[ex2 * CAP + pos2] = tok; p.list_gate[ex2 * CAP + pos2] = gt2;
      p.tok_e[tok * 2] = ex1; p.tok_e[tok * 2 + 1] = ex2;
      p.tok_pos[tok * 2] = pos1; p.tok_pos[tok * 2 + 1] = pos2;
    }
    __syncthreads();
  }
}

__device__ __forceinline__ void moe_prefix(const Params& p, int* s_off, int* s_rb) {
  __syncthreads();
  if (threadIdx.x == 0) {
    int o = 0, r = 0;
    for (int e = 0; e < NEXP; e++) {
      s_off[e] = o; s_rb[e] = r;
      int c = p.cnt[e];
      o += c; r += (c + 127) >> 7;
    }
    s_off[NEXP] = o; s_rb[NEXP] = r;
  }
  __syncthreads();
}

__device__ void phaseE1(const Params& p, char* smem) {
  int* s_off = (int*)(smem + 2 * GEMM_SMEM);
  int* s_rb = s_off + 72;
  moe_prefix(p, s_off, s_rb);
  xcd_queue_run(p.bar + QW_BASE + 1024, s_rb[NEXP], smem + 2 * GEMM_SMEM + 800, [&](int j, int q) {
    const int rbg = q, jt = j;
    int e = 0;
    while (s_rb[e + 1] <= rbg) e++;
    const int rb = rbg - s_rb[e];
    const int cnt = p.cnt[e];
    const int rows = min(128, cnt - rb * 128);
    const int* lt = p.list_tok + e * CAP + rb * 128;
    const int slot0 = s_off[e] + rb * 128;
    const int j0 = jt * 64;
    const u16* wg = p.WgT + (size_t)e * DEXP * DM;
    const u16* wu = p.WuT + (size_t)e * DEXP * DM;
    auto rowf = [&](int r) { int rr = r < rows ? r : 0; return (const void*)(p.X1B + (size_t)lt[rr] * DM); };
    auto colf = [&](int c) { return (const void*)(((c & 32) ? wu : wg) + (size_t)(j0 + (c >> 6) * 32 + (c & 31)) * DM); };
    auto epi = [&](f32x4 (&acc)[4][4], int mb, int nb) {
      const int wn = nb >> 6, kg4 = nb & 63;
#pragma unroll
      for (int mi = 0; mi < 4; mi++) {
        const int r = mb + mi * 16;
        if (r < rows) {
#pragma unroll
          for (int ni = 0; ni < 2; ni++) {
            f32x4 gv = acc[mi][ni], uv = acc[mi][ni + 2];
            uint2 o;
            o.x = pack2(siluf(gv[0]) * uv[0], siluf(gv[1]) * uv[1]);
            o.y = pack2(siluf(gv[2]) * uv[2], siluf(gv[3]) * uv[3]);
            *(uint2*)&p.H[(size_t)(slot0 + r) * DEXP + j0 + wn * 32 + ni * 16 + kg4] = o;
          }
        }
      }
    };
    gemm_tile<true, true>(smem, DM, rowf, colf, DEXP, epi);
  });
}

__device__ void phaseE2(const Params& p, char* smem) {
  int* s_off = (int*)(smem + 2 * GEMM_SMEM);
  int* s_rb = s_off + 72;
  moe_prefix(p, s_off, s_rb);
  xcd_queue_run(p.bar + QW_BASE + 1536, s_rb[NEXP], smem + 2 * GEMM_SMEM + 800, [&](int j, int q) {
    const int rbg = q, nt = j;
    int e = 0;
    while (s_rb[e + 1] <= rbg) e++;
    const int rb = rbg - s_rb[e];
    const int cnt = p.cnt[e];
    const int rows = min(128, cnt - rb * 128);
    const int slot0 = s_off[e] + rb * 128;
    const int n0 = nt * 128;
    const float* wd = p.w_down + (size_t)e * DEXP * DM;
    const float* lg = p.list_gate + e * CAP + rb * 128;
    auto rowf = [&](int r) { int rr = r < rows ? r : 0; return (const void*)(p.H + (size_t)(slot0 + rr) * DEXP); };
    auto colf = [&](int c) { return (const void*)(wd + n0 + c); };
    auto epi = [&](f32x4 (&acc)[4][4], int mb, int nb) {
#pragma unroll
      for (int mi = 0; mi < 4; mi++) {
        const int r = mb + mi * 16;
        if (r < rows) {
          const float gt = lg[r];
#pragma unroll
          for (int ni = 0; ni < 4; ni++) {
            f32x4 v = acc[mi][ni];
            uint2 o; o.x = pack2(gt * v[0], gt * v[1]); o.y = pack2(gt * v[2], gt * v[3]);
            *(uint2*)&p.Y[(size_t)(slot0 + r) * DM + n0 + nb + ni * 16] = o;
          }
        }
      }
    };
    gemm_tile<true, false>(smem, DEXP, rowf, colf, DM, epi);
  });
}

__device__ void phaseF(const Params& p, char* smem) {
  int* s_off = (int*)(smem + 2 * GEMM_SMEM);
  int* s_rb = s_off + 72;
  moe_prefix(p, s_off, s_rb);
  const int tid = threadIdx.x, lane = tid & 63, w = tid >> 6;
  for (int rp = blockIdx.x * 4 + w; rp < NTOK / 2; rp += gridDim.x * 4) {
    int sl[2][2];
#pragma unroll
    for (int h = 0; h < 2; h++) {
      const int row = rp * 2 + h;
      const int2 te = *(const int2*)&p.tok_e[row * 2], tp = *(const int2*)&p.tok_pos[row * 2];
      sl[h][0] = s_off[te.x] + tp.x;
      sl[h][1] = s_off[te.y] + tp.y;
    }
    float4 v[2][4];
#pragma unroll
    for (int h = 0; h < 2; h++) {
      const int row = rp * 2 + h;
#pragma unroll
      for (int i = 0; i < 4; i++) {
        const int c = lane * 4 + 256 * i;
        const uint2 xb2 = *(const uint2*)&p.X1B[(size_t)row * DM + c];
        const float4 xv = make_float4(bflo(xb2.x), bfhi(xb2.x), bflo(xb2.y), bfhi(xb2.y));
        const uint2 ya = *(const uint2*)&p.Y[(size_t)sl[h][0] * DM + c];
        const uint2 yb = *(const uint2*)&p.Y[(size_t)sl[h][1] * DM + c];
        v[h][i].x = ALPHA * xv.x + (bflo(ya.x) + bflo(yb.x));
        v[h][i].y = ALPHA * xv.y + (bfhi(ya.x) + bfhi(yb.x));
        v[h][i].z = ALPHA * xv.z + (bflo(ya.y) + bflo(yb.y));
        v[h][i].w = ALPHA * xv.w + (bfhi(ya.y) + bfhi(yb.y));
      }
    }
#pragma unroll
    for (int h = 0; h < 2; h++) {
      const int row = rp * 2 + h;
      float s = 0.f;
#pragma unroll
      for (int i = 0; i < 4; i++) s += v[h][i].x + v[h][i].y + v[h][i].z + v[h][i].w;
      const float mu = wave_sum(s) * (1.f / 1024.f);
      float q = 0.f;
#pragma unroll
      for (int i = 0; i < 4; i++) {
        v[h][i].x -= mu; v[h][i].y -= mu; v[h][i].z -= mu; v[h][i].w -= mu;
        q += v[h][i].x * v[h][i].x + v[h][i].y * v[h][i].y + v[h][i].z * v[h][i].z + v[h][i].w * v[h][i].w;
      }
      const float rstd = rsqrtf(wave_sum(q) * (1.f / 1024.f) + LN_EPS);
#pragma unroll
      for (int i = 0; i < 4; i++) {
        const int c = lane * 4 + 256 * i;
        const float4 gg = *(const float4*)&p.ln2_g[c], b4 = *(const float4*)&p.ln2_b[c];
        *(float4*)&p.out[(size_t)row * DM + c] =
            make_float4(v[h][i].x * rstd * gg.x + b4.x, v[h][i].y * rstd * gg.y + b4.y, v[h][i].z * rstd * gg.z + b4.z, v[h][i].w * rstd * gg.w + b4.w);
      }
    }
  }
}


#define XB_TMO      128
#define XB_XCNT(j)  (256  + 64 * (j))
#define XB_XSUB(j)  (1280 + 64 * (j))
#define XB_XGEN(j)  (2304 + 64 * (j))
#define XB_TOP      3328
#define XB_TOPGEN   3392
#define XCD_BAR_WORDS 3456
#define XB_SPIN_CAP (1u << 18)
#define LAS __attribute__((address_space(3)))
__device__ __forceinline__ unsigned xb_ld(unsigned* p)              { return __hip_atomic_load(p, __ATOMIC_RELAXED, __HIP_MEMORY_SCOPE_AGENT); }
__device__ __forceinline__ unsigned xb_add(unsigned* p, unsigned v) { return __hip_atomic_fetch_add(p, v, __ATOMIC_RELAXED, __HIP_MEMORY_SCOPE_AGENT); }
__device__ __forceinline__ unsigned xb_xcc_id() { return (unsigned)__builtin_amdgcn_s_getreg((3 << 11) | 20) & 0xFu; }
#define XB_SPIN(cond, bar) do { unsigned _sp = 0; while (cond) { __builtin_amdgcn_s_sleep(1); \
    if ((++_sp & 255u) == 0u) { if (xb_ld(&(bar)[XB_TMO])) break; if (_sp > XB_SPIN_CAP) { atomicAdd(&(bar)[XB_TMO], 1u); break; } } } } while (0)
struct XcdBarrier { unsigned* bar; unsigned x; volatile LAS unsigned* st; };
__device__ __forceinline__ XcdBarrier xcd_barrier_post(unsigned* bar, volatile LAS unsigned* st) {
  XcdBarrier b; b.bar = bar; b.x = xb_xcc_id(); b.st = st;
  if (threadIdx.x == 0) (void)xb_add(&bar[XB_XCNT(b.x)], 1u);
  return b;
}
__device__ __forceinline__ void xcd_barrier_complete(unsigned* bar, unsigned x, unsigned& nloc, unsigned& nx) {
  const unsigned G = gridDim.x * gridDim.y * gridDim.z;
  unsigned sum, cnt, mine, sp = 0u;
  for (;;) {
    sum = 0u; cnt = 0u; mine = 0u;
#pragma unroll
    for (unsigned j = 0; j < 16; ++j) { const unsigned c = xb_ld(&bar[XB_XCNT(j)]); sum += c; cnt += (c > 0u) ? 1u : 0u; mine = (j == x) ? c : mine; }
    if (sum == G) break;
    __builtin_amdgcn_s_sleep(1);
    if ((++sp & 255u) == 0u) { if (xb_ld(&bar[XB_TMO])) break; if (sp > XB_SPIN_CAP) { atomicAdd(&bar[XB_TMO], 1u); break; } }
  }
  nloc = mine > 0u ? mine : 1u; nx = cnt > 0u ? cnt : 1u;
}
__device__ __forceinline__ void xcd_barrier(const XcdBarrier& b) {
  asm volatile("s_waitcnt vmcnt(0)" ::: "memory");
  __syncthreads();
  if (threadIdx.x == 0) {
    unsigned* bar = b.bar;
    __builtin_amdgcn_s_waitcnt(0);
    unsigned nloc = b.st[0], nx = b.st[1];
    if (nloc == 0u) { xcd_barrier_complete(bar, b.x, nloc, nx); b.st[0] = nloc; b.st[1] = nx; }
    const unsigned old = xb_add(&bar[XB_XSUB(b.x)], 1u);
    const unsigned gen = old / nloc;
    if (old + 1u == (gen + 1u) * nloc) {
      __builtin_amdgcn_fence(__ATOMIC_RELEASE, "agent");
      asm volatile("s_waitcnt vmcnt(0)" ::: "memory");
      const unsigned og = xb_add(&bar[XB_TOP], 1u);
      const unsigned tg = og / nx;
      if (og + 1u == (tg + 1u) * nx) xb_add(&bar[XB_TOPGEN], 1u);
      else XB_SPIN(xb_ld(&bar[XB_TOPGEN]) == tg, bar);
      __builtin_amdgcn_fence(__ATOMIC_ACQUIRE, "agent");
      xb_add(&bar[XB_XGEN(b.x)], 1u);
      asm volatile("s_waitcnt vmcnt(0)" ::: "memory");
    } else {
      XB_SPIN(xb_ld(&bar[XB_XGEN(b.x)]) == gen, bar);
      __builtin_amdgcn_fence(__ATOMIC_ACQUIRE, "agent");
      asm volatile("s_waitcnt vmcnt(0)" ::: "memory");
    }
  }
  __syncthreads();
}

__device__ void mid_barrier(const Params& p, char* smem) {
  XcdBarrier b; b.bar = p.bar; b.x = xb_xcc_id(); b.st = (volatile LAS unsigned*)(smem + 2 * GEMM_SMEM + 768);
  xcd_barrier(b);
}
constexpr int AUX_OFF = 2 * GEMM_SMEM;
constexpr int SMEM_BYTES = AUX_OFF + 1024;

#if SINGLE
__global__ void __launch_bounds__(256, 2) fwd_megakernel(Params p) {
  extern __shared__ __attribute__((aligned(16))) char smem[];
  cg::grid_group grid = cg::this_grid();
  volatile LAS unsigned* st = (volatile LAS unsigned*)(smem + AUX_OFF + 768);
  if (threadIdx.x < 2) st[threadIdx.x] = 0u;
  __syncthreads();
  XcdBarrier xb = xcd_barrier_post(p.bar, st);
  if (p.use_cg) grid.sync();
  phaseP0(p, smem);
  xcd_barrier(xb);
  phaseA(p, smem);
  xcd_barrier(xb);
  phaseB0(p, smem);
  xcd_barrier(xb);
  phaseB(p, smem);
  xcd_barrier(xb);
  phaseC(p, smem, 1);
  xcd_barrier(xb);
  phaseD(p, smem);
  xcd_barrier(xb);
  phaseE1(p, smem);
  xcd_barrier(xb);
  phaseE2(p, smem);
  xcd_barrier(xb);
  phaseF(p, smem);
}
#else
#define PHASE_KERNEL(NAME, FN)                                             \
  __global__ void __launch_bounds__(256, 2) NAME(Params p) {                  \
    __shared__ __attribute__((aligned(16))) char smem[SMEM_BYTES];         \
    FN(p, smem);                                                           \
  }
PHASE_KERNEL(kA, phaseA)
PHASE_KERNEL(kB, phaseB)
PHASE_KERNEL(kC, phaseC)
PHASE_KERNEL(kD, phaseD)
PHASE_KERNEL(kE1, phaseE1)
PHASE_KERNEL(kE2, phaseE2)
PHASE_KERNEL(kF, phaseF)
#endif

extern "C" void kernel_launch(void* const* d_in, const int* in_sizes, int n_in, void* d_out, int out_size,
                              void* d_ws, size_t ws_size, hipStream_t stream) {
  Params p{};
  p.x = (const float*)d_in[0];
  p.w_in = (const float*)d_in[1];
  p.w_a2 = (const float*)d_in[2];
  p.b_a = (const float*)d_in[3];
  p.lb = (const float*)d_in[4];
  p.norm_h = (const float*)d_in[5];
  p.norm_g = (const float*)d_in[6];
  p.w_out = (const float*)d_in[7];
  p.ln1_g = (const float*)d_in[8];
  p.ln1_b = (const float*)d_in[9];
  p.w_gr = (const float*)d_in[10];
  p.w_er = (const float*)d_in[11];
  p.w_gate = (const float*)d_in[12];
  p.w_up = (const float*)d_in[13];
  p.w_down = (const float*)d_in[14];
  p.ln2_g = (const float*)d_in[15];
  p.ln2_b = (const float*)d_in[16];
  p.out = (float*)d_out;
  char* ws = (char*)d_ws;
  size_t off = 0;
  auto take = [&](size_t bytes) { char* r = ws + off; off += (bytes + 255) & ~(size_t)255; return r; };
  p.P = (u16*)take((size_t)NTOK * INC * 2);
  p.LF = (float*)take((size_t)NTOK * 512 * 4);
  p.GA = (float*)take((size_t)NTOK * 16 * 4);
  p.Z = (float*)take((size_t)NTOK * DM * 4);
  p.O = (u16*)take((size_t)NTOK * DM * 2);
  p.X1 = (float*)take((size_t)NTOK * DM * 4);
  p.X1B = (u16*)take((size_t)NTOK * DM * 2);
  p.cnt = (int*)take(256);
  p.tok_e = (int*)take((size_t)NTOK * 2 * 4);
  p.tok_pos = (int*)take((size_t)NTOK * 2 * 4);
  p.list_tok = (int*)take((size_t)NEXP * CAP * 4);
  p.list_gate = (float*)take((size_t)NEXP * CAP * 4);
  p.bar = (unsigned*)take((XCD_BAR_WORDS + 2048) * 4);
  p.XB = p.O;
  p.WgT = (u16*)take((size_t)NEXP * DEXP * DM * 2);
  p.WuT = (u16*)take((size_t)NEXP * DEXP * DM * 2);
  p.IMGH = (char*)p.X1;
  p.IMGG = (char*)p.Z;
  p.WinT = (u16*)take((size_t)INC * DM * 2);
  p.WoutT = (u16*)take((size_t)DM * DM * 2);
  p.use_cg = 0; p.pad_ = 0;
  p.H = p.P;
  p.Y = p.P + (size_t)32768 * DEXP;

#if SINGLE
  static int grid_blocks = 0;
  if (!grid_blocks) {
    int dev = 0, cus = 0, per_cu = 0;
    hipGetDevice(&dev);
    hipDeviceGetAttribute(&cus, hipDeviceAttributeMultiprocessorCount, dev);
    if (hipFuncSetAttribute((const void*)fwd_megakernel, hipFuncAttributeMaxDynamicSharedMemorySize, SMEM_BYTES) != hipSuccess)
      fprintf(stderr, "hipFuncSetAttribute failed\n");
    hipOccupancyMaxActiveBlocksPerMultiprocessor(&per_cu, fwd_megakernel, 256, SMEM_BYTES);
    if (per_cu > 2) per_cu = 2;
    grid_blocks = cus * per_cu;
  }
  hipMemsetAsync(p.bar, 0, (XCD_BAR_WORDS + 2048) * 4, stream);
  void* args[] = {&p};
  hipError_t e = hipLaunchCooperativeKernel((void*)fwd_megakernel, dim3(grid_blocks), dim3(256), args, SMEM_BYTES, stream);
  if (e != hipSuccess) fprintf(stderr, "cooperative launch failed: %s (grid %d)\n", hipGetErrorString(e), grid_blocks);
#else
  const int G = 512;
  kA<<<G, 256, 0, stream>>>(p);
  kB<<<64, 256, 0, stream>>>(p);
  kC<<<G, 256, 0, stream>>>(p);
  kD<<<G, 256, 0, stream>>>(p);
  kE1<<<G, 256, 0, stream>>>(p);
  kE2<<<G, 256, 0, stream>>>(p);
  kF<<<G, 256, 0, stream>>>(p);
#endif
}
```
